# Optimizing an MI355X kernel written in HIP

```python
import math
import jax, jax.numpy as jnp
from jax import lax
import numpy as np

D_MODEL = 2048
BATCH = 4
SEQ = 4096
DEPTH = 1

CONV_WIDTH = D_MODEL // 2
CONV_K = 3
N_HEADS = 16
N_KV_HEADS = 4
HEAD_DIM = 64
ATTN_WIDTH = N_HEADS * HEAD_DIM
KV_WIDTH = N_KV_HEADS * HEAD_DIM
IDX_HEADS = 16
IDX_DIM = 64
IDX_TOPK_MAX = 256
Q_BLOCK = 128
REL_BUCKETS = 32
REL_MAX_DIST = 128
N_EXPERTS = 64
N_GROUPS = 8
TOPK_GROUPS = 4
TOP_K = 8
D_EXPERT = 512
ROUTED_SCALE = 2.5
EPS = 1e-6
NEG = -1e30

kernel_name = "hybrid_conv_dsa_moe_block"


def rms_norm(x, w):
    xf = x.astype(jnp.float32)
    y = xf * lax.rsqrt(jnp.mean(xf * xf, axis=-1, keepdims=True) + EPS)
    return (y * w.astype(jnp.float32)).astype(x.dtype)


def layer_norm(x, w, b):
    xf = x.astype(jnp.float32)
    mu = jnp.mean(xf, axis=-1, keepdims=True)
    var = jnp.mean(jnp.square(xf - mu), axis=-1, keepdims=True)
    y = (xf - mu) * lax.rsqrt(var + EPS)
    return (y * w.astype(jnp.float32) + b.astype(jnp.float32)).astype(x.dtype)


def t5_bucket(dist):
    n = jnp.maximum(dist, 0)
    max_exact = REL_BUCKETS // 2
    nf = jnp.maximum(n, 1).astype(jnp.float32)
    large = max_exact + (jnp.log(nf / max_exact) / math.log(REL_MAX_DIST / max_exact)
                         * (REL_BUCKETS - max_exact)).astype(jnp.int32)
    large = jnp.minimum(large, REL_BUCKETS - 1)
    return jnp.where(n < max_exact, n, large)


def short_conv_mixer(b_gate, c_gate, u, conv_w):
    v = c_gate * u
    y = lax.conv_general_dilated(
        v, conv_w[:, None, :].astype(v.dtype), window_strides=(1,),
        padding=[(CONV_K - 1, 0)], dimension_numbers=("NWC", "WIO", "NWC"),
        feature_group_count=CONV_WIDTH)
    return b_gate * y


def dsa_attention(q, k, v, qi, ki, wi, rel_bias):
    B, S = q.shape[0], q.shape[1]
    n_sel = min(IDX_TOPK_MAX, S // 4)
    nb = S // Q_BLOCK
    rep = N_HEADS // N_KV_HEADS
    key_pos = jnp.arange(S, dtype=jnp.int32)

    def blockify(a):
        return a.reshape((B, nb, Q_BLOCK) + a.shape[2:]).swapaxes(0, 1)

    def one_block(args):
        blk, qb, qib, wib = args
        t = blk * Q_BLOCK + jnp.arange(Q_BLOCK, dtype=jnp.int32)
        dots = jnp.einsum("bqhd,bsd->bqhs", qib, ki, preferred_element_type=jnp.float32)
        idx_score = jnp.einsum("bqh,bqhs->bqs", wib.astype(jnp.float32),
                               jax.nn.relu(dots)) * (IDX_DIM ** -0.5)
        causal = key_pos[None, :] <= t[:, None]
        idx_score = jnp.where(causal[None], idx_score, NEG)
        _, sel = lax.top_k(idx_score, n_sel)
        valid = sel <= t[None, :, None]
        k_sel = jax.vmap(lambda kk, ii: kk[ii])(k, sel)
        v_sel = jax.vmap(lambda vv, ii: vv[ii])(v, sel)
        qg = qb.reshape(B, Q_BLOCK, N_KV_HEADS, rep, HEAD_DIM)
        logits = jnp.einsum("bqgrd,bqngd->bqgrn", qg, k_sel,
                            preferred_element_type=jnp.float32) * (HEAD_DIM ** -0.5)
        bias = rel_bias[t5_bucket(t[None, :, None] - sel)]
        bias = bias.reshape(B, Q_BLOCK, n_sel, N_KV_HEADS, rep).transpose(0, 1, 3, 4, 2)
        logits = logits + bias.astype(jnp.float32)
        logits = jnp.where(valid[:, :, None, None, :], logits, NEG)
        p = jax.nn.softmax(logits, axis=-1)
        o = jnp.einsum("bqgrn,bqngd->bqgrd", p.astype(v.dtype), v_sel)
        return o.reshape(B, Q_BLOCK, ATTN_WIDTH)

    out = lax.map(one_block, (jnp.arange(nb, dtype=jnp.int32), blockify(q),
                              blockify(qi), blockify(wi)))
    return out.swapaxes(0, 1).reshape(B, S, ATTN_WIDTH)


def swiglu(x, w1, w3, w2):
    return jnp.dot(jax.nn.silu(jnp.dot(x, w1)) * jnp.dot(x, w3), w2)


def moe_ffn(h, w_router, router_bias, w1, w3, w2, ws1, ws3, ws2):
    B, S, D = h.shape
    xt = h.reshape(B * S, D)
    scores = jax.nn.sigmoid(jnp.dot(xt, w_router, preferred_element_type=jnp.float32))
    sel_scores = scores + router_bias.astype(jnp.float32)
    grp = sel_scores.reshape(B * S, N_GROUPS, N_EXPERTS // N_GROUPS)
    grp_score = lax.top_k(grp, 2)[0].sum(-1)
    _, top_g = lax.top_k(grp_score, TOPK_GROUPS)
    gmask = jnp.sum(jax.nn.one_hot(top_g, N_GROUPS, dtype=jnp.float32), axis=1) > 0
    emask = jnp.repeat(gmask, N_EXPERTS // N_GROUPS, axis=1)
    _, top_e = lax.top_k(jnp.where(emask, sel_scores, NEG), TOP_K)
    w_sel = jnp.take_along_axis(scores, top_e, axis=1)
    w_sel = w_sel / jnp.sum(w_sel, axis=-1, keepdims=True) * ROUTED_SCALE
    combine = jnp.einsum("nk,nke->ne", w_sel,
                         jax.nn.one_hot(top_e, N_EXPERTS, dtype=jnp.float32)).astype(xt.dtype)
    out = swiglu(xt, ws1, ws3, ws2)
    for e in range(N_EXPERTS):
        out = out + combine[:, e:e + 1] * swiglu(xt, w1[e], w3[e], w2[e])
    return out.reshape(B, S, D)


def _split_sizes():
    return [CONV_WIDTH, CONV_WIDTH, CONV_WIDTH, ATTN_WIDTH, KV_WIDTH, KV_WIDTH,
            IDX_HEADS * IDX_DIM, IDX_DIM, IDX_HEADS, D_MODEL, D_MODEL]


def setup_inputs(seed: int = 0) -> dict:
    key = jax.random.key(seed)
    ks = jax.random.split(key, 32)
    L, D, E, F = DEPTH, D_MODEL, N_EXPERTS, D_EXPERT
    total_in = sum(_split_sizes())

    def nrm(k, shape, scale):
        return jax.random.normal(k, shape, jnp.float32) * scale

    return {
        "x": nrm(ks[0], (BATCH, SEQ, D), 1.0),
        "c": nrm(ks[1], (BATCH, D), 1.0),
        "rel_bias": nrm(ks[2], (REL_BUCKETS, N_HEADS), 0.5),
        "norm1_w": 1.0 + nrm(ks[3], (L, D), 0.02),
        "norm2_w": 1.0 + nrm(ks[4], (L, D), 0.02),
        "w_ada": nrm(ks[5], (L, D, 6 * D), 0.3 * D ** -0.5),
        "b_ada": nrm(ks[6], (L, 6 * D), 0.02),
        "w_in": nrm(ks[7], (L, D, total_in), D ** -0.5),
        "conv_w": nrm(ks[8], (L, CONV_K, CONV_WIDTH), CONV_K ** -0.5),
        "w_conv_out": nrm(ks[9], (L, CONV_WIDTH, D), CONV_WIDTH ** -0.5),
        "q_norm_w": 1.0 + nrm(ks[10], (L, HEAD_DIM), 0.02),
        "k_norm_w": 1.0 + nrm(ks[11], (L, HEAD_DIM), 0.02),
        "idx_k_norm_w": 1.0 + nrm(ks[12], (L, IDX_DIM), 0.02),
        "idx_k_norm_b": nrm(ks[13], (L, IDX_DIM), 0.02),
        "w_attn_out": nrm(ks[14], (L, ATTN_WIDTH, D), ATTN_WIDTH ** -0.5),
        "w_o": nrm(ks[15], (L, D, D), D ** -0.5),
        "w_router": nrm(ks[16], (L, D, E), D ** -0.5),
        "router_bias": nrm(ks[17], (L, E), 0.01),
        "w1": nrm(ks[18], (L, E, D, F), D ** -0.5),
        "w3": nrm(ks[19], (L, E, D, F), D ** -0.5),
        "w2": nrm(ks[20], (L, E, F, D), F ** -0.5),
        "ws1": nrm(ks[21], (L, D, F), D ** -0.5),
        "ws3": nrm(ks[22], (L, D, F), D ** -0.5),
        "ws2": nrm(ks[23], (L, F, D), F ** -0.5),
    }


def reference(x, c, rel_bias, norm1_w, norm2_w, w_ada, b_ada, w_in, conv_w, w_conv_out,
              q_norm_w, k_norm_w, idx_k_norm_w, idx_k_norm_b, w_attn_out, w_o,
              w_router, router_bias, w1, w3, w2, ws1, ws3, ws2):
    B, S, D = x.shape
    sizes = _split_sizes()
    splits = [int(v) for v in np.cumsum(sizes)[:-1]]
    for l in range(DEPTH):
        mod = jnp.dot(jax.nn.silu(c), w_ada[l]) + b_ada[l]
        sh1, sc1, g1, sh2, sc2, g2 = [m[:, None, :] for m in jnp.split(mod, 6, axis=-1)]

        h = rms_norm(x, norm1_w[l]) * (1 + sc1) + sh1
        proj = jnp.dot(h, w_in[l])
        cb, cc, cu, q, k, v, qi, ki, wi, ga, gb = jnp.split(proj, splits, axis=-1)

        y_conv = jnp.dot(short_conv_mixer(cb, cc, cu, conv_w[l]), w_conv_out[l])

        q = rms_norm(q.reshape(B, S, N_HEADS, HEAD_DIM), q_norm_w[l])
        k = rms_norm(k.reshape(B, S, N_KV_HEADS, HEAD_DIM), k_norm_w[l])
        v = v.reshape(B, S, N_KV_HEADS, HEAD_DIM)
        qi = qi.reshape(B, S, IDX_HEADS, IDX_DIM)
        ki = layer_norm(ki, idx_k_norm_w[l], idx_k_norm_b[l])
        wi = wi * (IDX_HEADS ** -0.5)
        y_attn = jnp.dot(dsa_attention(q, k, v, qi, ki, wi, rel_bias), w_attn_out[l])

        mixed = jax.nn.sigmoid(ga) * y_conv + jax.nn.sigmoid(gb) * y_attn
        x = x + g1 * jnp.dot(mixed, w_o[l])

        h2 = rms_norm(x, norm2_w[l]) * (1 + sc2) + sh2
        x = x + g2 * moe_ffn(h2, w_router[l], router_bias[l], w1[l], w3[l], w2[l],
                             ws1[l], ws3[l], ws2[l])
    return x
```

```cpp
#include <hip/hip_runtime.h>
#include <cstdint>
#include <cstdio>

#define LAS __attribute__((address_space(3)))
#define GAS __attribute__((address_space(1)))
typedef unsigned short bf16_t;
typedef short bf16x8 __attribute__((ext_vector_type(8)));
typedef short bf16x4 __attribute__((ext_vector_type(4)));
typedef float f32x2 __attribute__((ext_vector_type(2)));
typedef float f32x4 __attribute__((ext_vector_type(4)));
typedef float f32x16 __attribute__((ext_vector_type(16)));
typedef unsigned u32x2 __attribute__((ext_vector_type(2)));
typedef unsigned u32x4 __attribute__((ext_vector_type(4)));

constexpr int D = 2048, BATCH = 4, SEQ = 4096, NTOK = BATCH * SEQ;
constexpr int CW = 1024, NH = 16, NKV = 4, HD = 64, AW = 1024, KVW = 256, IH = 16, IDIM = 64, NSEL = 256;
constexpr int NE = 64, TOPK = 8, DE = 512;
constexpr int TOT = 9808, TOTP = 9984;
constexpr int O_CB = 0, O_CC = 1024, O_CU = 2048, O_Q = 3072, O_K = 4096, O_V = 4352, O_QI = 4608, O_KI = 5632, O_WI = 5696, O_GA = 5712, O_GB = 7760;
constexpr float EPS = 1e-6f;
constexpr int MAXPOS = NTOK * 8 + NE * 256 + NTOK;
constexpr int SH_POS0 = NTOK * 8 + NE * 256;

__device__ __forceinline__ unsigned f2bf(float f) { unsigned u = __builtin_bit_cast(unsigned, f); return (u + 0x7fffu + ((u >> 16) & 1u)) >> 16; }
__device__ __forceinline__ unsigned pk2(float lo, float hi) { return f2bf(lo) | (f2bf(hi) << 16); }
__device__ __forceinline__ unsigned cvt_pk_bf16(float lo, float hi) { unsigned r; asm volatile("v_cvt_pk_bf16_f32 %0, %1, %2" : "=v"(r) : "v"(lo), "v"(hi)); return r; }
__device__ __forceinline__ float bf_lo(unsigned w) { return __builtin_bit_cast(float, w << 16); }
__device__ __forceinline__ float bf_hi(unsigned w) { return __builtin_bit_cast(float, w & 0xffff0000u); }
__device__ __forceinline__ float bf2f(bf16_t h) { return __builtin_bit_cast(float, (unsigned)h << 16); }
__device__ __forceinline__ float sigmoid_f(float x) { return 1.f / (1.f + __expf(-x)); }
__device__ __forceinline__ float silu_f(float x) { return x / (1.f + __expf(-x)); }
__device__ __forceinline__ float wave_sum(float v) {
#pragma unroll
    for (int o = 1; o < 64; o <<= 1) v += __shfl_xor(v, o);
    return v;
}
#define LDS_WAIT() asm volatile("s_waitcnt lgkmcnt(0)" ::: "memory")
#define VM_WAIT() asm volatile("s_waitcnt vmcnt(0)" ::: "memory")

#define XB_TMO      128
#define XB_XCNT(j)  (256  + 64 * (j))
#define XB_XSUB(j)  (1280 + 64 * (j))
#define XB_XGEN(j)  (2304 + 64 * (j))
#define XB_TOP      3328
#define XB_TOPGEN   3392
#define XCD_BAR_WORDS 3456
#define XB_SPIN_CAP (1u << 22)

__device__ __forceinline__ unsigned xb_ld(unsigned* p)              { return __hip_atomic_load(p, __ATOMIC_RELAXED, __HIP_MEMORY_SCOPE_AGENT); }
__device__ __forceinline__ unsigned xb_add(unsigned* p, unsigned v) { return __hip_atomic_fetch_add(p, v, __ATOMIC_RELAXED, __HIP_MEMORY_SCOPE_AGENT); }
__device__ __forceinline__ unsigned xb_xcc_id() { return (unsigned)__builtin_amdgcn_s_getreg((3 << 11) | 20) & 0xFu; }
#define XB_SPIN(cond, bar) do { unsigned _sp = 0; while (cond) { __builtin_amdgcn_s_sleep(1); \
    if ((++_sp & 255u) == 0u) { if (xb_ld(&(bar)[XB_TMO])) break; if (_sp > XB_SPIN_CAP) { atomicAdd(&(bar)[XB_TMO], 1u); break; } } } } while (0)

struct XcdBarrier { unsigned* bar; unsigned x; volatile LAS unsigned* st; };

__device__ __forceinline__ XcdBarrier xcd_barrier_post(unsigned* bar, volatile LAS unsigned* st) {
    XcdBarrier b; b.bar = bar; b.x = xb_xcc_id(); b.st = st;
    if (threadIdx.x == 0) (void)xb_add(&bar[XB_XCNT(b.x)], 1u);
    return b;
}
__device__ __forceinline__ void xcd_barrier_complete(unsigned* bar, unsigned x, unsigned& nloc, unsigned& nx) {
    const unsigned G = gridDim.x * gridDim.y * gridDim.z;
    unsigned sum, cnt, mine, sp = 0u;
    for (;;) {
        sum = 0u; cnt = 0u; mine = 0u;
#pragma unroll
        for (unsigned j = 0; j < 16; ++j) { const unsigned c = xb_ld(&bar[XB_XCNT(j)]); sum += c; cnt += (c > 0u) ? 1u : 0u; mine = (j == x) ? c : mine; }
        if (sum == G) break;
        __builtin_amdgcn_s_sleep(1);
        if ((++sp & 255u) == 0u) { if (xb_ld(&bar[XB_TMO])) break; if (sp > XB_SPIN_CAP) { atomicAdd(&bar[XB_TMO], 1u); break; } }
    }
    nloc = mine > 0u ? mine : 1u; nx = cnt > 0u ? cnt : 1u;
}
__device__ __forceinline__ void xcd_barrier(const XcdBarrier& b) {
    asm volatile("s_waitcnt vmcnt(0)" ::: "memory");
    __syncthreads();
    if (threadIdx.x == 0) {
        unsigned* bar = b.bar;
        __builtin_amdgcn_s_waitcnt(0);
        unsigned nloc = b.st[0], nx = b.st[1];
        if (nloc == 0u) { xcd_barrier_complete(bar, b.x, nloc, nx); b.st[0] = nloc; b.st[1] = nx; }
        const unsigned old = xb_add(&bar[XB_XSUB(b.x)], 1u);
        const unsigned gen = old / nloc;
        if (old + 1u == (gen + 1u) * nloc) {
            __builtin_amdgcn_fence(__ATOMIC_RELEASE, "agent");
            asm volatile("s_waitcnt vmcnt(0)" ::: "memory");
            const unsigned og = xb_add(&bar[XB_TOP], 1u);
            const unsigned tg = og / nx;
            if (og + 1u == (tg + 1u) * nx) xb_add(&bar[XB_TOPGEN], 1u);
            else XB_SPIN(xb_ld(&bar[XB_TOPGEN]) == tg, bar);
            __builtin_amdgcn_fence(__ATOMIC_ACQUIRE, "agent");
            xb_add(&bar[XB_XGEN(b.x)], 1u);
            asm volatile("s_waitcnt vmcnt(0)" ::: "memory");
        } else {
            XB_SPIN(xb_ld(&bar[XB_XGEN(b.x)]) == gen, bar);
            __builtin_amdgcn_fence(__ATOMIC_ACQUIRE, "agent");
            asm volatile("s_waitcnt vmcnt(0)" ::: "memory");
        }
    }
    __syncthreads();
}

namespace pg8 {
constexpr int BM = 256, BK = 64, HALF = 128, HTB = HALF * BK * 2, STAGE_BYTES = 8 * HTB;
__host__ __device__ __forceinline__ int lds_byte(int r, int c) { const int st = (r >> 4) * 2 + (c >> 5), rr = r & 15, cc = c & 31, ob = rr * 64 + cc * 2; return st * 1024 + (ob ^ (((ob >> 9) & 1) << 5)); }
__host__ __device__ __forceinline__ void stage_rc(int b, int& R, int& C) { const int st = b / 1024, sb = b % 1024, swz = sb ^ (((sb >> 9) & 1) << 5); R = (st >> 1) * 16 + swz / 64; C = (st & 1) * 32 + (swz % 64) / 2; }
__host__ __device__ __forceinline__ int perm32(int rho) { const int n = rho >> 4, i = rho & 15; return 8 * (i >> 2) + 4 * n + (i & 3); }

struct Unit { const char* A; const char* B; int pm, pn, e, row0; };

template <class Epi, class Sched, bool GATHER>
__device__ __forceinline__ void gemm_phase(LAS unsigned char* lds, const int K, const Sched& S, const Epi& E) {
    const int tid = threadIdx.x, wid = __builtin_amdgcn_readfirstlane(tid >> 6), lane = tid & 63, wr = wid >> 2, wc = wid & 3, fr = lane & 15, fq = lane >> 4;
    const int nt = K / BK;
    unsigned voffA[2][2], voffB[2]; int RA[2], CA2[2];
#pragma unroll
    for (int i = 0; i < 2; ++i) { int R, C; stage_rc(tid * 16 + i * 8192, R, C); const int Rb = Epi::PERM ? ((R & ~31) + perm32(R & 31)) : R;
        RA[i] = R; CA2[i] = C * 2; voffB[i] = (unsigned)(Rb * K + C) * 2u;
        voffA[0][i] = (unsigned)(R * K + C) * 2u; voffA[1][i] = (unsigned)((R + HALF) * K + C) * 2u; }
    const size_t kstep = (size_t)(BK * 2);
    const size_t hstep = (size_t)HALF * K * 2;
    const unsigned ldsw = (unsigned)wid * 1024u;
    const int aoff = lds_byte(wr * 64 + fr, fq * 8), boff = lds_byte(wc * 32 + fr, fq * 8);
#define PG8_SA(b, h) (((b) * 2 + (h)) * HTB)
#define PG8_SB(b, h) ((4 + (b) * 2 + (h)) * HTB)
#define PG8_STAGE(bufoff, gbase, voff) do { _Pragma("unroll") for (int _i = 0; _i < 2; ++_i) \
        __builtin_amdgcn_global_load_lds((const unsigned*)((const char*)(gbase) + (voff)[_i]), (LAS unsigned*)(lds + (bufoff) + ldsw + _i * 8192), 16, 0, 0); } while (0)
#define PG8_LDA(dst, b, h) do { _Pragma("unroll") for (int m = 0; m < 4; ++m) _Pragma("unroll") for (int k = 0; k < 2; ++k) dst[m][k] = *(const LAS bf16x8*)(lds + PG8_SA(b, h) + aoff + m * 2048 + k * 1024); } while (0)
#define PG8_LDB(dst, b, h) do { _Pragma("unroll") for (int n = 0; n < 2; ++n) _Pragma("unroll") for (int k = 0; k < 2; ++k) dst[n][k] = *(const LAS bf16x8*)(lds + PG8_SB(b, h) + boff + n * 2048 + k * 1024); } while (0)
#define PG8_MMA(ai, bj, At, Bt) do { __builtin_amdgcn_s_setprio(1); _Pragma("unroll") for (int m = 0; m < 4; ++m) _Pragma("unroll") for (int n = 0; n < 2; ++n) _Pragma("unroll") for (int k = 0; k < 2; ++k) \
        acc[ai][bj][m][n] = __builtin_amdgcn_mfma_f32_16x16x32_bf16(Bt[n][k], At[m][k], acc[ai][bj][m][n], 0, 0, 0); __builtin_amdgcn_s_setprio(0); } while (0)
#define PG8_WAIT_V(n) asm volatile("s_waitcnt vmcnt(" #n ")" ::: "memory")
#define PG8_WAIT_L(n) asm volatile("s_waitcnt lgkmcnt(" #n ")" ::: "memory")
#define PG8_BAR __builtin_amdgcn_s_barrier()
#define PG8_SCHED __builtin_amdgcn_sched_barrier(0)
#define PG8_GLIST(ui_) do { if constexpr (GATHER) { const LAS int* L_ = S.list(ui_); _Pragma("unroll") for (int h_ = 0; h_ < 2; ++h_) _Pragma("unroll") for (int i_ = 0; i_ < 2; ++i_) \
        voffA[h_][i_] = (unsigned)L_[h_ * HALF + RA[i_]] * (unsigned)(K * 2) + (unsigned)CA2[i_]; } } while (0)
    Unit cur, nxt; int ui = 0;
    PG8_WAIT_V(0); __syncthreads();
    if (!S.next(0, cur)) return;
    PG8_GLIST(0);
    f32x4 acc[2][2][4][2];
#pragma unroll
    for (int a = 0; a < 2; ++a)
#pragma unroll
        for (int b = 0; b < 2; ++b)
#pragma unroll
            for (int m = 0; m < 4; ++m)
#pragma unroll
                for (int n = 0; n < 2; ++n) acc[a][b][m][n] = (f32x4){0.f, 0.f, 0.f, 0.f};
    bf16x8 At[4][2], B0[2][2], B1[2][2];
    const char* cA = cur.A; const char* cB = cur.B;
    PG8_STAGE(PG8_SB(0, 0), cB, voffB); PG8_STAGE(PG8_SB(0, 1), cB + hstep, voffB); PG8_STAGE(PG8_SA(0, 0), cA, voffA[0]); PG8_STAGE(PG8_SA(0, 1), cA, voffA[1]);
    if (wr == 1) PG8_BAR;
    PG8_WAIT_V(2); PG8_BAR;
    PG8_STAGE(PG8_SB(1, 0), cB + kstep, voffB); PG8_STAGE(PG8_SA(1, 0), cA + kstep, voffA[0]); PG8_STAGE(PG8_SB(1, 1), cB + hstep + kstep, voffB);
    PG8_WAIT_V(6); PG8_BAR;
    for (;;) {
        const bool has_next = S.next(ui + 1, nxt);
        const char* nA = has_next ? nxt.A : cA; const char* nB = has_next ? nxt.B : cB;
        for (int t = 0; t < nt; t += 2) {
            const bool last = (t == nt - 2);
            const char* a1 = cA + (size_t)(t + 1) * kstep;
            const char* a2 = last ? nA : cA + (size_t)(t + 2) * kstep; const char* b2 = last ? nB : cB + (size_t)(t + 2) * kstep;
            const char* a3 = a2 + kstep; const char* b3 = b2 + kstep;
            PG8_LDB(B0, 0, 0); PG8_LDB(B1, 0, 1); PG8_SCHED; PG8_LDA(At, 0, 0); PG8_STAGE(PG8_SA(1, 1), a1, voffA[1]);
            if (GATHER && last && has_next) { PG8_GLIST(ui + 1); }
            PG8_WAIT_V(8); PG8_WAIT_L(0); PG8_BAR; PG8_MMA(0, 0, At, B0); PG8_MMA(0, 1, At, B1); PG8_BAR; PG8_SCHED;
            PG8_LDA(At, 0, 1); PG8_STAGE(PG8_SB(0, 0), b2, voffB); PG8_STAGE(PG8_SB(0, 1), b2 + hstep, voffB); PG8_STAGE(PG8_SA(0, 0), a2, voffA[0]);
            PG8_WAIT_V(8); PG8_WAIT_L(0); PG8_BAR; PG8_MMA(1, 0, At, B0); PG8_MMA(1, 1, At, B1); PG8_BAR; PG8_SCHED;
            PG8_LDB(B0, 1, 0); PG8_LDB(B1, 1, 1); PG8_SCHED; PG8_LDA(At, 1, 0); PG8_STAGE(PG8_SA(0, 1), a2, voffA[1]);
            PG8_WAIT_V(8); PG8_WAIT_L(0); PG8_BAR; PG8_MMA(0, 0, At, B0); PG8_MMA(0, 1, At, B1); PG8_BAR; PG8_SCHED;
            PG8_LDA(At, 1, 1); PG8_STAGE(PG8_SB(1, 0), b3, voffB); PG8_STAGE(PG8_SB(1, 1), b3 + hstep, voffB); PG8_STAGE(PG8_SA(1, 0), a3, voffA[0]);
            PG8_WAIT_V(8); PG8_WAIT_L(0); PG8_BAR; PG8_MMA(1, 0, At, B0); PG8_MMA(1, 1, At, B1); PG8_BAR; PG8_SCHED;
        }
        if (wr == 0) PG8_BAR;
        E(acc, cur, wr, wc, fr, fq);
        if (!has_next) break;
#pragma unroll
        for (int a = 0; a < 2; ++a)
#pragma unroll
            for (int b = 0; b < 2; ++b)
#pragma unroll
                for (int m = 0; m < 4; ++m)
#pragma unroll
                    for (int n = 0; n < 2; ++n) acc[a][b][m][n] = (f32x4){0.f, 0.f, 0.f, 0.f};
        cur = nxt; cA = nA; cB = nB; ++ui;
        if (wr == 1) PG8_BAR;
    }
    PG8_WAIT_V(0);
    PG8_BAR;
#undef PG8_SA
#undef PG8_SB
#undef PG8_STAGE
#undef PG8_LDA
#undef PG8_LDB
#undef PG8_MMA
#undef PG8_WAIT_V
#undef PG8_WAIT_L
#undef PG8_BAR
#undef PG8_SCHED
#undef PG8_GLIST
}

struct PlainOrder {
    const char* A; const char* Bt; int K; int nM, nN, nwg, G, c;
    __device__ void init(const void* A_, const void* Bt_, int M, int N, int K_, int G_, int c_) { A = (const char*)A_; Bt = (const char*)Bt_; K = K_; nM = M / BM; nN = N / BM; nwg = nM * nN; G = G_; c = c_; }
    __device__ __forceinline__ bool next(int i, Unit& u) const {
        const long L = (long)i * G + c; if (L >= nwg) return false;
        int wgid = (int)L; { const int q = nwg / 8, r = nwg % 8, xcd = wgid % 8, off = wgid / 8; wgid = (xcd < r ? xcd * (q + 1) : r * (q + 1) + (xcd - r) * q) + off; }
        const int nig = 8 * nN, gid = wgid / nig, fm = gid * 8, gsz = (nM - fm) < 8 ? (nM - fm) : 8;
        u.pm = fm + ((wgid % nig) % gsz); u.pn = (wgid % nig) / gsz; u.e = 0; u.row0 = u.pm * BM;
        u.A = A + (size_t)u.pm * BM * K * 2; u.B = Bt + (size_t)u.pn * BM * K * 2; return true;
    }
    __device__ __forceinline__ const LAS int* list(int) const { return nullptr; }
};

struct EpiBf16 {
    static constexpr bool PERM = true;
    bf16_t* O; int ldc;
    __device__ __forceinline__ void operator()(const f32x4 (&acc)[2][2][4][2], const Unit& u, int wr, int wc, int fr, int fq) const {
        const int row0 = u.row0 + wr * 64 + fr; const int col0 = u.pn * BM + wc * 32 + 8 * fq;
#pragma unroll
        for (int ai = 0; ai < 2; ++ai)
#pragma unroll
            for (int m = 0; m < 4; ++m) { bf16_t* rowp = O + (size_t)(row0 + ai * HALF + m * 16) * ldc + col0;
#pragma unroll
                for (int bj = 0; bj < 2; ++bj) { const f32x4 v0 = acc[ai][bj][m][0], v1 = acc[ai][bj][m][1];
                    u32x4 w; w.x = cvt_pk_bf16(v0[0], v0[1]); w.y = cvt_pk_bf16(v0[2], v0[3]); w.z = cvt_pk_bf16(v1[0], v1[1]); w.w = cvt_pk_bf16(v1[2], v1[3]);
                    *(u32x4*)(rowp + bj * HALF) = w; } }
    }
};
}
constexpr size_t MiB = 1u << 20;
constexpr size_t WS_CTL = 0, CTL_ZERO_BYTES = 1 * MiB;
constexpr size_t WS_MOD = 1 * MiB;
constexpr size_t WS_MODP = WS_MOD + 256 * 1024;
constexpr size_t WS_TOKE = 3 * MiB, WS_TOKW = WS_TOKE + 512 * 1024, WS_TOKPOS = WS_TOKW + 512 * 1024, WS_TOKRANK = WS_TOKPOS + 512 * 1024;
constexpr size_t WS_BLKBASE = WS_TOKRANK + 512 * 1024;
constexpr size_t WS_SRT = 6 * MiB;
constexpr size_t WS_W2T = 8 * MiB;
constexpr size_t WS_HH = 138 * MiB;
constexpr size_t WS_YB = 298 * MiB;
constexpr size_t WS_W13T = 298 * MiB;
constexpr size_t WS_HB = 558 * MiB;
constexpr size_t WS_WINT = 622 * MiB;
constexpr size_t WS_WCVT = 661 * MiB, WS_WATT = 665 * MiB, WS_WOT = 669 * MiB, WS_WRX = 677 * MiB, WS_WRY = 678 * MiB;
constexpr size_t WS_RLOG = 679 * MiB;
constexpr size_t WS_PROJ = 691 * MiB;
constexpr size_t WS_HLO = WS_PROJ;
constexpr size_t WS_UMIX = 1003 * MiB, WS_AO = 1035 * MiB, WS_KN = 1067 * MiB, WS_VT = 1075 * MiB, WS_KIN = 1083 * MiB, WS_MASK = 1085 * MiB, WS_END = 1093 * MiB;
constexpr int CW_TMO = 0, CW_BAR = 4096, CW_CNT = 16384  , CW_CUR = 16384 + 64;

constexpr int RING_BYTES = 131072;
constexpr int LIST_OFF = RING_BYTES;
constexpr int MISC_OFF = LIST_OFF + 12 * 1024;
constexpr int LDS_BYTES = MISC_OFF + 256;
constexpr int NWAVES = 8, NTHREADS = 512;

struct Args {
    const float* in[24]; float* out; unsigned char* ws; int ph_lo, ph_hi, bar_region, pad;
};

__device__ __forceinline__ void p0_item(const float* W, int K, int N, int k0, int n0, bf16_t* dst, bf16_t* dst2, int mode, LAS float* scr, int lane) {
    const int nn = n0 + (lane & 31); const bool ok = nn < N;
#pragma unroll 8
    for (int i = 0; i < 32; ++i) { const int kk = 2 * i + (lane >> 5); scr[kk * 33 + (lane & 31)] = ok ? W[(size_t)(k0 + kk) * N + nn] : 0.f; }
    LDS_WAIT(); asm volatile("" ::: "memory");
    const int c = lane & 7;
#pragma unroll
    for (int j = 0; j < 4; ++j) { const int n = (lane >> 3) + 8 * j; const LAS float* s = scr + (8 * c) * 33 + n;
        float v[8];
#pragma unroll
        for (int q = 0; q < 8; ++q) v[q] = s[q * 33];
        if (mode == 2) {
#pragma unroll
            for (int q = 0; q < 8; ++q) v[q] = v[q] - __builtin_bit_cast(float, f2bf(v[q]) << 16);
        }
        u32x4 o; o.x = pk2(v[0], v[1]); o.y = pk2(v[2], v[3]); o.z = pk2(v[4], v[5]); o.w = pk2(v[6], v[7]);
        *(u32x4*)(dst + (size_t)n * K + k0 + 8 * c) = o;
        if (mode == 1) *(u32x4*)(dst2 + (size_t)n * K + k0 + 8 * c) = o; }
    LDS_WAIT(); asm volatile("" ::: "memory");
}

struct Frame {
    LAS unsigned char* lds; unsigned* ctl; unsigned char* ws; const float* const* in; float* out;
    int tid, lane, wave, G, bid;
};

__device__ __forceinline__ void p0_prologue(const Frame& F) {
    const float* c_in = F.in[1]; const float* w_ada = F.in[5];
    LAS float* scr = (LAS float*)(F.lds + F.wave * 16384);
    const int gw = F.bid * NWAVES + F.wave, NGW = F.G * NWAVES;
    for (int task = gw; task < 192 * 8; task += NGW) {
        const int kc = task & 7, cc = task >> 3, kbase = kc * 256;
#pragma unroll
        for (int b = 0; b < 4; ++b)
#pragma unroll
            for (int j = 0; j < 4; ++j) { const int k = F.lane + 64 * j; scr[b * 256 + k] = silu_f(c_in[b * D + kbase + k]); }
        LDS_WAIT(); asm volatile("" ::: "memory");
        float a0 = 0.f, a1 = 0.f, a2 = 0.f, a3 = 0.f;
        const float* wp = w_ada + (size_t)kbase * (6 * D) + cc * 64 + F.lane;
#pragma unroll 8
        for (int k = 0; k < 256; ++k) { const float w = wp[(size_t)k * (6 * D)];
            a0 += scr[k] * w; a1 += scr[256 + k] * w; a2 += scr[512 + k] * w; a3 += scr[768 + k] * w; }
        float* mp = (float*)(F.ws + WS_MODP) + (size_t)kc * (4 * 6 * D) + cc * 64 + F.lane;
        mp[0] = a0; mp[6 * D] = a1; mp[2 * 6 * D] = a2; mp[3 * 6 * D] = a3;
        LDS_WAIT(); asm volatile("" ::: "memory");
    }
    constexpr int NB_IN = (TOT + 31) / 32;
    constexpr int I_IN = (D / 64) * NB_IN, I_CV = (CW / 64) * (D / 32), I_AT = I_CV, I_O = (D / 64) * (D / 32);
    constexpr int I_13 = (D / 64) * (DE / 32)  , I_2 = (DE / 64) * (D / 32)  , I_R = (D / 64) * 2 * 2;
    constexpr int NITEMS = I_IN + I_CV + I_AT + I_O + 130 * I_13 + 65 * I_2 + I_R;
    bf16_t* WINT = (bf16_t*)(F.ws + WS_WINT); bf16_t* W13T = (bf16_t*)(F.ws + WS_W13T); bf16_t* W2T = (bf16_t*)(F.ws + WS_W2T);
    for (int it = gw; it < NITEMS; it += NGW) {
        int r = it;
        if (r < I_IN) { const int kb = r / NB_IN, nb = r % NB_IN; p0_item(F.in[7], D, TOT, 64 * kb, 32 * nb, WINT + (size_t)(32 * nb) * D, nullptr, 0, scr, F.lane); continue; } r -= I_IN;
        if (r < I_CV) { const int kb = r / (D / 32), nb = r % (D / 32); p0_item(F.in[9], CW, D, 64 * kb, 32 * nb, (bf16_t*)(F.ws + WS_WCVT) + (size_t)(32 * nb) * CW, nullptr, 0, scr, F.lane); continue; } r -= I_CV;
        if (r < I_AT) { const int kb = r / (D / 32), nb = r % (D / 32); p0_item(F.in[14], AW, D, 64 * kb, 32 * nb, (bf16_t*)(F.ws + WS_WATT) + (size_t)(32 * nb) * AW, nullptr, 0, scr, F.lane); continue; } r -= I_AT;
        if (r < I_O) { const int kb = r / (D / 32), nb = r % (D / 32); p0_item(F.in[15], D, D, 64 * kb, 32 * nb, (bf16_t*)(F.ws + WS_WOT) + (size_t)(32 * nb) * D, nullptr, 0, scr, F.lane); continue; } r -= I_O;
        if (r < 130 * I_13) {
            const int mtx = r / I_13, q = r % I_13, kb = q / (DE / 32), nb = q % (DE / 32);
            const int is3 = (mtx >= 64 && mtx < 128) || mtx == 129; const int e = mtx < 64 ? mtx : (mtx < 128 ? mtx - 64 : 64);
            const float* W = mtx < 64 ? F.in[18] + (size_t)mtx * D * DE : (mtx < 128 ? F.in[19] + (size_t)(mtx - 64) * D * DE : (mtx == 128 ? F.in[21] : F.in[22]));
            const int n0 = 32 * nb; const int drow = e * 1024 + (n0 >> 7) * 256 + is3 * 128 + (n0 & 127);
            p0_item(W, D, DE, 64 * kb, n0, W13T + (size_t)drow * D, nullptr, 0, scr, F.lane); continue; } r -= 130 * I_13;
        if (r < 65 * I_2) {
            const int mtx = r / I_2, q = r % I_2, kb = q / (D / 32), nb = q % (D / 32);
            const float* W = mtx < 64 ? F.in[20] + (size_t)mtx * DE * D : F.in[23];
            p0_item(W, DE, D, 64 * kb, 32 * nb, W2T + ((size_t)mtx * D + 32 * nb) * DE, nullptr, 0, scr, F.lane); continue; } r -= 65 * I_2;
        { const int mode = 1 + (r & 1); const int q = r >> 1, kb = q / 2, nb = q % 2;
          bf16_t* WRX = (bf16_t*)(F.ws + WS_WRX); bf16_t* WRY = (bf16_t*)(F.ws + WS_WRY);
          p0_item(F.in[16], D, NE, 64 * kb, 32 * nb, WRX + (size_t)((mode == 2 ? 64 : 0) + 32 * nb) * D, WRY + (size_t)(32 * nb) * D, mode, scr, F.lane); }
    }
    {
        const u32x4 z = {0u, 0u, 0u, 0u};
        const int gt = gw * 64 + F.lane, NGT = NGW * 64;
        u32x4* p1 = (u32x4*)(WINT + (size_t)9824 * D); for (int i = gt; i < 160 * 256; i += NGT) p1[i] = z;
        u32x4* p2 = (u32x4*)((bf16_t*)(F.ws + WS_WRX) + (size_t)128 * D); for (int i = gt; i < 128 * 256; i += NGT) p2[i] = z;
        u32x4* p3 = (u32x4*)((bf16_t*)(F.ws + WS_WRY) + (size_t)64 * D); for (int i = gt; i < 192 * 256; i += NGT) p3[i] = z;
    }
}

__device__ __forceinline__ float mod_value(const Frame& F, int idx) {
    const float* mp = (const float*)(F.ws + WS_MODP) + idx; float s = 0.f;
#pragma unroll
    for (int p = 0; p < 8; ++p) s += mp[(size_t)p * (4 * 6 * D)];
    return s + F.in[6][idx % (6 * D)];
}

__device__ __forceinline__ void p1_norm1(const Frame& F) {
    LAS float* sh = (LAS float*)F.lds;
    LAS float* sc = sh + D;
    float* MOD = (float*)(F.ws + WS_MOD);
    for (int idx = F.bid * NTHREADS + F.tid; idx < 4 * 6 * D; idx += F.G * NTHREADS) MOD[idx] = mod_value(F, idx);
    for (int blk = F.bid; blk < NTOK / 64; blk += F.G) {
        const int b = blk / (SEQ / 64);
        __syncthreads();
        for (int i = F.tid; i < D; i += NTHREADS) { sh[i] = mod_value(F, b * 6 * D + i); sc[i] = (1.f + mod_value(F, b * 6 * D + D + i)) * F.in[3][i]; }
        __syncthreads();
        for (int j = 0; j < 8; ++j) {
            const int t = blk * 64 + F.wave * 8 + j;
            const f32x4* xr = (const f32x4*)(F.in[0] + (size_t)t * D) + F.lane;
            f32x4 v[8]; float s = 0.f;
#pragma unroll
            for (int q = 0; q < 8; ++q) { v[q] = xr[64 * q]; s += (v[q].x * v[q].x + v[q].y * v[q].y) + (v[q].z * v[q].z + v[q].w * v[q].w); }
            const float r = rsqrtf(wave_sum(s) * (1.f / D) + EPS);
            u32x2* o = (u32x2*)((bf16_t*)(F.ws + WS_HB) + (size_t)t * D) + F.lane;
#pragma unroll
            for (int q = 0; q < 8; ++q) { const int c0 = 4 * F.lane + 256 * q;
                const f32x4 a = *(const LAS f32x4*)(sc + c0), bb = *(const LAS f32x4*)(sh + c0);
                u32x2 w; w.x = pk2(v[q].x * r * a.x + bb.x, v[q].y * r * a.y + bb.y); w.y = pk2(v[q].z * r * a.z + bb.z, v[q].w * r * a.w + bb.w);
                o[64 * q] = w; }
        }
    }
}

__device__ __forceinline__ void p3_mix(const Frame& F) {
    const bf16_t* PROJ = (const bf16_t*)(F.ws + WS_PROJ);
    bf16_t* UMIX = (bf16_t*)(F.ws + WS_UMIX); bf16_t* KN = (bf16_t*)(F.ws + WS_KN); bf16_t* VT = (bf16_t*)(F.ws + WS_VT); bf16_t* KIN = (bf16_t*)(F.ws + WS_KIN);
    const float* conv_w = F.in[8];
    LAS bf16_t* tile = (LAS bf16_t*)F.lds;
    const int c0 = F.lane * 16;
    float w0[16], w1[16], w2[16];
#pragma unroll
    for (int i = 0; i < 16; ++i) { w0[i] = conv_w[c0 + i]; w1[i] = conv_w[CW + c0 + i]; w2[i] = conv_w[2 * CW + c0 + i]; }
    const float* knw = F.in[11]; float kw4[4];
#pragma unroll
    for (int i = 0; i < 4; ++i) kw4[i] = knw[(F.lane & 15) * 4 + i];
    const float iw = F.in[12][F.lane], ib = F.in[13][F.lane];
    for (int blk = F.bid; blk < NTOK / 64; blk += F.G) {
        const int tok0 = blk * 64, b = tok0 / SEQ, tt0 = tok0 % SEQ;
        __syncthreads();
#pragma unroll
        for (int it = 0; it < 4; ++it) { const int idx = it * NTHREADS + F.tid, tk = idx >> 5, ch = idx & 31;
            const u32x4 v = *(const u32x4*)(PROJ + (size_t)(tok0 + tk) * TOTP + O_V + ch * 8);
            const unsigned wv[4] = {v.x, v.y, v.z, v.w};
#pragma unroll
            for (int j = 0; j < 4; ++j) { tile[(ch * 8 + 2 * j) * 72 + tk] = (bf16_t)(wv[j] & 0xffffu); tile[(ch * 8 + 2 * j + 1) * 72 + tk] = (bf16_t)(wv[j] >> 16); } }
        __syncthreads();
#pragma unroll
        for (int it = 0; it < 4; ++it) { const int idx = it * NTHREADS + F.tid, col = idx >> 3, ch = idx & 7;
            const u32x4 v = *(const LAS u32x4*)(tile + col * 72 + ch * 8);
            *(u32x4*)(VT + ((size_t)(b * 256 + col)) * SEQ + tt0 + ch * 8) = v; }
        float vm1[16], vm2[16];
        {
            const int t = tok0 + F.wave * 8, tt = t % SEQ;
#pragma unroll
            for (int back = 1; back <= 2; ++back) {
                float* dst = back == 1 ? vm1 : vm2;
                if (tt >= back) {
                    const bf16_t* p = PROJ + (size_t)(t - back) * TOTP;
                    const u32x4 a0 = *(const u32x4*)(p + O_CC + c0), a1 = *(const u32x4*)(p + O_CC + c0 + 8), b0 = *(const u32x4*)(p + O_CU + c0), b1 = *(const u32x4*)(p + O_CU + c0 + 8);
                    const unsigned aw[8] = {a0.x, a0.y, a0.z, a0.w, a1.x, a1.y, a1.z, a1.w}, bw[8] = {b0.x, b0.y, b0.z, b0.w, b1.x, b1.y, b1.z, b1.w};
#pragma unroll
                    for (int i = 0; i < 8; ++i) { dst[2 * i] = bf_lo(aw[i]) * bf_lo(bw[i]); dst[2 * i + 1] = bf_hi(aw[i]) * bf_hi(bw[i]); }
                } else {
#pragma unroll
                    for (int i = 0; i < 16; ++i) dst[i] = 0.f;
                }
            }
        }
        for (int j = 0; j < 8; ++j) {
            const int t = tok0 + F.wave * 8 + j;
            const bf16_t* p = PROJ + (size_t)t * TOTP;
            const u32x4 a0 = *(const u32x4*)(p + O_CC + c0), a1 = *(const u32x4*)(p + O_CC + c0 + 8), b0 = *(const u32x4*)(p + O_CU + c0), b1 = *(const u32x4*)(p + O_CU + c0 + 8);
            const u32x4 g0 = *(const u32x4*)(p + O_CB + c0), g1 = *(const u32x4*)(p + O_CB + c0 + 8);
            const unsigned aw[8] = {a0.x, a0.y, a0.z, a0.w, a1.x, a1.y, a1.z, a1.w}, bw[8] = {b0.x, b0.y, b0.z, b0.w, b1.x, b1.y, b1.z, b1.w}, gw[8] = {g0.x, g0.y, g0.z, g0.w, g1.x, g1.y, g1.z, g1.w};
            float v0[16]; unsigned ow[8];
#pragma unroll
            for (int i = 0; i < 8; ++i) { v0[2 * i] = bf_lo(aw[i]) * bf_lo(bw[i]); v0[2 * i + 1] = bf_hi(aw[i]) * bf_hi(bw[i]); }
#pragma unroll
            for (int i = 0; i < 8; ++i) {
                const float y0 = w0[2 * i] * vm2[2 * i] + w1[2 * i] * vm1[2 * i] + w2[2 * i] * v0[2 * i];
                const float y1 = w0[2 * i + 1] * vm2[2 * i + 1] + w1[2 * i + 1] * vm1[2 * i + 1] + w2[2 * i + 1] * v0[2 * i + 1];
                ow[i] = pk2(bf_lo(gw[i]) * y0, bf_hi(gw[i]) * y1); }
            u32x4* o = (u32x4*)(UMIX + (size_t)t * CW + c0);
            o[0] = (u32x4){ow[0], ow[1], ow[2], ow[3]}; o[1] = (u32x4){ow[4], ow[5], ow[6], ow[7]};
#pragma unroll
            for (int i = 0; i < 16; ++i) { vm2[i] = vm1[i]; vm1[i] = v0[i]; }
            { const u32x2 kv = *(const u32x2*)(p + O_K + F.lane * 4);
              float k0 = bf_lo(kv.x), k1 = bf_hi(kv.x), k2 = bf_lo(kv.y), k3 = bf_hi(kv.y);
              float s = (k0 * k0 + k1 * k1) + (k2 * k2 + k3 * k3);
              s += __shfl_xor(s, 1); s += __shfl_xor(s, 2); s += __shfl_xor(s, 4); s += __shfl_xor(s, 8);
              const float r = rsqrtf(s * (1.f / 64.f) + EPS);
              u32x2 ov; ov.x = pk2(k0 * r * kw4[0], k1 * r * kw4[1]); ov.y = pk2(k2 * r * kw4[2], k3 * r * kw4[3]);
              *(u32x2*)(KN + (size_t)t * KVW + F.lane * 4) = ov; }
            { const float xv = bf2f(p[O_KI + F.lane]);
              const float mu = wave_sum(xv) * (1.f / 64.f), dx = xv - mu, var = wave_sum(dx * dx) * (1.f / 64.f);
              KIN[(size_t)t * IDIM + F.lane] = (bf16_t)f2bf(dx * rsqrtf(var + EPS) * iw + ib); }
        }
    }
}

__device__ __forceinline__ unsigned f2key(float f) { const unsigned u = __float_as_uint(f); return (u & 0x80000000u) ? ~u : (u | 0x80000000u); }
__device__ __forceinline__ int crow32(int r, int hi) { return (r & 3) + 8 * (r >> 2) + 4 * hi; }

__device__ __forceinline__ void p4_index(const Frame& F) {
    const bf16_t* PROJ = (const bf16_t*)(F.ws + WS_PROJ); const bf16_t* KIN = (const bf16_t*)(F.ws + WS_KIN);
    unsigned* MASK = (unsigned*)(F.ws + WS_MASK);
    LAS float* SC = (LAS float*)F.lds;
    const int lane = F.lane, n32 = lane & 31, hi = lane >> 5, w = F.wave;
    constexpr int NUNITS = BATCH * (SEQ / 8);
    for (int r = 0;; ++r) {
        const int L = r * F.G + ((r & 1) ? (F.G - 1 - F.bid) : F.bid);
        if (L >= NUNITS) break;
        const int b = L & 3, qg = (SEQ / 8 - 1) - (L >> 2), t0 = qg * 8;
        const int nkt = (t0 + 7) / 32 + 1;
        __syncthreads();
#pragma unroll 1
        for (int half = 0; half < 2; ++half) {
            bf16x8 Af[2][4]; float wq[2][16];
            {
                const int qsel = (n32 >> 2) & 1, head = (n32 & 3) + 4 * (n32 >> 3);
#pragma unroll
                for (int rt = 0; rt < 2; ++rt) {
                    const int q2 = 4 * half + 2 * rt;
                    const bf16_t* p = PROJ + (size_t)(b * SEQ + t0 + q2 + qsel) * TOTP + O_QI + head * 64 + 8 * hi;
#pragma unroll
                    for (int ks = 0; ks < 4; ++ks) Af[rt][ks] = *(const bf16x8*)(p + 16 * ks);
                    const bf16_t* pw = PROJ + (size_t)(b * SEQ + t0 + q2 + hi) * TOTP + O_WI;
                    const u32x4 x0 = *(const u32x4*)pw, x1 = *(const u32x4*)(pw + 8);
                    const unsigned xw[8] = {x0.x, x0.y, x0.z, x0.w, x1.x, x1.y, x1.z, x1.w};
#pragma unroll
                    for (int i = 0; i < 8; ++i) { wq[rt][2 * i] = bf_lo(xw[i]) * (0.25f * 0.125f); wq[rt][2 * i + 1] = bf_hi(xw[i]) * (0.25f * 0.125f); }
                }
            }
            bf16x8 Bf[4];
            if (w < nkt) {
                const bf16_t* kp = KIN + (size_t)(b * SEQ + w * 32 + n32) * IDIM + 8 * hi;
#pragma unroll
                for (int ks = 0; ks < 4; ++ks) Bf[ks] = *(const bf16x8*)(kp + 16 * ks);
            }
            for (int kt = w; kt < nkt; kt += 8) {
                bf16x8 Bn[4];
                const bool more = kt + 8 < nkt;
                if (more) {
                    const bf16_t* kp = KIN + (size_t)(b * SEQ + (kt + 8) * 32 + n32) * IDIM + 8 * hi;
#pragma unroll
                    for (int ks = 0; ks < 4; ++ks) Bn[ks] = *(const bf16x8*)(kp + 16 * ks);
                }
#pragma unroll
                for (int rt = 0; rt < 2; ++rt) {
                    f32x16 acc = {};
#pragma unroll
                    for (int ks = 0; ks < 4; ++ks) acc = __builtin_amdgcn_mfma_f32_32x32x16_bf16(Af[rt][ks], Bf[ks], acc, 0, 0, 0);
                    float s = 0.f;
#pragma unroll
                    for (int i = 0; i < 16; ++i) s += wq[rt][i] * fmaxf(acc[i], 0.f);
                    SC[(4 * half + 2 * rt + hi) * SEQ + kt * 32 + n32] = s;
                }
                if (more) {
#pragma unroll
                    for (int ks = 0; ks < 4; ++ks) Bf[ks] = Bn[ks];
                }
            }
        }
        __syncthreads();
        {
            const int t = t0 + w, jmax = t >> 6;
            unsigned key[64];
#pragma unroll
            for (int j = 0; j < 64; ++j) { const int s = j * 64 + lane; key[j] = (j <= jmax && s <= t) ? f2key(SC[w * SEQ + s]) : 0u; }
            unsigned TH = 0u; bool exact = false;
            if (t + 1 <= NSEL) { TH = 1u; exact = true; }
            else {
                for (int bit = 31; bit >= 0; --bit) {
                    const unsigned cand = TH | (1u << bit);
                    int c = 0;
#pragma unroll
                    for (int j = 0; j < 64; ++j) c += __popcll(__ballot(key[j] >= cand));
                    if (c >= NSEL) TH = cand;
                    if (c == NSEL) { exact = true; break; }
                }
            }
            int rem = 0;
            if (!exact) { int cgt = 0;
#pragma unroll
                for (int j = 0; j < 64; ++j) cgt += __popcll(__ballot(key[j] > TH));
                rem = NSEL - cgt; }
            unsigned mlo = 0u, mhi = 0u;
#pragma unroll
            for (int j = 0; j < 64; ++j) {
                unsigned long long m;
                if (exact) m = __ballot(key[j] >= TH);
                else {
                    m = __ballot(key[j] > TH);
                    unsigned long long e = __ballot(key[j] == TH);
                    while (rem > 0 && e) { const unsigned long long bitv = e & (~e + 1ull); m |= bitv; e ^= bitv; --rem; }
                }
                if (lane == j) { mlo = (unsigned)m; mhi = (unsigned)(m >> 32); }
            }
            if (lane <= jmax) {
                MASK[((size_t)(b * 128 + 2 * lane)) * SEQ + t] = mlo;
                MASK[((size_t)(b * 128 + 2 * lane + 1)) * SEQ + t] = mhi;
            }
        }
    }
}

constexpr int P5_KBUF = 0, P5_VBUF = 16384, P5_STG = 32768, P5_BIAS = 73728, P5_END = P5_BIAS + 16 * 132 * 4;
__device__ __forceinline__ int t5_bucket(int n) {
    if (n < 16) return n;
    const int large = 16 + (int)(__logf((float)n * (1.f / 16.f)) * (16.f / 2.0794415416798357f));
    return large < 31 ? large : 31;
}
__device__ __forceinline__ void p5_attn(const Frame& F) {
    const bf16_t* PROJ = (const bf16_t*)(F.ws + WS_PROJ); const bf16_t* KN = (const bf16_t*)(F.ws + WS_KN); const bf16_t* VT = (const bf16_t*)(F.ws + WS_VT);
    const unsigned* MASK = (const unsigned*)(F.ws + WS_MASK); bf16_t* AO = (bf16_t*)(F.ws + WS_AO);
    const float* rel_bias = F.in[2]; const float* qnw = F.in[10];
    const int lane = F.lane, q32 = lane & 31, hi = lane >> 5, w = F.wave, tid = F.tid;
    constexpr float LOG2E = 1.4426950408889634f;
    LAS float* BT = (LAS float*)(F.lds + P5_BIAS);
    __syncthreads();
    for (int i = tid; i < 16 * 129; i += NTHREADS) { const int h = i / 129, d = i % 129;
        BT[h * 132 + d] = d < 128 ? (rel_bias[t5_bucket(d) * NH + h] - rel_bias[31 * NH + h]) * LOG2E : 0.f; }
    __syncthreads();
    constexpr int NUNITS = BATCH * NKV * (SEQ / 64);
    const int kkey = tid >> 3, kch = tid & 7;
    const int ldsK = kkey * 128 + ((kch ^ ((kkey >> 1) & 7)) * 16);
    for (int r = 0;; ++r) {
        const int L = r * F.G + ((r & 1) ? (F.G - 1 - F.bid) : F.bid);
        if (L >= NUNITS) break;
        const int bg = L & 15, b = bg >> 2, g = bg & 3, qt = (SEQ / 64 - 1) - (L >> 4), t0 = qt * 64;
        const int h = 4 * g + (w >> 1), tq = t0 + 32 * (w & 1) + q32;
        const int nkt = qt + 1;
        bf16x8 Qf[4];
        {
            const bf16_t* qp = PROJ + (size_t)(b * SEQ + tq) * TOTP + O_Q + h * 64 + 8 * hi;
            u32x4 raw[4]; float ss = 0.f;
#pragma unroll
            for (int ks = 0; ks < 4; ++ks) { raw[ks] = *(const u32x4*)(qp + 16 * ks); const unsigned xw[4] = {raw[ks].x, raw[ks].y, raw[ks].z, raw[ks].w};
#pragma unroll
                for (int i = 0; i < 4; ++i) { const float a = bf_lo(xw[i]), c = bf_hi(xw[i]); ss += a * a + c * c; } }
            ss += __shfl_xor(ss, 32);
            const float rs = rsqrtf(ss * (1.f / 64.f) + EPS) * (0.125f * LOG2E);
#pragma unroll
            for (int ks = 0; ks < 4; ++ks) { const unsigned xw[4] = {raw[ks].x, raw[ks].y, raw[ks].z, raw[ks].w}; const float* wn = qnw + 16 * ks + 8 * hi; u32x4 o;
                unsigned ow[4];
#pragma unroll
                for (int i = 0; i < 4; ++i) ow[i] = pk2(bf_lo(xw[i]) * rs * wn[2 * i], bf_hi(xw[i]) * rs * wn[2 * i + 1]);
                o = (u32x4){ow[0], ow[1], ow[2], ow[3]}; Qf[ks] = __builtin_bit_cast(bf16x8, o); }
        }
        const bf16_t* kg = KN + (size_t)(b * SEQ) * KVW + g * 64 + kkey * KVW + kch * 8;
        const bf16_t* vg = VT + ((size_t)((b * 4 + g) * 64 + kkey)) * SEQ + kch * 8;
        const unsigned* mg = MASK + (size_t)(b * 128) * SEQ + tq;
        f32x16 O0 = {}, O1 = {}; float lsum = 0.f;
        __syncthreads();
        { const u32x4 kv = *(const u32x4*)kg, vv = *(const u32x4*)vg;
          *(LAS u32x4*)(F.lds + P5_KBUF + ldsK) = kv; *(LAS u32x4*)(F.lds + P5_VBUF + ldsK) = vv; }
        unsigned mn0 = mg[0], mn1 = mg[SEQ];
        __syncthreads();
        for (int kt = 0; kt < nkt; ++kt) {
            const int cur = (kt & 1) * 8192;
            u32x4 kn_, vn_; const bool more = kt + 1 < nkt;
            const unsigned m0 = mn0 >> (4 * hi), m1 = mn1 >> (4 * hi);
            if (more) { kn_ = *(const u32x4*)(kg + (size_t)(kt + 1) * 64 * KVW); vn_ = *(const u32x4*)(vg + (kt + 1) * 64);
                        mn0 = mg[(size_t)(2 * kt + 2) * SEQ]; mn1 = mg[(size_t)(2 * kt + 3) * SEQ]; }
            f32x16 p0 = {}, p1 = {};
            {
                const LAS unsigned char* kb = F.lds + P5_KBUF + cur;
#pragma unroll
                for (int ks = 0; ks < 4; ++ks) {
                    const int ch = 2 * ks + hi;
                    const bf16x8 a0 = *(const LAS bf16x8*)(kb + q32 * 128 + ((ch ^ ((q32 >> 1) & 7)) * 16));
                    const bf16x8 a1 = *(const LAS bf16x8*)(kb + (q32 + 32) * 128 + ((ch ^ (((q32 + 32) >> 1) & 7)) * 16));
                    p0 = __builtin_amdgcn_mfma_f32_32x32x16_bf16(a0, Qf[ks], p0, 0, 0, 0);
                    p1 = __builtin_amdgcn_mfma_f32_32x32x16_bf16(a1, Qf[ks], p1, 0, 0, 0);
                }
            }
            if (kt + 3 > qt) {
                const LAS float* bt = BT + (w >> 1 | (g << 2)) * 132; const int dbase = tq - kt * 64 - 4 * hi;
#pragma unroll
                for (int r2 = 0; r2 < 16; ++r2) { const int kk = (r2 & 3) + 8 * (r2 >> 2);
                    int d0 = dbase - kk, d1 = dbase - kk - 32; d0 = d0 < 0 ? 128 : (d0 > 128 ? 128 : d0); d1 = d1 < 0 ? 128 : (d1 > 128 ? 128 : d1);
                    p0[r2] += bt[d0]; p1[r2] += bt[d1]; }
            }
#pragma unroll
            for (int r2 = 0; r2 < 16; ++r2) { const int bitpos = (r2 & 3) + 8 * (r2 >> 2);
                const float e0 = __builtin_amdgcn_exp2f(p0[r2]), e1 = __builtin_amdgcn_exp2f(p1[r2]);
                p0[r2] = __uint_as_float(__float_as_uint(e0) & (unsigned)__builtin_amdgcn_sbfe(m0, bitpos, 1));
                p1[r2] = __uint_as_float(__float_as_uint(e1) & (unsigned)__builtin_amdgcn_sbfe(m1, bitpos, 1));
                lsum += p0[r2] + p1[r2]; }
            {
                const LAS unsigned char* vb = F.lds + P5_VBUF + cur;
#pragma unroll
                for (int s = 0; s < 4; ++s) {
                    const f32x16& pp = (s < 2) ? p0 : p1; const int rb = 8 * (s & 1);
                    u32x4 pw; pw.x = cvt_pk_bf16(pp[rb + 0], pp[rb + 1]); pw.y = cvt_pk_bf16(pp[rb + 2], pp[rb + 3]); pw.z = cvt_pk_bf16(pp[rb + 4], pp[rb + 5]); pw.w = cvt_pk_bf16(pp[rb + 6], pp[rb + 7]);
                    const bf16x8 pb = __builtin_bit_cast(bf16x8, pw);
#pragma unroll
                    for (int blk = 0; blk < 2; ++blk) {
                        const int dim = q32 + 32 * blk, sw = (dim >> 1) & 7;
                        const u32x2 x0 = *(const LAS u32x2*)(vb + dim * 128 + (((2 * s) ^ sw) * 16) + 8 * hi);
                        const u32x2 x1 = *(const LAS u32x2*)(vb + dim * 128 + (((2 * s + 1) ^ sw) * 16) + 8 * hi);
                        const bf16x8 va = __builtin_bit_cast(bf16x8, ((u32x4){x0.x, x0.y, x1.x, x1.y}));
                        if (blk == 0) O0 = __builtin_amdgcn_mfma_f32_32x32x16_bf16(va, pb, O0, 0, 0, 0);
                        else O1 = __builtin_amdgcn_mfma_f32_32x32x16_bf16(va, pb, O1, 0, 0, 0);
                    }
                }
            }
            if (more) { *(LAS u32x4*)(F.lds + P5_KBUF + (cur ^ 8192) + ldsK) = kn_; *(LAS u32x4*)(F.lds + P5_VBUF + (cur ^ 8192) + ldsK) = vn_; }
            __syncthreads();
        }
        lsum += __shfl_xor(lsum, 32);
        const float inv = 1.f / lsum;
        LAS bf16_t* stg = (LAS bf16_t*)(F.lds + P5_STG) + w * (32 * 72);
#pragma unroll
        for (int r2 = 0; r2 < 16; ++r2) { const int dim = crow32(r2, hi);
            stg[q32 * 72 + dim] = (bf16_t)f2bf(O0[r2] * inv); stg[q32 * 72 + dim + 32] = (bf16_t)f2bf(O1[r2] * inv); }
        LDS_WAIT(); asm volatile("" ::: "memory");
#pragma unroll
        for (int i = 0; i < 4; ++i) { const int row = i * 8 + (lane >> 3), ch = lane & 7;
            const u32x4 v = *(const LAS u32x4*)(stg + row * 72 + ch * 8);
            *(u32x4*)(AO + (size_t)(b * SEQ + t0 + 32 * (w & 1) + row) * AW + h * 64 + ch * 8) = v; }
    }
}
namespace pg8 {
template <bool ADD> struct EpiGate {
    static constexpr bool PERM = true;
    const bf16_t* G; int ldg; bf16_t* O;
    __device__ __forceinline__ void operator()(const f32x4 (&acc)[2][2][4][2], const Unit& u, int wr, int wc, int fr, int fq) const {
        const int row0 = u.row0 + wr * 64 + fr; const int col0 = u.pn * BM + wc * 32 + 8 * fq;
#pragma unroll
        for (int ai = 0; ai < 2; ++ai)
#pragma unroll
            for (int m = 0; m < 4; ++m) { const size_t row = (size_t)(row0 + ai * HALF + m * 16);
#pragma unroll
                for (int bj = 0; bj < 2; ++bj) { const f32x4 v0 = acc[ai][bj][m][0], v1 = acc[ai][bj][m][1];
                    const u32x4 g = *(const u32x4*)(G + row * ldg + col0 + bj * HALF);
                    float r[8] = {v0[0] * sigmoid_f(bf_lo(g.x)), v0[1] * sigmoid_f(bf_hi(g.x)), v0[2] * sigmoid_f(bf_lo(g.y)), v0[3] * sigmoid_f(bf_hi(g.y)),
                                  v1[0] * sigmoid_f(bf_lo(g.z)), v1[1] * sigmoid_f(bf_hi(g.z)), v1[2] * sigmoid_f(bf_lo(g.w)), v1[3] * sigmoid_f(bf_hi(g.w))};
                    bf16_t* op = O + row * D + col0 + bj * HALF;
                    if (ADD) { const u32x4 o = *(const u32x4*)op;
                        r[0] += bf_lo(o.x); r[1] += bf_hi(o.x); r[2] += bf_lo(o.y); r[3] += bf_hi(o.y); r[4] += bf_lo(o.z); r[5] += bf_hi(o.z); r[6] += bf_lo(o.w); r[7] += bf_hi(o.w); }
                    u32x4 w; w.x = cvt_pk_bf16(r[0], r[1]); w.y = cvt_pk_bf16(r[2], r[3]); w.z = cvt_pk_bf16(r[4], r[5]); w.w = cvt_pk_bf16(r[6], r[7]);
                    *(u32x4*)op = w; } }
    }
};
struct EpiX1 {
    static constexpr bool PERM = false;
    const float* X; const float* gate; float* O;
    __device__ __forceinline__ void operator()(const f32x4 (&acc)[2][2][4][2], const Unit& u, int wr, int wc, int fr, int fq) const {
        const int row0 = u.row0 + wr * 64 + fr; const int col0 = u.pn * BM + wc * 32 + 4 * fq; const float* gp = gate + (size_t)(u.row0 / SEQ) * 6 * D;
#pragma unroll
        for (int bj = 0; bj < 2; ++bj)
#pragma unroll
            for (int n = 0; n < 2; ++n) { const int c = col0 + bj * HALF + n * 16; const f32x4 gv = *(const f32x4*)(gp + c);
#pragma unroll
                for (int ai = 0; ai < 2; ++ai)
#pragma unroll
                    for (int m = 0; m < 4; ++m) { const size_t off = (size_t)(row0 + ai * HALF + m * 16) * D + c;
                        const f32x4 xv = *(const f32x4*)(X + off); *(f32x4*)(O + off) = xv + gv * acc[ai][bj][m][n]; } }
    }
};
struct EpiRouter {
    static constexpr bool PERM = false;
    float* O;
    __device__ __forceinline__ void operator()(const f32x4 (&acc)[2][2][4][2], const Unit& u, int wr, int wc, int fr, int fq) const {
        const int row0 = u.row0 + wr * 64 + fr; const int ncols = u.e ? 64 : 128, coff = u.e ? 128 : 0;
#pragma unroll
        for (int n = 0; n < 2; ++n) { const int c = wc * 32 + n * 16 + 4 * fq;
            if (c < ncols) {
#pragma unroll
                for (int ai = 0; ai < 2; ++ai)
#pragma unroll
                    for (int m = 0; m < 4; ++m) *(f32x4*)(O + (size_t)(row0 + ai * HALF + m * 16) * 192 + coff + c) = acc[ai][0][m][n]; } }
    }
};
struct EpiSwiglu {
    static constexpr bool PERM = true;
    bf16_t* O;
    __device__ __forceinline__ void operator()(const f32x4 (&acc)[2][2][4][2], const Unit& u, int wr, int wc, int fr, int fq) const {
        const int row0 = u.row0 + wr * 64 + fr; const int col0 = u.pn * HALF + wc * 32 + 8 * fq;
#pragma unroll
        for (int ai = 0; ai < 2; ++ai)
#pragma unroll
            for (int m = 0; m < 4; ++m) { const f32x4 a0 = acc[ai][0][m][0], a1 = acc[ai][0][m][1], b0 = acc[ai][1][m][0], b1 = acc[ai][1][m][1];
                u32x4 w; w.x = cvt_pk_bf16(silu_f(a0[0]) * b0[0], silu_f(a0[1]) * b0[1]); w.y = cvt_pk_bf16(silu_f(a0[2]) * b0[2], silu_f(a0[3]) * b0[3]);
                w.z = cvt_pk_bf16(silu_f(a1[0]) * b1[0], silu_f(a1[1]) * b1[1]); w.w = cvt_pk_bf16(silu_f(a1[2]) * b1[2], silu_f(a1[3]) * b1[3]);
                *(u32x4*)(O + (size_t)(row0 + ai * HALF + m * 16) * DE + col0) = w; }
    }
};
struct RouterOrder {
    const char* Ahi; const char* Alo; const char* Bx; const char* By; int G, c;
    __device__ __forceinline__ bool next(int i, Unit& u) const {
        const int L = i * G + c; if (L >= 128) return false;
        u.e = L >> 6; u.pm = L & 63; u.pn = 0; u.row0 = u.pm * BM;
        u.A = (u.e ? Alo : Ahi) + (size_t)u.pm * BM * D * 2; u.B = u.e ? By : Bx; return true;
    }
    __device__ __forceinline__ const LAS int* list(int) const { return nullptr; }
};
struct MoeOrder {
    const char* A; const char* W; const LAS int* tstart; const LAS int* lists; int G, c, npn_shift, a_tile_bytes; size_t w_exp_bytes, w_tile_bytes;
    __device__ __forceinline__ bool next(int i, Unit& u) const {
        const int L = i * G + c; const int tile = L >> npn_shift; if (tile >= tstart[65]) return false;
        int e = 0;
#pragma unroll 1
        for (int step = 32; step > 0; step >>= 1) if (e + step <= 64 && tstart[e + step] <= tile) e += step;
        if (e < 64 && tstart[e + 1] <= tile) e += 1;
        u.e = e; u.pm = tile; u.pn = L & ((1 << npn_shift) - 1); u.row0 = tile * BM;
        u.A = A + (size_t)tile * a_tile_bytes; u.B = W + (size_t)e * w_exp_bytes + (size_t)u.pn * w_tile_bytes; return true;
    }
    __device__ __forceinline__ const LAS int* list(int i) const { return lists + i * 256; }
};
}

__device__ __forceinline__ void p8_norm2(const Frame& F) {
    LAS float* sh = (LAS float*)F.lds; LAS float* sc = sh + D;
    const float* MOD = (const float*)(F.ws + WS_MOD);
    for (int blk = F.bid; blk < NTOK / 64; blk += F.G) {
        const int b = blk / (SEQ / 64);
        __syncthreads();
        for (int i = F.tid; i < D; i += NTHREADS) { sh[i] = MOD[b * 6 * D + 3 * D + i]; sc[i] = (1.f + MOD[b * 6 * D + 4 * D + i]) * F.in[4][i]; }
        __syncthreads();
        for (int j = 0; j < 8; ++j) {
            const int t = blk * 64 + F.wave * 8 + j;
            const f32x4* xr = (const f32x4*)(F.out + (size_t)t * D) + F.lane;
            f32x4 v[8]; float s = 0.f;
#pragma unroll
            for (int q = 0; q < 8; ++q) { v[q] = xr[64 * q]; s += (v[q].x * v[q].x + v[q].y * v[q].y) + (v[q].z * v[q].z + v[q].w * v[q].w); }
            const float r = rsqrtf(wave_sum(s) * (1.f / D) + EPS);
            u32x2* oh = (u32x2*)((bf16_t*)(F.ws + WS_HB) + (size_t)t * D) + F.lane;
            u32x2* ol = (u32x2*)((bf16_t*)(F.ws + WS_HLO) + (size_t)t * D) + F.lane;
#pragma unroll
            for (int q = 0; q < 8; ++q) { const int c0 = 4 * F.lane + 256 * q;
                const f32x4 a = *(const LAS f32x4*)(sc + c0), bb = *(const LAS f32x4*)(sh + c0);
                const float y0 = v[q].x * r * a.x + bb.x, y1 = v[q].y * r * a.y + bb.y, y2 = v[q].z * r * a.z + bb.z, y3 = v[q].w * r * a.w + bb.w;
                u32x2 wh; wh.x = pk2(y0, y1); wh.y = pk2(y2, y3);
                u32x2 wl; wl.x = pk2(y0 - bf_lo(wh.x), y1 - bf_hi(wh.x)); wl.y = pk2(y2 - bf_lo(wh.y), y3 - bf_hi(wh.y));
                oh[64 * q] = wh; ol[64 * q] = wl; }
        }
    }
}

__device__ __forceinline__ void p10a_route(const Frame& F) {
    const float* RLOG = (const float*)(F.ws + WS_RLOG); const float* rbias = F.in[17];
    int* TOKE = (int*)(F.ws + WS_TOKE); float* TOKW = (float*)(F.ws + WS_TOKW); int* TOKRANK = (int*)(F.ws + WS_TOKRANK); int* BLKBASE = (int*)(F.ws + WS_BLKBASE);
    LAS int* hist = (LAS int*)F.lds;
    const int e = F.lane; const float rb = rbias[e];
    for (int blk = F.bid; blk < NTOK / 64; blk += F.G) {
        __syncthreads();
        if (F.tid < 64) hist[F.tid] = 0;
        __syncthreads();
        for (int j = 0; j < 8; ++j) {
            const int t = blk * 64 + F.wave * 8 + j;
            const float* rl = RLOG + (size_t)t * 192;
            const float logit = rl[e] + rl[64 + e] + rl[128 + e];
            const float s = 1.f / (1.f + expf(-logit)), sel = s + rb;
            float m1 = sel;
            m1 = fmaxf(m1, __shfl_xor(m1, 1)); m1 = fmaxf(m1, __shfl_xor(m1, 2)); m1 = fmaxf(m1, __shfl_xor(m1, 4));
            const unsigned long long ismax = __ballot(sel == m1);
            const int firstmax = __ffsll((long long)((ismax >> (e & ~7)) & 0xffull)) - 1 + (e & ~7);
            float m2 = (e == firstmax) ? -3.0e38f : sel;
            m2 = fmaxf(m2, __shfl_xor(m2, 1)); m2 = fmaxf(m2, __shfl_xor(m2, 2)); m2 = fmaxf(m2, __shfl_xor(m2, 4));
            const float gs = m1 + m2; const int g = e >> 3;
            int grank = 0;
#pragma unroll
            for (int g2 = 0; g2 < 8; ++g2) { const float o = __shfl(gs, g2 * 8); grank += (o > gs || (o == gs && g2 < g)) ? 1 : 0; }
            const float cand = grank < 4 ? sel : -1.0e30f;
            int rank = 0;
#pragma unroll
            for (int e2 = 0; e2 < 64; ++e2) { const float o = __shfl(cand, e2); rank += (o > cand || (o == cand && e2 < e)) ? 1 : 0; }
            const bool chosen = rank < 8;
            const float wsum = wave_sum(chosen ? s : 0.f);
            if (chosen) {
                const int lr = __hip_atomic_fetch_add(&hist[e], 1, __ATOMIC_RELAXED, __HIP_MEMORY_SCOPE_WORKGROUP);
                TOKE[t * 8 + rank] = e; TOKW[t * 8 + rank] = s / wsum * 2.5f; TOKRANK[t * 8 + rank] = lr;
            }
        }
        __syncthreads();
        if (F.tid < 64) { const int base = (int)atomicAdd(F.ctl + CW_CNT + F.tid, (unsigned)hist[F.tid]); BLKBASE[blk * 64 + F.tid] = base; }
    }
}
__device__ __forceinline__ void moe_tile_table(const Frame& F, LAS int* tst) {
    __syncthreads();
    if (F.tid == 0) { int o = 0; for (int e = 0; e < 64; ++e) { tst[e] = o; o += ((int)F.ctl[CW_CNT + e] + 255) >> 8; } tst[64] = o; tst[65] = o + NTOK / 256; }
    __syncthreads();
}
__device__ __forceinline__ void p10b_lists(const Frame& F) {
    const int* TOKE = (const int*)(F.ws + WS_TOKE); const int* TOKRANK = (const int*)(F.ws + WS_TOKRANK); const int* BLKBASE = (const int*)(F.ws + WS_BLKBASE);
    int* TOKPOS = (int*)(F.ws + WS_TOKPOS); int* SRT = (int*)(F.ws + WS_SRT);
    LAS int* tst = (LAS int*)F.lds;
    moe_tile_table(F, tst);
    for (int blk = F.bid; blk < NTOK / 64; blk += F.G) {
        { const int i = blk * 512 + F.tid;
          const int e = TOKE[i], pos = tst[e] * 256 + BLKBASE[blk * 64 + e] + TOKRANK[i];
          SRT[pos] = i >> 3; TOKPOS[i] = pos; }
        if (F.tid < 64) SRT[tst[64] * 256 + blk * 64 + F.tid] = blk * 64 + F.tid;
    }
    for (int e = F.bid; e < 64; e += F.G) {
        const int lo = tst[e] * 256 + (int)F.ctl[CW_CNT + e], hi = tst[e + 1] * 256;
        for (int p = lo + F.tid; p < hi; p += NTHREADS) SRT[p] = 0;
    }
}
__device__ __forceinline__ void p13_combine(const Frame& F) {
    const bf16_t* YB = (const bf16_t*)(F.ws + WS_YB); const int* TOKPOS = (const int*)(F.ws + WS_TOKPOS); const float* TOKW = (const float*)(F.ws + WS_TOKW);
    const float* MOD = (const float*)(F.ws + WS_MOD);
    LAS int* tst = (LAS int*)F.lds;
    moe_tile_table(F, tst);
    const int sh0 = tst[64] * 256;
    const int gw = F.bid * NWAVES + F.wave, NGW = F.G * NWAVES;
    for (int t = gw; t < NTOK; t += NGW) {
        const int b = t / SEQ;
        int pos[9]; float wk[9];
#pragma unroll
        for (int k = 0; k < 8; ++k) { pos[k] = TOKPOS[t * 8 + k]; wk[k] = TOKW[t * 8 + k]; }
        pos[8] = sh0 + t; wk[8] = 1.f;
        float* orow = F.out + (size_t)t * D; const float* g2 = MOD + (size_t)b * 6 * D + 5 * D;
#pragma unroll 2
        for (int q = 0; q < 8; ++q) { const int c = 4 * F.lane + 256 * q;
            float a0 = 0.f, a1 = 0.f, a2 = 0.f, a3 = 0.f;
#pragma unroll
            for (int k = 0; k < 9; ++k) { const u32x2 y = *(const u32x2*)(YB + (size_t)pos[k] * D + c);
                a0 += wk[k] * bf_lo(y.x); a1 += wk[k] * bf_hi(y.x); a2 += wk[k] * bf_lo(y.y); a3 += wk[k] * bf_hi(y.y); }
            const f32x4 xv = *(const f32x4*)(orow + c), gv = *(const f32x4*)(g2 + c);
            *(f32x4*)(orow + c) = (f32x4){xv.x + gv.x * a0, xv.y + gv.y * a1, xv.z + gv.z * a2, xv.w + gv.w * a3}; }
    }
}
constexpr int N_PHASES = 16;
__global__ void __launch_bounds__(NTHREADS, 2) mk_fwd(Args args) {
    extern __shared__ __attribute__((aligned(16))) unsigned char lds_raw[];
    Frame F;
    F.lds = (LAS unsigned char*)lds_raw; F.ws = args.ws; F.ctl = (unsigned*)(args.ws + WS_CTL); F.in = args.in; F.out = args.out;
    F.tid = threadIdx.x; F.lane = F.tid & 63; F.wave = __builtin_amdgcn_readfirstlane(F.tid >> 6); F.G = gridDim.x; F.bid = blockIdx.x;
    volatile LAS unsigned* MISC = (volatile LAS unsigned*)(F.lds + MISC_OFF);
    if (F.tid < 64) MISC[F.tid] = 0u;
    __syncthreads();
    const int lo = args.ph_lo, hi = args.ph_hi;
    const bool need_bar = (hi - lo) > 1;
    XcdBarrier bar; bar.bar = F.ctl + CW_BAR + args.bar_region * XCD_BAR_WORDS; bar.x = 0; bar.st = MISC + 8;
    if (need_bar) bar = xcd_barrier_post(F.ctl + CW_BAR + args.bar_region * XCD_BAR_WORDS, MISC + 8);
#define IN(k) (lo <= (k) && (k) < hi)
#define SEAM(k) do { if (IN(k) && IN((k) + 1)) xcd_barrier(bar); } while (0)

    if (IN(0)) { p0_prologue(F); } SEAM(0);
    if (IN(1)) { p1_norm1(F); } SEAM(1);
    if (IN(2)) {
        pg8::PlainOrder S; S.init(F.ws + WS_HB, F.ws + WS_WINT, NTOK, TOTP, D, F.G, F.bid);
        pg8::EpiBf16 E{(bf16_t*)(F.ws + WS_PROJ), TOTP};
        pg8::gemm_phase<pg8::EpiBf16, pg8::PlainOrder, false>(F.lds, D, S, E);
    } SEAM(2);
    if (IN(3)) { p3_mix(F); } SEAM(3);
    if (IN(4)) { p4_index(F); } SEAM(4);
    if (IN(5)) { p5_attn(F); } SEAM(5);
    if (IN(6)) {
        pg8::PlainOrder S; S.init(F.ws + WS_UMIX, F.ws + WS_WCVT, NTOK, D, CW, F.G, F.bid);
        pg8::EpiGate<false> E{(const bf16_t*)(F.ws + WS_PROJ) + O_GA, TOTP, (bf16_t*)(F.ws + WS_HB)};
        pg8::gemm_phase<pg8::EpiGate<false>, pg8::PlainOrder, false>(F.lds, CW, S, E);
    } SEAM(6);
    if (IN(7)) {
        pg8::PlainOrder S; S.init(F.ws + WS_AO, F.ws + WS_WATT, NTOK, D, AW, F.G, F.bid);
        pg8::EpiGate<true> E{(const bf16_t*)(F.ws + WS_PROJ) + O_GB, TOTP, (bf16_t*)(F.ws + WS_HB)};
        pg8::gemm_phase<pg8::EpiGate<true>, pg8::PlainOrder, false>(F.lds, AW, S, E);
    } SEAM(7);
    if (IN(8)) {
        pg8::PlainOrder S; S.init(F.ws + WS_HB, F.ws + WS_WOT, NTOK, D, D, F.G, F.bid);
        pg8::EpiX1 E{F.in[0], (const float*)(F.ws + WS_MOD) + 2 * D, F.out};
        pg8::gemm_phase<pg8::EpiX1, pg8::PlainOrder, false>(F.lds, D, S, E);
    } SEAM(8);
    if (IN(9)) { p8_norm2(F); } SEAM(9);
    if (IN(10)) {
        pg8::RouterOrder S{(const char*)(F.ws + WS_HB), (const char*)(F.ws + WS_HLO), (const char*)(F.ws + WS_WRX), (const char*)(F.ws + WS_WRY), F.G, F.bid};
        pg8::EpiRouter E{(float*)(F.ws + WS_RLOG)};
        pg8::gemm_phase<pg8::EpiRouter, pg8::RouterOrder, false>(F.lds, D, S, E);
    } SEAM(10);
    if (IN(11)) { p10a_route(F); } SEAM(11);
    if (IN(12)) { p10b_lists(F); } SEAM(12);
    if (IN(13)) {
        LAS int* tst = (LAS int*)(F.lds + LIST_OFF + 11264); LAS int* lists = (LAS int*)(F.lds + LIST_OFF);
        moe_tile_table(F, tst);
        const int* SRT = (const int*)(F.ws + WS_SRT);
        for (int i = 0; i < 11; ++i) { const int tile = (i * F.G + F.bid) >> 2; if (tile >= tst[65]) break; if (F.tid < 256) lists[i * 256 + F.tid] = SRT[tile * 256 + F.tid]; }
        __syncthreads();
        pg8::MoeOrder S{(const char*)(F.ws + WS_HB), (const char*)(F.ws + WS_W13T), tst, lists, F.G, F.bid, 2, 0, (size_t)1024 * D * 2, (size_t)256 * D * 2};
        pg8::EpiSwiglu E{(bf16_t*)(F.ws + WS_HH)};
        pg8::gemm_phase<pg8::EpiSwiglu, pg8::MoeOrder, true>(F.lds, D, S, E);
    } SEAM(13);
    if (IN(14)) {
        LAS int* tst = (LAS int*)(F.lds + LIST_OFF + 11264);
        moe_tile_table(F, tst);
        pg8::MoeOrder S{(const char*)(F.ws + WS_HH), (const char*)(F.ws + WS_W2T), tst, nullptr, F.G, F.bid, 3, 256 * DE * 2, (size_t)D * DE * 2, (size_t)256 * DE * 2};
        pg8::EpiBf16 E{(bf16_t*)(F.ws + WS_YB), D};
        pg8::gemm_phase<pg8::EpiBf16, pg8::MoeOrder, false>(F.lds, DE, S, E);
    } SEAM(14);
    if (IN(15)) { p13_combine(F); }
#undef IN
#undef SEAM
}

static int g_grid = 0;
static bool mk_setup(size_t ws_size) {
    if (g_grid == 0) {
        if (ws_size < WS_END) { fprintf(stderr, "kernel_launch: workspace too small: %zu < %zu\n", ws_size, (size_t)WS_END); g_grid = -1; return false; }
        int dev = 0, cus = 0, per_cu = 0;
        if (hipGetDevice(&dev) != hipSuccess || hipDeviceGetAttribute(&cus, hipDeviceAttributeMultiprocessorCount, dev) != hipSuccess) { g_grid = -1; return false; }
        if (hipFuncSetAttribute((const void*)mk_fwd, hipFuncAttributeMaxDynamicSharedMemorySize, LDS_BYTES) != hipSuccess) { fprintf(stderr, "kernel_launch: hipFuncSetAttribute failed\n"); g_grid = -1; return false; }
        if (hipOccupancyMaxActiveBlocksPerMultiprocessor(&per_cu, (const void*)mk_fwd, NTHREADS, LDS_BYTES) != hipSuccess || per_cu < 1) { fprintf(stderr, "kernel_launch: occupancy query says %d\n", per_cu); }
        (void)hipGetLastError();
        g_grid = cus;
    }
    return g_grid > 0;
}
static void mk_launch(const Args& a0, int lo, int hi, int region, hipStream_t stream) {
    Args a = a0; a.ph_lo = lo; a.ph_hi = hi; a.bar_region = region;
    hipLaunchKernelGGL(mk_fwd, dim3(g_grid), dim3(NTHREADS), LDS_BYTES, stream, a);
}
#ifndef MK_N_LAUNCHES
#define MK_N_LAUNCHES 1
#endif
extern "C" void kernel_launch(void* const* d_in, const int* in_sizes, int n_in, void* d_out, int out_size, void* d_ws, size_t ws_size, hipStream_t stream) {
    if (!mk_setup(ws_size)) return;
    (void)hipMemsetAsync((char*)d_ws + WS_CTL, 0, CTL_ZERO_BYTES, stream);
    Args a{};
    for (int i = 0; i < 24; ++i) a.in[i] = (const float*)d_in[i];
    a.out = (float*)d_out; a.ws = (unsigned char*)d_ws;
    if (MK_N_LAUNCHES == 1) mk_launch(a, 0, N_PHASES, 0, stream);
    else for (int p = 0; p < N_PHASES; ++p) mk_launch(a, p, p + 1, 0, stream);
}
```

```cpp
#include <hip/hip_runtime.h>
#define CVT_OVERLAP 1
#ifndef P2_NU
#define P2_NU 0x679AABCDull
#endif
#ifndef P2_CV
#define P2_CV 0xA9644210ull
#endif
#define P2_CVSUM (((P2_CV >> 0) & 15) + ((P2_CV >> 4) & 15) + ((P2_CV >> 8) & 15) + ((P2_CV >> 12) & 15) + ((P2_CV >> 16) & 15) + ((P2_CV >> 20) & 15) + ((P2_CV >> 24) & 15) + ((P2_CV >> 28) & 15))
#ifndef CVT_UG
#define CVT_UG 13
#endif
#ifndef CVT_NG2
#define CVT_NG2 216
#endif
#ifndef CVT_SPLIT
#define CVT_SPLIT 47000
#endif
#ifndef CVT_NG
#define CVT_NG 192
#endif
#include <cstdint>
#include <cstdio>

#define LAS __attribute__((address_space(3)))
#define GAS __attribute__((address_space(1)))
typedef unsigned short bf16_t;
typedef short bf16x8 __attribute__((ext_vector_type(8)));
typedef short bf16x4 __attribute__((ext_vector_type(4)));
typedef float f32x2 __attribute__((ext_vector_type(2)));
typedef float f32x4 __attribute__((ext_vector_type(4)));
typedef float f32x16 __attribute__((ext_vector_type(16)));
typedef unsigned u32x2 __attribute__((ext_vector_type(2)));
typedef unsigned u32x4 __attribute__((ext_vector_type(4)));

constexpr int D = 2048, BATCH = 4, SEQ = 4096, NTOK = BATCH * SEQ;
constexpr int CW = 1024, NH = 16, NKV = 4, HD = 64, AW = 1024, KVW = 256, IH = 16, IDIM = 64, NSEL = 256;
constexpr int NE = 64, TOPK = 8, DE = 512;
constexpr int TOT = 9808, TOTP = 9984;
constexpr int O_CB = 0, O_CC = 1024, O_CU = 2048, O_Q = 3072, O_K = 4096, O_V = 4352, O_QI = 4608, O_KI = 5632, O_WI = 5696, O_GA = 5712, O_GB = 7760;
constexpr float EPS = 1e-6f;
constexpr int MAXPOS = NTOK * 8 + NE * 256 + NTOK;
constexpr int SH_POS0 = NTOK * 8 + NE * 256;

__device__ __forceinline__ unsigned f2bf(float f) { unsigned u = __builtin_bit_cast(unsigned, f); return (u + 0x7fffu + ((u >> 16) & 1u)) >> 16; }
__device__ __forceinline__ unsigned pk2(float lo, float hi) { return f2bf(lo) | (f2bf(hi) << 16); }
typedef __bf16 bf16x2_hw __attribute__((ext_vector_type(2)));
__device__ __forceinline__ unsigned cvt_pk_bf16(float lo, float hi) { const f32x2 v = {lo, hi}; const bf16x2_hw b = __builtin_convertvector(v, bf16x2_hw); return __builtin_bit_cast(unsigned, b); }
__device__ __forceinline__ float bf_lo(unsigned w) { return __builtin_bit_cast(float, w << 16); }
__device__ __forceinline__ float bf_hi(unsigned w) { return __builtin_bit_cast(float, w & 0xffff0000u); }
__device__ __forceinline__ float bf2f(bf16_t h) { return __builtin_bit_cast(float, (unsigned)h << 16); }
__device__ __forceinline__ float sigmoid_f(float x) { return __builtin_amdgcn_rcpf(1.f + __expf(-x)); }
__device__ __forceinline__ float silu_f(float x) { return x * __builtin_amdgcn_rcpf(1.f + __expf(-x)); }
__device__ __forceinline__ float wave_sum(float v) {
#pragma unroll
    for (int o = 1; o < 64; o <<= 1) v += __shfl_xor(v, o);
    return v;
}
#ifndef EPI_PLAIN_STORES
#define EPI_ST16(ptr_, v_) asm volatile("global_store_dwordx4 %0, %1, off sc1" :: "v"(ptr_), "v"(v_) : "memory")
#else
#define EPI_ST16(ptr_, v_) (*(u32x4*)(ptr_) = (v_))
#endif
#define LDS_WAIT() asm volatile("s_waitcnt lgkmcnt(0)" ::: "memory")
#define VM_WAIT() asm volatile("s_waitcnt vmcnt(0)" ::: "memory")

#define XB_TMO      128
#define XB_XCNT(j)  (256  + 64 * (j))
#define XB_XSUB(j)  (1280 + 64 * (j))
#define XB_XGEN(j)  (2304 + 64 * (j))
#define XB_TOP      3328
#define XB_TOPGEN   3392
#define XCD_BAR_WORDS 3456
#define XB_SPIN_CAP (1u << 22)

__device__ __forceinline__ unsigned xb_ld(unsigned* p)              { return __hip_atomic_load(p, __ATOMIC_RELAXED, __HIP_MEMORY_SCOPE_AGENT); }
__device__ __forceinline__ unsigned xb_add(unsigned* p, unsigned v) { return __hip_atomic_fetch_add(p, v, __ATOMIC_RELAXED, __HIP_MEMORY_SCOPE_AGENT); }
__device__ __forceinline__ unsigned xb_xcc_id() { return (unsigned)__builtin_amdgcn_s_getreg((3 << 11) | 20) & 0xFu; }
#define XB_SPIN(cond, bar) do { unsigned _sp = 0; while (cond) { __builtin_amdgcn_s_sleep(1); \
    if ((++_sp & 255u) == 0u) { if (xb_ld(&(bar)[XB_TMO])) break; if (_sp > XB_SPIN_CAP) { atomicAdd(&(bar)[XB_TMO], 1u); break; } } } } while (0)

struct XcdBarrier { unsigned* bar; unsigned x; volatile LAS unsigned* st; };

__device__ __forceinline__ XcdBarrier xcd_barrier_post(unsigned* bar, volatile LAS unsigned* st) {
    XcdBarrier b; b.bar = bar; b.x = xb_xcc_id(); b.st = st;
    if (threadIdx.x == 0) (void)xb_add(&bar[XB_XCNT(b.x)], 1u);
    return b;
}
__device__ __forceinline__ void xcd_barrier_complete(unsigned* bar, unsigned x, unsigned& nloc, unsigned& nx) {
    const unsigned G = gridDim.x * gridDim.y * gridDim.z;
    unsigned sum, cnt, mine, sp = 0u;
    for (;;) {
        sum = 0u; cnt = 0u; mine = 0u;
#pragma unroll
        for (unsigned j = 0; j < 16; ++j) { const unsigned c = xb_ld(&bar[XB_XCNT(j)]); sum += c; cnt += (c > 0u) ? 1u : 0u; mine = (j == x) ? c : mine; }
        if (sum == G) break;
        __builtin_amdgcn_s_sleep(1);
        if ((++sp & 255u) == 0u) { if (xb_ld(&bar[XB_TMO])) break; if (sp > XB_SPIN_CAP) { atomicAdd(&bar[XB_TMO], 1u); break; } }
    }
    nloc = mine > 0u ? mine : 1u; nx = cnt > 0u ? cnt : 1u;
}
__device__ __forceinline__ void xcd_barrier(const XcdBarrier& b) {
    asm volatile("s_waitcnt vmcnt(0)" ::: "memory");
    __syncthreads();
    if (threadIdx.x == 0) {
        unsigned* bar = b.bar;
        __builtin_amdgcn_s_waitcnt(0);
        unsigned nloc = b.st[0], nx = b.st[1];
        if (nloc == 0u) { xcd_barrier_complete(bar, b.x, nloc, nx); b.st[0] = nloc; b.st[1] = nx; }
        const unsigned old = xb_add(&bar[XB_XSUB(b.x)], 1u);
        const unsigned gen = old / nloc;
        if (old + 1u == (gen + 1u) * nloc) {
            __builtin_amdgcn_fence(__ATOMIC_RELEASE, "agent");
            asm volatile("s_waitcnt vmcnt(0)" ::: "memory");
            const unsigned og = xb_add(&bar[XB_TOP], 1u);
            const unsigned tg = og / nx;
            if (og + 1u == (tg + 1u) * nx) xb_add(&bar[XB_TOPGEN], 1u);
            else XB_SPIN(xb_ld(&bar[XB_TOPGEN]) == tg, bar);
            __builtin_amdgcn_fence(__ATOMIC_ACQUIRE, "agent");
            xb_add(&bar[XB_XGEN(b.x)], 1u);
            asm volatile("s_waitcnt vmcnt(0)" ::: "memory");
        } else {
            XB_SPIN(xb_ld(&bar[XB_XGEN(b.x)]) == gen, bar);
            __builtin_amdgcn_fence(__ATOMIC_ACQUIRE, "agent");
            asm volatile("s_waitcnt vmcnt(0)" ::: "memory");
        }
    }
    __syncthreads();
}

namespace pg8 {
constexpr int BM = 256, BK = 64, HALF = 128, HTB = HALF * BK * 2, STAGE_BYTES = 8 * HTB;
__host__ __device__ __forceinline__ int lds_byte(int r, int c) { const int st = (r >> 4) * 2 + (c >> 5), rr = r & 15, cc = c & 31, ob = rr * 64 + cc * 2; return st * 1024 + (ob ^ (((ob >> 9) & 1) << 5)); }
__host__ __device__ __forceinline__ void stage_rc(int b, int& R, int& C) { const int st = b / 1024, sb = b % 1024, swz = sb ^ (((sb >> 9) & 1) << 5); R = (st >> 1) * 16 + swz / 64; C = (st & 1) * 32 + (swz % 64) / 2; }
__host__ __device__ __forceinline__ int perm32(int rho) { const int n = rho >> 4, i = rho & 15; return 8 * (i >> 2) + 4 * n + (i & 3); }

struct Unit { const char* A; const char* B; int pm, pn, e, row0; };

template <class Epi, class Sched, bool GATHER>
__device__ __forceinline__ void gemm_phase(LAS unsigned char* lds, const int K, const Sched& S, const Epi& E, const int LD = 0) {
    const int tid = threadIdx.x, wid = __builtin_amdgcn_readfirstlane(tid >> 6), lane = tid & 63, wr = wid >> 2, wc = wid & 3, fr = lane & 15, fq = lane >> 4;
    const int nt = K / BK; const int PK = LD ? LD : K;
    unsigned voffA[2][2], voffB[2][2]; int RA[2], CA2[2];
#pragma unroll
    for (int i = 0; i < 2; ++i) { int R, C; stage_rc(tid * 16 + i * 8192, R, C);
        RA[i] = R; CA2[i] = C * 2;
#pragma unroll
        for (int bj = 0; bj < 2; ++bj) { const int Rb = (int)Epi::PERM == 2 ? (64 * (R >> 5) + 16 * ((R >> 2) & 3) + 8 * bj + 4 * ((R >> 4) & 1) + (R & 3))
                                                       : (int)Epi::PERM == 3 ? (64 * (R >> 5) + 32 * bj + 8 * ((R >> 2) & 3) + 4 * ((R >> 4) & 1) + (R & 3))
                                                       : ((int)Epi::PERM == 1 ? ((R & ~31) + perm32(R & 31)) : R) + bj * HALF;
            voffB[bj][i] = (unsigned)(Rb * PK + C) * 2u; }
        voffA[0][i] = (unsigned)(R * PK + C) * 2u; voffA[1][i] = (unsigned)((R + HALF) * PK + C) * 2u; }
    const size_t kstep = (size_t)(BK * 2);
    const unsigned ldsw = (unsigned)wid * 1024u;
    const int aoff = lds_byte(wr * 64 + fr, fq * 8), boff = lds_byte(wc * 32 + fr, fq * 8);
#define PG8_SA(b, h) (((b) * 2 + (h)) * HTB)
#define PG8_SB(b, h) ((4 + (b) * 2 + (h)) * HTB)
#define PG8_STAGE(bufoff, gbase, voff) do { _Pragma("unroll") for (int _i = 0; _i < 2; ++_i) \
        __builtin_amdgcn_global_load_lds((const unsigned*)((const char*)(gbase) + (voff)[_i]), (LAS unsigned*)(lds + (bufoff) + ldsw + _i * 8192), 16, 0, 0); } while (0)
#define PG8_LDA(dst, b, h) do { _Pragma("unroll") for (int m = 0; m < 4; ++m) _Pragma("unroll") for (int k = 0; k < 2; ++k) dst[m][k] = *(const LAS bf16x8*)(lds + PG8_SA(b, h) + aoff + m * 2048 + k * 1024); } while (0)
#define PG8_LDB(dst, b, h) do { _Pragma("unroll") for (int n = 0; n < 2; ++n) _Pragma("unroll") for (int k = 0; k < 2; ++k) dst[n][k] = *(const LAS bf16x8*)(lds + PG8_SB(b, h) + boff + n * 2048 + k * 1024); } while (0)
#define PG8_MMA(ai, bj, At, Bt) do { __builtin_amdgcn_s_setprio(1); _Pragma("unroll") for (int m = 0; m < 4; ++m) _Pragma("unroll") for (int n = 0; n < 2; ++n) _Pragma("unroll") for (int k = 0; k < 2; ++k) \
        acc[ai][bj][m][n] = __builtin_amdgcn_mfma_f32_16x16x32_bf16(Bt[n][k], At[m][k], acc[ai][bj][m][n], 0, 0, 0); __builtin_amdgcn_s_setprio(0); } while (0)
#define PG8_WAIT_V(n) asm volatile("s_waitcnt vmcnt(" #n ")" ::: "memory")
#define PG8_WAIT_L(n) asm volatile("s_waitcnt lgkmcnt(" #n ")" ::: "memory")
#define PG8_BAR __builtin_amdgcn_s_barrier()
#define PG8_SCHED __builtin_amdgcn_sched_barrier(0)
#define PG8_GLIST(ui_) do { if constexpr (GATHER) { const LAS int* L_ = S.list(ui_); _Pragma("unroll") for (int h_ = 0; h_ < 2; ++h_) _Pragma("unroll") for (int i_ = 0; i_ < 2; ++i_) \
        voffA[h_][i_] = (unsigned)L_[h_ * HALF + RA[i_]] * (unsigned)(PK * 2) + (unsigned)CA2[i_]; } } while (0)
    Unit cur, nxt; int ui = 0;
    PG8_WAIT_V(0); __syncthreads();
    if (!S.next(0, cur)) return;
    S.a_ready(cur);
    Unit prevu = cur; bool have_prev = false;
    PG8_GLIST(0);
    f32x4 acc[2][2][4][2];
#pragma unroll
    for (int a = 0; a < 2; ++a)
#pragma unroll
        for (int b = 0; b < 2; ++b)
#pragma unroll
            for (int m = 0; m < 4; ++m)
#pragma unroll
                for (int n = 0; n < 2; ++n) acc[a][b][m][n] = (f32x4){0.f, 0.f, 0.f, 0.f};
    bf16x8 At[4][2], B0[2][2], B1[2][2];
    const char* cA = cur.A; const char* cB = cur.B;
    PG8_STAGE(PG8_SB(0, 0), cB, voffB[0]); PG8_STAGE(PG8_SB(0, 1), cB, voffB[1]); PG8_STAGE(PG8_SA(0, 0), cA, voffA[0]); PG8_STAGE(PG8_SA(0, 1), cA, voffA[1]);
    if (wr == 1) PG8_BAR;
    PG8_WAIT_V(2); PG8_BAR;
    PG8_STAGE(PG8_SB(1, 0), cB + kstep, voffB[0]); PG8_STAGE(PG8_SA(1, 0), cA + kstep, voffA[0]); PG8_STAGE(PG8_SB(1, 1), cB + kstep, voffB[1]);
    PG8_WAIT_V(6); PG8_BAR;
    for (;;) {
        const bool has_next = S.next(ui + 1, nxt);
        const char* nA = has_next ? nxt.A : cA; const char* nB = has_next ? nxt.B : cB;
#ifndef KREP
#define KREP 1
#endif
        const int krep_ = S.krep > 1 ? S.krep : KREP;
#pragma unroll 1
        for (int kr_ = 0; kr_ < krep_; ++kr_) {
        if (kr_) {
#pragma unroll
            for (int a = 0; a < 2; ++a)
#pragma unroll
                for (int b = 0; b < 2; ++b)
#pragma unroll
                    for (int m = 0; m < 4; ++m)
#pragma unroll
                        for (int n = 0; n < 2; ++n) acc[a][b][m][n] = (f32x4){0.f, 0.f, 0.f, 0.f};
        }
        for (int t = 0; t < nt; t += 2) {
            const bool lastt = (t == nt - 2), last = lastt && (kr_ == krep_ - 1);
            if (lastt && !last) {   }
            const char* a1 = cA + (size_t)(t + 1) * kstep;
            const char* a2 = last ? nA : (lastt ? cA : cA + (size_t)(t + 2) * kstep); const char* b2 = last ? nB : (lastt ? cB : cB + (size_t)(t + 2) * kstep);
            const char* a3 = a2 + kstep; const char* b3 = b2 + kstep;
            if (last && has_next) S.a_ready(nxt);
            PG8_LDB(B0, 0, 0); PG8_LDB(B1, 0, 1); PG8_SCHED; PG8_LDA(At, 0, 0); PG8_STAGE(PG8_SA(1, 1), a1, voffA[1]);
            if (GATHER && last && has_next) { PG8_GLIST(ui + 1); }
            PG8_WAIT_V(8); PG8_WAIT_L(0); PG8_BAR; PG8_MMA(0, 0, At, B0); PG8_MMA(0, 1, At, B1); PG8_BAR; PG8_SCHED;
            PG8_LDA(At, 0, 1); PG8_STAGE(PG8_SB(0, 0), b2, voffB[0]); PG8_STAGE(PG8_SB(0, 1), b2, voffB[1]); PG8_STAGE(PG8_SA(0, 0), a2, voffA[0]);
            PG8_WAIT_V(8); PG8_WAIT_L(0); PG8_BAR; PG8_MMA(1, 0, At, B0); PG8_MMA(1, 1, At, B1); PG8_BAR; PG8_SCHED;
            PG8_LDB(B0, 1, 0); PG8_LDB(B1, 1, 1); PG8_SCHED; PG8_LDA(At, 1, 0); PG8_STAGE(PG8_SA(0, 1), a2, voffA[1]);
            PG8_WAIT_V(8); PG8_WAIT_L(0); PG8_BAR; PG8_MMA(0, 0, At, B0); PG8_MMA(0, 1, At, B1); PG8_BAR; PG8_SCHED;
            PG8_LDA(At, 1, 1); PG8_STAGE(PG8_SB(1, 0), b3, voffB[0]); PG8_STAGE(PG8_SB(1, 1), b3, voffB[1]); PG8_STAGE(PG8_SA(1, 0), a3, voffA[0]);
            PG8_WAIT_V(8); PG8_WAIT_L(0); PG8_BAR; PG8_MMA(1, 0, At, B0); PG8_MMA(1, 1, At, B1); PG8_BAR; PG8_SCHED;
        }
        }
        if (wr == 0) PG8_BAR;
#ifndef EPI_REP
#define EPI_REP 1
#endif
        if (have_prev) S.done(prevu);
#pragma unroll 1
        for (int er_ = 0; er_ < (Epi::IDEMP ? EPI_REP : 1); ++er_) E(acc, cur, wr, wc, fr, fq);
        prevu = cur; have_prev = true;
        if (!has_next) break;
#pragma unroll
        for (int a = 0; a < 2; ++a)
#pragma unroll
            for (int b = 0; b < 2; ++b)
#pragma unroll
                for (int m = 0; m < 4; ++m)
#pragma unroll
                    for (int n = 0; n < 2; ++n) acc[a][b][m][n] = (f32x4){0.f, 0.f, 0.f, 0.f};
        cur = nxt; cA = nA; cB = nB; ++ui;
        if (wr == 1) PG8_BAR;
    }
    PG8_WAIT_V(0);
    if (have_prev) S.done(prevu);
    PG8_BAR;
#undef PG8_SA
#undef PG8_SB
#undef PG8_STAGE
#undef PG8_LDA
#undef PG8_LDB
#undef PG8_MMA
#undef PG8_WAIT_V
#undef PG8_WAIT_L
#undef PG8_BAR
#undef PG8_SCHED
#undef PG8_GLIST
}

struct PlainOrder {
    int krep = 1;
    const char* A; const char* Bt; int K; int nM, nN, nwg, G, c, L0, Lend;
    __device__ void init(const void* A_, const void* Bt_, int M, int N, int K_, int G_, int c_) { A = (const char*)A_; Bt = (const char*)Bt_; K = K_; nM = M / BM; nN = N / BM; nwg = nM * nN; G = G_; c = c_; L0 = 0; Lend = nwg; }
    __device__ __forceinline__ bool next(int i, Unit& u) const {
        const long L = (long)L0 + (long)i * G + c; if (L >= Lend) return false;
        int wgid = (int)L; { const int q = nwg / 8, r = nwg % 8, xcd = wgid % 8, off = wgid / 8; wgid = (xcd < r ? xcd * (q + 1) : r * (q + 1) + (xcd - r) * q) + off; }
        const int nig = 8 * nN, gid = wgid / nig, fm = gid * 8, gsz = (nM - fm) < 8 ? (nM - fm) : 8;
        u.pm = fm + ((wgid % nig) % gsz); u.pn = (wgid % nig) / gsz; u.e = 0; u.row0 = u.pm * BM;
        u.A = A + (size_t)u.pm * BM * K * 2; u.B = Bt + (size_t)u.pn * BM * K * 2; return true;
    }
    __device__ __forceinline__ const LAS int* list(int) const { return nullptr; }
    __device__ __forceinline__ void a_ready(const Unit&) const {}
    __device__ __forceinline__ void done(const Unit&) const {}
};
struct XcdRunOrder {
    int krep = 1;
    const char* A; const char* Bt; int K, nM, nN, wg0, wpx, j, nu;
    __device__ __forceinline__ bool next(int i, Unit& u) const {
        if (i >= nu) return false;
        const int wgid = wg0 + i * wpx + j; if (wgid >= nM * nN) return false;
        const int nig = 8 * nN, gid = wgid / nig, fm = gid * 8, gsz = (nM - fm) < 8 ? (nM - fm) : 8;
        u.pm = fm + ((wgid % nig) % gsz); u.pn = (wgid % nig) / gsz; u.e = 0; u.row0 = u.pm * BM;
        u.A = A + (size_t)u.pm * BM * K * 2; u.B = Bt + (size_t)u.pn * BM * K * 2; return true;
    }
    __device__ __forceinline__ const LAS int* list(int) const { return nullptr; }
    __device__ __forceinline__ void a_ready(const Unit&) const {}
    __device__ __forceinline__ void done(const Unit&) const {}
};

struct EpiBf16 {
    static constexpr int PERM = 3; static constexpr bool IDEMP = true;
    bf16_t* O; int ldc; int nostore = 0;
    __device__ __forceinline__ void operator()(const f32x4 (&acc)[2][2][4][2], const Unit& u, int wr, int wc, int fr, int fq) const {
        const int row0 = u.row0 + wr * 64 + fr; const int col0 = u.pn * BM + wc * 64 + 8 * fq;
#pragma unroll
        for (int ai = 0; ai < 2; ++ai)
#pragma unroll
            for (int m = 0; m < 4; ++m) { bf16_t* rowp = O + (size_t)(row0 + ai * HALF + m * 16) * ldc + col0;
#pragma unroll
                for (int bj = 0; bj < 2; ++bj) { const f32x4 v0 = acc[ai][bj][m][0], v1 = acc[ai][bj][m][1];
                    u32x4 w; w.x = cvt_pk_bf16(v0[0], v0[1]); w.y = cvt_pk_bf16(v0[2], v0[3]); w.z = cvt_pk_bf16(v1[0], v1[1]); w.w = cvt_pk_bf16(v1[2], v1[3]);
                    if (!nostore) EPI_ST16(rowp + bj * 32, w);
                    else asm volatile("" :: "v"(w.x), "v"(w.y), "v"(w.z), "v"(w.w)); } }
    }
};
}
constexpr size_t MiB = 1u << 20;
constexpr size_t WS_CTL = 0, CTL_ZERO_BYTES = 128 * 1024;
constexpr size_t WS_MOD = 1 * MiB;
constexpr size_t WS_MODP = WS_MOD + 256 * 1024;
constexpr size_t WS_TOKE = 3 * MiB, WS_TOKW = WS_TOKE + 512 * 1024, WS_TOKPOS = WS_TOKW + 512 * 1024, WS_TOKRANK = WS_TOKPOS + 512 * 1024;
constexpr size_t WS_BLKBASE = WS_TOKRANK + 512 * 1024;
constexpr size_t WS_SRT = 6 * MiB;
constexpr size_t WS_W2T = 8 * MiB;
constexpr size_t WS_HH = 138 * MiB;
#ifndef YB_MIB
#define YB_MIB 691
#endif
constexpr size_t WS_YB = (size_t)YB_MIB * MiB;
constexpr size_t WS_W13T = 298 * MiB;
constexpr size_t WS_MASKB = 558 * MiB;
constexpr size_t WS_HB = 558 * MiB;
constexpr size_t WS_WINT = 622 * MiB;
constexpr size_t WS_WCVT = 661 * MiB, WS_WATT = 665 * MiB, WS_WOT = 669 * MiB, WS_WRX = 677 * MiB, WS_WRY = 678 * MiB;
constexpr size_t WS_RLOG = 760 * MiB;
constexpr size_t WS_PROJ = 691 * MiB;
constexpr size_t WS_Y1 = 1011 * MiB;
constexpr size_t WS_HLO = WS_PROJ;
constexpr size_t WS_UMIX = 1003 * MiB, WS_AO = 1035 * MiB, WS_KN = 1067 * MiB, WS_VT = 1075 * MiB, WS_KIN = 1083 * MiB, WS_MASK = 1085 * MiB, WS_END = 1093 * MiB;
constexpr int CW_TMO = 0, CW_BAR = 4096, CW_CNT = 16384  , CW_CUR = 16384 + 64, CW_TDONE = 20000  ;
#ifndef TAIL_CAP_N
#define TAIL_CAP_N 3
#endif
constexpr int TAIL_CAP = TAIL_CAP_N;

constexpr int RING_BYTES = 131072;
constexpr int LIST_OFF = RING_BYTES;
constexpr int LDS_BYTES = 163840;
constexpr int MISC_OFF = LDS_BYTES - 256;
constexpr int NWAVES = 8, NTHREADS = 512;

struct Args {
    const float* in[24]; float* out; unsigned char* ws; int ph_lo, ph_hi, bar_region, pad;
};

struct Frame {
    LAS unsigned char* lds; unsigned* ctl; unsigned char* ws; const float* const* in; float* out;
    int tid, lane, wave, G, bid;
};
struct CvtItem { const float* W; bf16_t* dst; bf16_t* dst2; int K, N, k0, n0, mode; };
__device__ __forceinline__ void cvt_load(const CvtItem& it, f32x4 (&v)[8], int lane) {
    const int row = lane >> 3; int n = it.n0 + (lane & 7) * 4; n = n < it.N ? n : 0;
    const float* p = it.W + (size_t)(it.k0 + row) * it.N + n;
#pragma unroll
    for (int i = 0; i < 8; ++i) v[i] = __builtin_nontemporal_load((const f32x4*)(p + (size_t)(8 * i) * it.N));
}
template <bool MODES>
__device__ __forceinline__ void cvt_store(const CvtItem& it, const f32x4 (&v)[8], LAS float* scr, int lane) {
    const int row = lane >> 3, c4 = (lane & 7) * 4; const float keep = (it.n0 + c4 < it.N) ? 1.f : 0.f;
#pragma unroll
    for (int i = 0; i < 8; ++i) { LAS float* d = scr + (8 * i + row) * 33 + c4; d[0] = v[i].x * keep; d[1] = v[i].y * keep; d[2] = v[i].z * keep; d[3] = v[i].w * keep; }
    LDS_WAIT(); asm volatile("" ::: "memory");
    const int c = lane & 7; const int K = it.K;
    float x[4][8];
#pragma unroll
    for (int j = 0; j < 4; ++j) { const LAS float* s = scr + (8 * c) * 33 + (lane >> 3) + 8 * j;
#pragma unroll
        for (int q = 0; q < 8; ++q) x[j][q] = s[q * 33]; }
    LDS_WAIT(); asm volatile("" ::: "memory");
    bf16_t* dp = it.dst + (size_t)(lane >> 3) * K + it.k0 + 8 * c;
#pragma unroll
    for (int j = 0; j < 4; ++j) {
        u32x4 o; o.x = cvt_pk_bf16(x[j][0], x[j][1]); o.y = cvt_pk_bf16(x[j][2], x[j][3]); o.z = cvt_pk_bf16(x[j][4], x[j][5]); o.w = cvt_pk_bf16(x[j][6], x[j][7]);
        if (MODES && it.mode == 2) {
            o.x = cvt_pk_bf16(x[j][0] - bf_lo(o.x), x[j][1] - bf_hi(o.x)); o.y = cvt_pk_bf16(x[j][2] - bf_lo(o.y), x[j][3] - bf_hi(o.y));
            o.z = cvt_pk_bf16(x[j][4] - bf_lo(o.z), x[j][5] - bf_hi(o.z)); o.w = cvt_pk_bf16(x[j][6] - bf_lo(o.w), x[j][7] - bf_hi(o.w)); }
        __builtin_nontemporal_store(o, (u32x4*)(dp + (size_t)(8 * j) * K));
        if (MODES && it.mode == 1) __builtin_nontemporal_store(o, (u32x4*)(it.dst2 + (size_t)((lane >> 3) + 8 * j) * K + it.k0 + 8 * c)); }
}
constexpr int NB_IN = (TOT + 31) / 32;
constexpr int I_IN = (D / 64) * NB_IN, I_CV = (CW / 64) * (D / 32), I_AT = I_CV, I_O = (D / 64) * (D / 32), I_R = (D / 64) * 2 * 2;
constexpr int I_13 = (D / 64) * (DE / 32)  , I_2 = (DE / 64) * (D / 32)  ;
constexpr int NITEMS_SMALL = I_IN + I_CV + I_AT + I_O + I_R, NITEMS_EXP = 130 * I_13 + 65 * I_2;
__device__ __forceinline__ CvtItem small_item(const Frame& F, int r) {
    CvtItem it; it.dst2 = nullptr; it.mode = 0;
    if (r < I_IN) { const int kb = r / NB_IN, nb = r % NB_IN; it.W = F.in[7]; it.K = D; it.N = TOT; it.k0 = 64 * kb; it.n0 = 32 * nb; it.dst = (bf16_t*)(F.ws + WS_WINT) + (size_t)(32 * nb) * D; return it; } r -= I_IN;
    if (r < I_CV) { const int kb = r / (D / 32), nb = r % (D / 32); it.W = F.in[9]; it.K = CW; it.N = D; it.k0 = 64 * kb; it.n0 = 32 * nb; it.dst = (bf16_t*)(F.ws + WS_WCVT) + (size_t)(32 * nb) * CW; return it; } r -= I_CV;
    if (r < I_AT) { const int kb = r / (D / 32), nb = r % (D / 32); it.W = F.in[14]; it.K = AW; it.N = D; it.k0 = 64 * kb; it.n0 = 32 * nb; it.dst = (bf16_t*)(F.ws + WS_WATT) + (size_t)(32 * nb) * AW; return it; } r -= I_AT;
    if (r < I_O) { const int kb = r / (D / 32), nb = r % (D / 32); it.W = F.in[15]; it.K = D; it.N = D; it.k0 = 64 * kb; it.n0 = 32 * nb; it.dst = (bf16_t*)(F.ws + WS_WOT) + (size_t)(32 * nb) * D; return it; } r -= I_O;
    { it.mode = 1 + (r & 1); const int q = r >> 1, kb = q / 2, nb = q % 2; it.W = F.in[16]; it.K = D; it.N = NE; it.k0 = 64 * kb; it.n0 = 32 * nb;
      it.dst = (bf16_t*)(F.ws + WS_WRX) + (size_t)((it.mode == 2 ? 64 : 0) + 32 * nb) * D; it.dst2 = (bf16_t*)(F.ws + WS_WRY) + (size_t)(32 * nb) * D; return it; }
}
__device__ __forceinline__ CvtItem expert_item(const Frame& F, int r) {
    CvtItem it; it.dst2 = nullptr; it.mode = 0;
    const bool up = r < 130 * I_13; const int r2 = up ? r : r - 130 * I_13;
    const int mtx = r2 >> 9, q = r2 & 511;
    const int kb = up ? (q >> 4) : (q >> 6), nb = up ? (q & 15) : (q & 63);
    const int is3 = ((mtx >= 64 && mtx < 128) || mtx == 129) ? 1 : 0; const int e = mtx < 64 ? mtx : (mtx < 128 ? mtx - 64 : 64);
    const float* Wup = mtx < 64 ? F.in[18] + (size_t)mtx * D * DE : (mtx < 128 ? F.in[19] + (size_t)(mtx - 64) * D * DE : (mtx == 128 ? F.in[21] : F.in[22]));
    const float* Wdn = mtx < 64 ? F.in[20] + (size_t)mtx * DE * D : F.in[23];
    const int n0 = 32 * nb; const int drow = e * 1024 + (n0 >> 7) * 256 + is3 * 128 + (n0 & 127);
    it.W = up ? Wup : Wdn; it.K = up ? D : DE; it.N = up ? DE : D; it.k0 = 64 * kb; it.n0 = n0;
    it.dst = up ? (bf16_t*)(F.ws + WS_W13T) + (size_t)drow * D : (bf16_t*)(F.ws + WS_W2T) + ((size_t)mtx * D + n0) * DE;
    return it;
}
template <bool EXPERTS>
__device__ __forceinline__ void cvt_run(const Frame& F, int n, int blk0, int nblk, int first = 0) {
    LAS float* scr = (LAS float*)(F.lds + F.wave * 16384);
    const int gw = first + (F.bid - blk0) * NWAVES + F.wave, S = nblk * NWAVES;
    const int cnt = gw < n ? (n - gw + S - 1) / S : 0; if (cnt == 0) return;
    CvtItem i0, i1, i2, i3; f32x4 v0[8], v1[8], v2[8], v3[8];
#define CV_LD(I, V, k_) do { const int kk_ = (k_) < cnt ? (k_) : cnt - 1; I = EXPERTS ? expert_item(F, gw + kk_ * S) : small_item(F, gw + kk_ * S); cvt_load(I, V, F.lane); } while (0)
    CV_LD(i0, v0, 0); CV_LD(i1, v1, 1); CV_LD(i2, v2, 2);
    int k = 0;
    for (; k + 4 <= cnt; k += 4) {
        CV_LD(i3, v3, k + 3); cvt_store<!EXPERTS>(i0, v0, scr, F.lane);
        CV_LD(i0, v0, k + 4); cvt_store<!EXPERTS>(i1, v1, scr, F.lane);
        CV_LD(i1, v1, k + 5); cvt_store<!EXPERTS>(i2, v2, scr, F.lane);
        CV_LD(i2, v2, k + 6); cvt_store<!EXPERTS>(i3, v3, scr, F.lane);
    }
    if (k < cnt) cvt_store<!EXPERTS>(i0, v0, scr, F.lane);
    if (k + 1 < cnt) cvt_store<!EXPERTS>(i1, v1, scr, F.lane);
    if (k + 2 < cnt) cvt_store<!EXPERTS>(i2, v2, scr, F.lane);
#undef CV_LD
}

__device__ __forceinline__ void p0_prologue(const Frame& F) {
    const float* c_in = F.in[1]; const float* w_ada = F.in[5];
    LAS float* scr = (LAS float*)(F.lds + F.wave * 16384);
    const int gw = F.bid * NWAVES + F.wave, NGW = F.G * NWAVES;
    for (int task = gw; task < 192 * 8; task += NGW) {
        const int kc = task & 7, cc = task >> 3, kbase = kc * 256;
#pragma unroll
        for (int b = 0; b < 4; ++b)
#pragma unroll
            for (int j = 0; j < 4; ++j) { const int k = F.lane + 64 * j; scr[b * 256 + k] = silu_f(c_in[b * D + kbase + k]); }
        LDS_WAIT(); asm volatile("" ::: "memory");
        float a0 = 0.f, a1 = 0.f, a2 = 0.f, a3 = 0.f;
        const float* wp = w_ada + (size_t)kbase * (6 * D) + cc * 64 + F.lane;
#pragma unroll 16
        for (int k = 0; k < 256; ++k) { const float w = wp[(size_t)k * (6 * D)];
            a0 += scr[k] * w; a1 += scr[256 + k] * w; a2 += scr[512 + k] * w; a3 += scr[768 + k] * w; }
        float* mp = (float*)(F.ws + WS_MODP) + (size_t)kc * (4 * 6 * D) + cc * 64 + F.lane;
        mp[0] = a0; mp[6 * D] = a1; mp[2 * 6 * D] = a2; mp[3 * 6 * D] = a3;
        LDS_WAIT(); asm volatile("" ::: "memory");
    }
    cvt_run<false>(F, NITEMS_SMALL, 0, F.G);
#ifndef CVT_OVERLAP
    cvt_run<true>(F, NITEMS_EXP, 0, F.G);
#endif
#ifdef CVT_P0_ON
    if (F.bid < CVT_P0_ON) cvt_run<true>(F, NITEMS_EXP, 0, CVT_P0_ON);
#endif
    {
        const u32x4 z = {0u, 0u, 0u, 0u};
        const int gt = gw * 64 + F.lane, NGT = NGW * 64;
        u32x4* p1 = (u32x4*)((bf16_t*)(F.ws + WS_WINT) + (size_t)9824 * D); for (int i = gt; i < 160 * 256; i += NGT) p1[i] = z;
        u32x4* p2 = (u32x4*)((bf16_t*)(F.ws + WS_WRX) + (size_t)128 * D); for (int i = gt; i < 128 * 256; i += NGT) p2[i] = z;
        u32x4* p3 = (u32x4*)((bf16_t*)(F.ws + WS_WRY) + (size_t)64 * D); for (int i = gt; i < 192 * 256; i += NGT) p3[i] = z;
    }
}

__device__ __forceinline__ float mod_value(const Frame& F, int idx) {
    const float* mp = (const float*)(F.ws + WS_MODP) + idx; float s = 0.f;
#pragma unroll
    for (int p = 0; p < 8; ++p) s += mp[(size_t)p * (4 * 6 * D)];
    return s + F.in[6][idx % (6 * D)];
}

__device__ __forceinline__ void p1_norm1(const Frame& F) {
    LAS float* sh = (LAS float*)F.lds;
    LAS float* sc = sh + D;
    float* MOD = (float*)(F.ws + WS_MOD);
    for (int idx = F.bid * NTHREADS + F.tid; idx < 4 * 6 * D; idx += F.G * NTHREADS) MOD[idx] = mod_value(F, idx);
    for (int blk = F.bid; blk < NTOK / 64; blk += F.G) {
        const int b = blk / (SEQ / 64);
        __syncthreads();
        for (int i = F.tid; i < D; i += NTHREADS) { sh[i] = mod_value(F, b * 6 * D + i); sc[i] = (1.f + mod_value(F, b * 6 * D + D + i)) * F.in[3][i]; }
        __syncthreads();
        for (int j = 0; j < 8; ++j) {
            const int t = blk * 64 + F.wave * 8 + j;
            const f32x4* xr = (const f32x4*)(F.in[0] + (size_t)t * D) + F.lane;
            f32x4 v[8]; float s = 0.f;
#pragma unroll
            for (int q = 0; q < 8; ++q) { v[q] = xr[64 * q]; s += (v[q].x * v[q].x + v[q].y * v[q].y) + (v[q].z * v[q].z + v[q].w * v[q].w); }
            const float r = rsqrtf(wave_sum(s) * (1.f / D) + EPS);
            u32x2* o = (u32x2*)((bf16_t*)(F.ws + WS_HB) + (size_t)t * D) + F.lane;
#pragma unroll
            for (int q = 0; q < 8; ++q) { const int c0 = 4 * F.lane + 256 * q;
                const f32x4 a = *(const LAS f32x4*)(sc + c0), bb = *(const LAS f32x4*)(sh + c0);
                u32x2 w; w.x = pk2(v[q].x * r * a.x + bb.x, v[q].y * r * a.y + bb.y); w.y = pk2(v[q].z * r * a.z + bb.z, v[q].w * r * a.w + bb.w);
                o[64 * q] = w; }
        }
    }
}

__device__ __forceinline__ void p3_mix(const Frame& F) {
    const bf16_t* PROJ = (const bf16_t*)(F.ws + WS_PROJ);
    bf16_t* UMIX = (bf16_t*)(F.ws + WS_UMIX); bf16_t* KN = (bf16_t*)(F.ws + WS_KN); bf16_t* VT = (bf16_t*)(F.ws + WS_VT); bf16_t* KIN = (bf16_t*)(F.ws + WS_KIN);
    const float* conv_w = F.in[8];
    LAS bf16_t* tile = (LAS bf16_t*)F.lds;
    const int c0 = F.lane * 16;
    float w0[16], w1[16], w2[16];
#pragma unroll
    for (int i = 0; i < 16; ++i) { w0[i] = conv_w[c0 + i]; w1[i] = conv_w[CW + c0 + i]; w2[i] = conv_w[2 * CW + c0 + i]; }
    const float* knw = F.in[11]; float kw4[4];
#pragma unroll
    for (int i = 0; i < 4; ++i) kw4[i] = knw[(F.lane & 15) * 4 + i];
    const float iw = F.in[12][F.lane], ib = F.in[13][F.lane];
    for (int blk = F.bid; blk < NTOK / 64; blk += F.G) {
        const int tok0 = blk * 64, b = tok0 / SEQ, tt0 = tok0 % SEQ;
        __syncthreads();
#pragma unroll
        for (int it = 0; it < 4; ++it) { const int idx = it * NTHREADS + F.tid, tk = idx >> 5, ch = idx & 31;
            const u32x4 v = *(const u32x4*)(PROJ + (size_t)(tok0 + tk) * TOTP + O_V + ch * 8);
            const unsigned wv[4] = {v.x, v.y, v.z, v.w};
#pragma unroll
            for (int j = 0; j < 4; ++j) { tile[(ch * 8 + 2 * j) * 72 + tk] = (bf16_t)(wv[j] & 0xffffu); tile[(ch * 8 + 2 * j + 1) * 72 + tk] = (bf16_t)(wv[j] >> 16); } }
        __syncthreads();
#pragma unroll
        for (int it = 0; it < 4; ++it) { const int idx = it * NTHREADS + F.tid, col = idx >> 3, ch = idx & 7;
            const int g16 = ch >> 1, c1 = ch & 1;
            const u32x2 v0 = *(const LAS u32x2*)(tile + col * 72 + 16 * g16 + 4 * c1), v1 = *(const LAS u32x2*)(tile + col * 72 + 16 * g16 + 8 + 4 * c1);
            *(u32x4*)(VT + ((size_t)(b * 256 + col)) * SEQ + tt0 + ch * 8) = (u32x4){v0.x, v0.y, v1.x, v1.y}; }
        float vm1[16], vm2[16];
        {
            const int t = tok0 + F.wave * 8, tt = t % SEQ;
#pragma unroll
            for (int back = 1; back <= 2; ++back) {
                float* dst = back == 1 ? vm1 : vm2;
                if (tt >= back) {
                    const bf16_t* p = PROJ + (size_t)(t - back) * TOTP;
                    const u32x4 a0 = *(const u32x4*)(p + O_CC + c0), a1 = *(const u32x4*)(p + O_CC + c0 + 8), b0 = *(const u32x4*)(p + O_CU + c0), b1 = *(const u32x4*)(p + O_CU + c0 + 8);
                    const unsigned aw[8] = {a0.x, a0.y, a0.z, a0.w, a1.x, a1.y, a1.z, a1.w}, bw[8] = {b0.x, b0.y, b0.z, b0.w, b1.x, b1.y, b1.z, b1.w};
#pragma unroll
                    for (int i = 0; i < 8; ++i) { dst[2 * i] = bf_lo(aw[i]) * bf_lo(bw[i]); dst[2 * i + 1] = bf_hi(aw[i]) * bf_hi(bw[i]); }
                } else {
#pragma unroll
                    for (int i = 0; i < 16; ++i) dst[i] = 0.f;
                }
            }
        }
        for (int j = 0; j < 8; ++j) {
            const int t = tok0 + F.wave * 8 + j;
            const bf16_t* p = PROJ + (size_t)t * TOTP;
            const u32x4 a0 = *(const u32x4*)(p + O_CC + c0), a1 = *(const u32x4*)(p + O_CC + c0 + 8), b0 = *(const u32x4*)(p + O_CU + c0), b1 = *(const u32x4*)(p + O_CU + c0 + 8);
            const u32x4 g0 = *(const u32x4*)(p + O_CB + c0), g1 = *(const u32x4*)(p + O_CB + c0 + 8);
            const unsigned aw[8] = {a0.x, a0.y, a0.z, a0.w, a1.x, a1.y, a1.z, a1.w}, bw[8] = {b0.x, b0.y, b0.z, b0.w, b1.x, b1.y, b1.z, b1.w}, gw[8] = {g0.x, g0.y, g0.z, g0.w, g1.x, g1.y, g1.z, g1.w};
            float v0[16]; unsigned ow[8];
#pragma unroll
            for (int i = 0; i < 8; ++i) { v0[2 * i] = bf_lo(aw[i]) * bf_lo(bw[i]); v0[2 * i + 1] = bf_hi(aw[i]) * bf_hi(bw[i]); }
#pragma unroll
            for (int i = 0; i < 8; ++i) {
                const float y0 = w0[2 * i] * vm2[2 * i] + w1[2 * i] * vm1[2 * i] + w2[2 * i] * v0[2 * i];
                const float y1 = w0[2 * i + 1] * vm2[2 * i + 1] + w1[2 * i + 1] * vm1[2 * i + 1] + w2[2 * i + 1] * v0[2 * i + 1];
                ow[i] = pk2(bf_lo(gw[i]) * y0, bf_hi(gw[i]) * y1); }
            u32x4* o = (u32x4*)(UMIX + (size_t)t * CW + c0);
            o[0] = (u32x4){ow[0], ow[1], ow[2], ow[3]}; o[1] = (u32x4){ow[4], ow[5], ow[6], ow[7]};
#pragma unroll
            for (int i = 0; i < 16; ++i) { vm2[i] = vm1[i]; vm1[i] = v0[i]; }
            { const u32x2 kv = *(const u32x2*)(p + O_K + F.lane * 4);
              float k0 = bf_lo(kv.x), k1 = bf_hi(kv.x), k2 = bf_lo(kv.y), k3 = bf_hi(kv.y);
              float s = (k0 * k0 + k1 * k1) + (k2 * k2 + k3 * k3);
              s += __shfl_xor(s, 1); s += __shfl_xor(s, 2); s += __shfl_xor(s, 4); s += __shfl_xor(s, 8);
              const float r = rsqrtf(s * (1.f / 64.f) + EPS);
              u32x2 ov; ov.x = pk2(k0 * r * kw4[0], k1 * r * kw4[1]); ov.y = pk2(k2 * r * kw4[2], k3 * r * kw4[3]);
              *(u32x2*)(KN + (size_t)t * KVW + F.lane * 4) = ov; }
            { const float xv = bf2f(p[O_KI + F.lane]);
              const float mu = wave_sum(xv) * (1.f / 64.f), dx = xv - mu, var = wave_sum(dx * dx) * (1.f / 64.f);
              KIN[(size_t)t * IDIM + F.lane] = (bf16_t)f2bf(dx * rsqrtf(var + EPS) * iw + ib); }
        }
    }
}

__device__ __forceinline__ unsigned f2key(float f) { const unsigned u = __float_as_uint(f); return (u & 0x80000000u) ? ~u : (u | 0x80000000u); }
__device__ __forceinline__ unsigned fxkey(float v) { const int q = (int)__builtin_fmaf(v, 131072.f, 524289.f); return (unsigned)(q < 1 ? 1 : (q > 1048574 ? 1048574 : q)); }
__device__ __forceinline__ int crow32(int r, int hi) { return (r & 3) + 8 * (r >> 2) + 4 * hi; }

__device__ __forceinline__ void p4_index(const Frame& F) {
    const bf16_t* PROJ = (const bf16_t*)(F.ws + WS_PROJ); const bf16_t* KIN = (const bf16_t*)(F.ws + WS_KIN);
    unsigned* MASK = (unsigned*)(F.ws + WS_MASK);
    LAS unsigned* SCK = (LAS unsigned*)F.lds;
    LAS float* WQ = (LAS float*)(F.lds + LIST_OFF);
    LAS bf16_t* UQ = (LAS bf16_t*)(F.lds + LIST_OFF + 512);
    const int lane = F.lane, n32 = lane & 31, hi = lane >> 5, w = F.wave;
    constexpr int NUNITS = BATCH * (SEQ / 8);
    for (int r = 0;; ++r) {
        const int L = r * F.G + ((r & 1) ? (F.G - 1 - F.bid) : F.bid);
        if (L >= NUNITS) break;
        const int b = L & 3, qg = (SEQ / 8 - 1) - (L >> 2), t0 = qg * 8;
        const int nkt = (t0 + 7) / 32 + 1;
        bf16x8 Af[4][4];
        {
            const int qsel = (n32 >> 2) & 1, head = (n32 & 3) + 4 * (n32 >> 3);
#pragma unroll
            for (int rt = 0; rt < 4; ++rt) {
                const bf16_t* p = PROJ + (size_t)(b * SEQ + t0 + 2 * rt + qsel) * TOTP + O_QI + head * 64 + 8 * hi;
#pragma unroll
                for (int ks = 0; ks < 4; ++ks) Af[rt][ks] = *(const bf16x8*)(p + 16 * ks);
            }
        }
        bf16x8 B0[4], B1[4];
#define P4_LDB(dst, kt_) do { const bf16_t* kp_ = KIN + (size_t)(b * SEQ + (kt_) * 32 + n32) * IDIM + 8 * hi; _Pragma("unroll") for (int ks = 0; ks < 4; ++ks) dst[ks] = *(const bf16x8*)(kp_ + 16 * ks); } while (0)
        if (w < nkt) P4_LDB(B0, w);
        __syncthreads();
        if (F.tid < 128) WQ[F.tid] = bf2f(PROJ[(size_t)(b * SEQ + t0 + (F.tid >> 4)) * TOTP + O_WI + (F.tid & 15)]) * (0.25f * 0.125f);
        __syncthreads();
        { const int q = F.tid >> 6, d = F.tid & 63; const bf16_t* qp = PROJ + (size_t)(b * SEQ + t0 + q) * TOTP + O_QI + d; float uacc = 0.f;
#pragma unroll
          for (int h2 = 0; h2 < 16; ++h2) uacc += WQ[q * 16 + h2] * bf2f(qp[h2 * 64]);
          UQ[q * 64 + d] = (bf16_t)f2bf(uacc); }
        __syncthreads();
        bf16x8 A5[4];
        { const int qm = n32 < 4 ? 2 * n32 : 2 * (n32 - 4) + 1;
#pragma unroll
          for (int ks = 0; ks < 4; ++ks) { const bf16x8 v = *(const LAS bf16x8*)(UQ + (qm & 7) * 64 + 16 * ks + 8 * hi); A5[ks] = n32 < 8 ? v : (bf16x8){0, 0, 0, 0, 0, 0, 0, 0}; } }
#define P4_TILE(Bc, kt_) do { f32x16 lin = {}; _Pragma("unroll") for (int ks = 0; ks < 4; ++ks) lin = __builtin_amdgcn_mfma_f32_32x32x16_bf16(A5[ks], Bc[ks], lin, 0, 0, 0); \
        _Pragma("unroll") for (int rt = 0; rt < 4; ++rt) { \
            f32x16 acc = {}; _Pragma("unroll") for (int ks = 0; ks < 4; ++ks) acc = __builtin_amdgcn_mfma_f32_32x32x16_bf16(Af[rt][ks], Bc[ks], acc, 0, 0, 0); \
            const LAS f32x4* wv = (const LAS f32x4*)(WQ + (2 * rt + hi) * 16); float s_ = lin[rt]; \
            _Pragma("unroll") for (int i4 = 0; i4 < 4; ++i4) { const f32x4 ww = wv[i4]; \
                s_ += ww.x * __builtin_fabsf(acc[4 * i4]) + ww.y * __builtin_fabsf(acc[4 * i4 + 1]) + ww.z * __builtin_fabsf(acc[4 * i4 + 2]) + ww.w * __builtin_fabsf(acc[4 * i4 + 3]); } \
            SCK[(2 * rt + hi) * SEQ + (kt_) * 32 + n32] = fxkey(0.5f * s_); } } while (0)
#ifndef P4_REP_SC
#define P4_REP_SC 1
#endif
#ifndef P4_REP_SEL
#define P4_REP_SEL 1
#endif
#pragma unroll 1
        for (int rep_ = 0; rep_ < P4_REP_SC; ++rep_) { if (rep_ && w < nkt) P4_LDB(B0, w);
        for (int kt = w; kt < nkt; kt += 16) {
            if (kt + 8 < nkt) P4_LDB(B1, kt + 8);
            P4_TILE(B0, kt);
            if (kt + 8 < nkt) {
                if (kt + 16 < nkt) P4_LDB(B0, kt + 16);
                P4_TILE(B1, kt + 8);
            }
        }
        }
#undef P4_LDB
#undef P4_TILE
        __syncthreads();
#ifndef P4_REP_SEL
#define P4_REP_SEL 1
#endif
#pragma unroll 1
        for (int rep2_ = 0; rep2_ < P4_REP_SEL; ++rep2_) {
            const int t = t0 + w, jmax = t >> 6;
            unsigned key[64];
#pragma unroll
            for (int g8 = 0; g8 < 8; ++g8) {
                if (g8 * 8 <= jmax) {
#pragma unroll
                    for (int jj = 0; jj < 8; ++jj) { const int j = g8 * 8 + jj, s = j * 64 + lane; const unsigned v = SCK[w * SEQ + s]; key[j] = (s <= t) ? v : 0u; }
                } else {
#pragma unroll
                    for (int jj = 0; jj < 8; ++jj) key[g8 * 8 + jj] = 0u;
                }
            }
#define P4_CNT8(g8_, op_, cand_, c_) do { unsigned long long m0_, m1_, m2_, m3_, m4_, m5_, m6_, m7_; \
                asm volatile("v_cmp_" op_ "_u32_e64 %0, %8, %16\n\tv_cmp_" op_ "_u32_e64 %1, %9, %16\n\tv_cmp_" op_ "_u32_e64 %2, %10, %16\n\tv_cmp_" op_ "_u32_e64 %3, %11, %16\n\t" \
                             "v_cmp_" op_ "_u32_e64 %4, %12, %16\n\tv_cmp_" op_ "_u32_e64 %5, %13, %16\n\tv_cmp_" op_ "_u32_e64 %6, %14, %16\n\tv_cmp_" op_ "_u32_e64 %7, %15, %16" \
                    : "=&s"(m0_), "=&s"(m1_), "=&s"(m2_), "=&s"(m3_), "=&s"(m4_), "=&s"(m5_), "=&s"(m6_), "=&s"(m7_) \
                    : "v"(key[(g8_) * 8 + 0]), "v"(key[(g8_) * 8 + 1]), "v"(key[(g8_) * 8 + 2]), "v"(key[(g8_) * 8 + 3]), "v"(key[(g8_) * 8 + 4]), "v"(key[(g8_) * 8 + 5]), "v"(key[(g8_) * 8 + 6]), "v"(key[(g8_) * 8 + 7]), "s"(cand_)); \
                c_ += (__popcll(m0_) + __popcll(m1_)) + (__popcll(m2_) + __popcll(m3_)) + (__popcll(m4_) + __popcll(m5_)) + (__popcll(m6_) + __popcll(m7_)); } while (0)
            unsigned TH = 0u; bool exact = false; int rem = 0;
            if (t + 1 <= NSEL) { TH = 1u; exact = true; }
            else {
#pragma unroll 1
                for (int bit = 19; bit >= 0; --bit) {
                    const unsigned cand = (unsigned)__builtin_amdgcn_readfirstlane((int)(TH | (1u << bit)));
                    int c = 0;
#pragma unroll
                    for (int g8 = 0; g8 < 8; ++g8) { if (g8 * 8 <= jmax) P4_CNT8(g8, "ge", cand, c); }
                    if (c >= NSEL) TH = cand;
                    if (c == NSEL) { exact = true; break; }
                }
                if (!exact) { int cgt = 0; const unsigned ths = (unsigned)__builtin_amdgcn_readfirstlane((int)TH);
#pragma unroll
                    for (int g8 = 0; g8 < 8; ++g8) { if (g8 * 8 <= jmax) P4_CNT8(g8, "gt", ths, cgt); }
                    rem = NSEL - cgt; }
            }
            unsigned char* mrow = (unsigned char*)(F.ws + WS_MASKB) + ((size_t)(b * SEQ + t)) * SEQ + (((lane >> 2) & 1) * 32 + (lane >> 3) * 4 + (lane & 3));
#pragma unroll
            for (int g8 = 0; g8 < 8; ++g8) {
                if (g8 * 8 <= jmax) {
#pragma unroll
                    for (int jj = 0; jj < 8; ++jj) { const int j = g8 * 8 + jj;
                        unsigned long long m;
                        if (exact) m = __ballot(key[j] >= TH);
                        else {
                            m = __ballot(key[j] > TH);
                            unsigned long long e = __ballot(key[j] == TH);
                            while (rem > 0 && e) { const unsigned long long bitv = e & (~e + 1ull); m |= bitv; e ^= bitv; --rem; }
                        }
                        unsigned bytev; asm volatile("s_nop 1\n\tv_cndmask_b32_e64 %0, 0, %1, %2" : "=v"(bytev) : "v"(0xFFu), "s"(m));
                        asm volatile("global_store_byte %0, %1, off offset:%2" :: "v"(mrow), "v"(bytev), "n"(j * 64) : "memory"); }
                }
            }
        }
#undef P4_CNT8
    }
}

constexpr int P5_KBUF = 0, P5_VBUF = 49152, P5_STG = 98304, P5_BIAS = 135168, P5_BTW = 324, P5_END = P5_BIAS + 16 * P5_BTW * 4;
static_assert(P5_END <= MISC_OFF, "P5 LDS map");
__device__ __forceinline__ int t5_bucket(int n) {
    if (n < 16) return n;
    const int large = 16 + (int)(__logf((float)n * (1.f / 16.f)) * (16.f / 2.0794415416798357f));
    return large < 31 ? large : 31;
}
__device__ __forceinline__ void p5_attn(const Frame& F) {
    const bf16_t* PROJ = (const bf16_t*)(F.ws + WS_PROJ); const bf16_t* KN = (const bf16_t*)(F.ws + WS_KN); const bf16_t* VT = (const bf16_t*)(F.ws + WS_VT);
    const unsigned* MASK = (const unsigned*)(F.ws + WS_MASK); bf16_t* AO = (bf16_t*)(F.ws + WS_AO);
    const float* rel_bias = F.in[2]; const float* qnw = F.in[10];
    const int lane = F.lane, q32 = lane & 31, hi = lane >> 5, w = F.wave, tid = F.tid;
    constexpr float LOG2E = 1.4426950408889634f;
    LAS float* BT = (LAS float*)(F.lds + P5_BIAS);
    __syncthreads();
    for (int i = tid; i < 16 * P5_BTW; i += NTHREADS) { const int h = i / P5_BTW, d = i % P5_BTW - 64;
        BT[i] = (d >= 0 && d < 128) ? (rel_bias[t5_bucket(d) * NH + h] - rel_bias[31 * NH + h]) * LOG2E : 0.f; }
    __syncthreads();
    constexpr int NUNITS = BATCH * NKV * (SEQ / 64);
    const int kkey = tid >> 3, kch = tid & 7;
    const int ldsK = kkey * 128 + ((kch ^ ((kkey >> 1) & 7)) * 16);
    const bf16x8 ones = {0x3f80, 0x3f80, 0x3f80, 0x3f80, 0x3f80, 0x3f80, 0x3f80, 0x3f80};
#define P5_QK(p0_, p1_, kslot_) do { const LAS unsigned char* kb_ = F.lds + P5_KBUF + (kslot_) * 8192; p0_ = (f32x16){}; p1_ = (f32x16){}; \
        _Pragma("unroll") for (int ks = 0; ks < 4; ++ks) { const int ch = 2 * ks + hi; \
            const bf16x8 a0 = *(const LAS bf16x8*)(kb_ + q32 * 128 + ((ch ^ ((q32 >> 1) & 7)) * 16)); \
            const bf16x8 a1 = *(const LAS bf16x8*)(kb_ + (q32 + 32) * 128 + ((ch ^ (((q32 + 32) >> 1) & 7)) * 16)); \
            p0_ = __builtin_amdgcn_mfma_f32_32x32x16_bf16(a0, Qf[ks], p0_, 0, 0, 0); p1_ = __builtin_amdgcn_mfma_f32_32x32x16_bf16(a1, Qf[ks], p1_, 0, 0, 0); } } while (0)
#define P5_LDK(Kf_, kslot_) P5_LDKR(Kf_, kslot_, 0, 4)
#define P5_LDKR(Kf_, kslot_, k0_, k1_) do { const LAS unsigned char* kb_ = F.lds + P5_KBUF + (kslot_) * 8192; \
        _Pragma("unroll") for (int ks = (k0_); ks < (k1_); ++ks) { const int ch = 2 * ks + hi; \
            Kf_[2 * ks] = *(const LAS bf16x8*)(kb_ + q32 * 128 + ((ch ^ ((q32 >> 1) & 7)) * 16)); \
            Kf_[2 * ks + 1] = *(const LAS bf16x8*)(kb_ + (q32 + 32) * 128 + ((ch ^ (((q32 + 32) >> 1) & 7)) * 16)); } } while (0)
#define P5_QKF(p0_, p1_, Kf_) do { p0_ = (f32x16){}; p1_ = (f32x16){}; \
        _Pragma("unroll") for (int ks = 0; ks < 4; ++ks) { p0_ = __builtin_amdgcn_mfma_f32_32x32x16_bf16(Kf_[2 * ks], Qf[ks], p0_, 0, 0, 0); p1_ = __builtin_amdgcn_mfma_f32_32x32x16_bf16(Kf_[2 * ks + 1], Qf[ks], p1_, 0, 0, 0); } } while (0)
#define P5_LDVR(Vf_, vslot_, s0_, s1_) do { const LAS unsigned char* vb_ = F.lds + P5_VBUF + (vslot_) * 8192; \
        _Pragma("unroll") for (int s = (s0_); s < (s1_); ++s) _Pragma("unroll") for (int blk = 0; blk < 2; ++blk) { const int dim = q32 + 32 * blk, swz = (dim >> 1) & 7; \
            Vf_[2 * s + blk] = *(const LAS bf16x8*)(vb_ + dim * 128 + (((2 * s + hi) ^ swz) * 16)); } } while (0)
    for (int r = 0;; ++r) {
        const int L = r * F.G + ((r & 1) ? (F.G - 1 - F.bid) : F.bid);
        if (L >= NUNITS) break;
        const int bg = L & 15, b = bg >> 2, g = bg & 3, qt = (SEQ / 64 - 1) - (L >> 4), t0 = qt * 64;
        const int h = 4 * g + (w >> 1), tq = t0 + 32 * (w & 1) + q32;
        const int nkt = qt + 1;
        bf16x8 Qf[4];
        {
            const bf16_t* qp = PROJ + (size_t)(b * SEQ + tq) * TOTP + O_Q + h * 64 + 8 * hi;
            u32x4 raw[4]; float ss = 0.f;
#pragma unroll
            for (int ks = 0; ks < 4; ++ks) { raw[ks] = *(const u32x4*)(qp + 16 * ks); const unsigned xw[4] = {raw[ks].x, raw[ks].y, raw[ks].z, raw[ks].w};
#pragma unroll
                for (int i = 0; i < 4; ++i) { const float a = bf_lo(xw[i]), c = bf_hi(xw[i]); ss += a * a + c * c; } }
            ss += __shfl_xor(ss, 32);
            const float rs = rsqrtf(ss * (1.f / 64.f) + EPS) * (0.125f * LOG2E);
#pragma unroll
            for (int ks = 0; ks < 4; ++ks) { const unsigned xw[4] = {raw[ks].x, raw[ks].y, raw[ks].z, raw[ks].w}; const float* wn = qnw + 16 * ks + 8 * hi; u32x4 o;
                unsigned ow[4];
#pragma unroll
                for (int i = 0; i < 4; ++i) ow[i] = pk2(bf_lo(xw[i]) * rs * wn[2 * i], bf_hi(xw[i]) * rs * wn[2 * i + 1]);
                o = (u32x4){ow[0], ow[1], ow[2], ow[3]}; Qf[ks] = __builtin_bit_cast(bf16x8, o); }
        }
        const bf16_t* kg = KN + (size_t)(b * SEQ) * KVW + g * 64 + kkey * KVW + kch * 8;
        const bf16_t* vg = VT + ((size_t)((b * 4 + g) * 64 + kkey)) * SEQ + kch * 8;
        const unsigned char* mg = (const unsigned char*)(F.ws + WS_MASKB) + ((size_t)(b * SEQ + tq)) * SEQ + hi * 32;
        f32x16 O0 = {}, O1 = {}, Ls = {};
        __syncthreads();
        { const int t1 = nkt > 1 ? 1 : 0, t2 = nkt > 2 ? 2 : nkt - 1;
          const u32x4 kv0 = *(const u32x4*)kg, vv0 = *(const u32x4*)vg;
          const u32x4 kv1 = *(const u32x4*)(kg + (size_t)t1 * 64 * KVW), vv1 = *(const u32x4*)(vg + t1 * 64);
          const u32x4 kv2 = *(const u32x4*)(kg + (size_t)t2 * 64 * KVW), vv2 = *(const u32x4*)(vg + t2 * 64);
          *(LAS u32x4*)(F.lds + P5_KBUF + ldsK) = kv0; *(LAS u32x4*)(F.lds + P5_VBUF + ldsK) = vv0;
          *(LAS u32x4*)(F.lds + P5_KBUF + 8192 + ldsK) = kv1; *(LAS u32x4*)(F.lds + P5_VBUF + 8192 + ldsK) = vv1;
          *(LAS u32x4*)(F.lds + P5_KBUF + 16384 + ldsK) = kv2; *(LAS u32x4*)(F.lds + P5_VBUF + 16384 + ldsK) = vv2; }
        u32x4 mc0 = *(const u32x4*)mg, mc1 = *(const u32x4*)(mg + 16);
        __syncthreads();
        f32x16 pa0, pa1, pb0, pb1; bf16x8 Kf[8], Vf[8]; P5_LDK(Kf, 0); P5_QKF(pa0, pa1, Kf);
        int s0 = 0;
#define P5_SLOT(j_) ((s0 + (j_)) >= 6 ? (s0 + (j_)) - 6 : (s0 + (j_)))
#define P5_SDW(pk_, zb_, xa_, xb_, mw_, SA_, SB_) asm("v_exp_f32 %0, %2\n\tv_exp_f32 %1, %3\n\tv_and_b32_sdwa %0, %0, sext(%4) dst_sel:DWORD dst_unused:UNUSED_PAD src0_sel:DWORD src1_sel:" SA_ "\n\t" \
            "v_and_b32_sdwa %1, %1, sext(%4) dst_sel:DWORD dst_unused:UNUSED_PAD src0_sel:DWORD src1_sel:" SB_ "\n\tv_cvt_pk_bf16_f32 %0, %0, %1" : "=&v"(pk_), "=&v"(zb_) : "v"(xa_), "v"(xb_), "v"(mw_))
#define P5_X(PP, MM, s_, h_) do { _Pragma("unroll") for (int i_ = 0; i_ < 4; i_ += 2) { \
            const int ra_ = 8 * ((s_) & 1) + 4 * (h_) + i_, rb_ = ra_ + 1; \
              \
            unsigned pk_; { float zb_; const unsigned mw_ = MM[ra_ >> 2]; \
            if ((ra_ & 3) == 0) P5_SDW(pk_, zb_, PP[ra_], PP[rb_], mw_, "BYTE_0", "BYTE_1"); else P5_SDW(pk_, zb_, PP[ra_], PP[rb_], mw_, "BYTE_2", "BYTE_3"); } \
            pw[s_][2 * (h_) + (i_ >> 1)] = pk_; } } while (0)
#define P5_SB __builtin_amdgcn_sched_barrier(0)
#define P5_Q(N0, N1, j_) do { if ((j_) == 0) N0 = __builtin_amdgcn_mfma_f32_32x32x16_bf16(Kf[0], Qf[0], (f32x16){}, 0, 0, 0); \
            else if ((j_) == 1) N1 = __builtin_amdgcn_mfma_f32_32x32x16_bf16(Kf[1], Qf[0], (f32x16){}, 0, 0, 0); \
            else if ((j_) & 1) N1 = __builtin_amdgcn_mfma_f32_32x32x16_bf16(Kf[j_], Qf[(j_) >> 1], N1, 0, 0, 0); \
            else N0 = __builtin_amdgcn_mfma_f32_32x32x16_bf16(Kf[j_], Qf[(j_) >> 1], N0, 0, 0, 0); } while (0)
#define P5_PB(s_) __builtin_bit_cast(bf16x8, ((u32x4){pw[s_][0], pw[s_][1], pw[s_][2], pw[s_][3]}))
#define P5_PVL(s_) Ls = __builtin_amdgcn_mfma_f32_32x32x16_bf16(ones, P5_PB(s_), Ls, 0, 0, 0)
#define P5_PV0(s_) O0 = __builtin_amdgcn_mfma_f32_32x32x16_bf16(Vf[2 * (s_)], P5_PB(s_), O0, 0, 0, 0)
#define P5_PV1(s_) O1 = __builtin_amdgcn_mfma_f32_32x32x16_bf16(Vf[2 * (s_) + 1], P5_PB(s_), O1, 0, 0, 0)
#define P5_STEP(C0, C1, N0, N1, kt_, sc_, sn_) do { \
            const int t1 = (kt_) + 1 < nkt ? (kt_) + 1 : (kt_); \
            const u32x4 mn0 = *(const u32x4*)(mg + t1 * 64), mn1 = *(const u32x4*)(mg + t1 * 64 + 16); \
            P5_LDKR(Kf, sn_, 0, 2); P5_LDVR(Vf, sc_, 0, 2); \
            const u32x4 m0 = mc0, m1 = mc1; \
            if ((kt_) + 3 > qt) { \
                const LAS float* bt = BT + (w >> 1 | (g << 2)) * P5_BTW + (tq - (kt_) * 64 - 4 * hi + 64);     \
                _Pragma("unroll") for (int r2 = 0; r2 < 16; ++r2) { const int kk = (r2 & 3) + 8 * (r2 >> 2); C0[r2] += bt[-kk]; C1[r2] += bt[-kk - 32]; } \
            } \
            unsigned pw[4][4]; \
            P5_SB; P5_Q(N0, N1, 0); P5_SB; P5_X(C0, m0, 0, 0); P5_SB; P5_Q(N0, N1, 1); P5_SB; P5_Q(N0, N1, 2); P5_SB; P5_X(C0, m0, 0, 1); P5_SB; P5_Q(N0, N1, 3); P5_LDKR(Kf, sn_, 2, 4); P5_SB; \
            P5_PVL(0); P5_SB; P5_X(C0, m0, 1, 0); P5_SB; P5_PV0(0); P5_SB; P5_PV1(0); P5_LDVR(Vf, sc_, 2, 3); P5_SB; P5_X(C0, m0, 1, 1); P5_SB; P5_Q(N0, N1, 4); P5_SB; \
            P5_PVL(1); P5_SB; P5_X(C1, m1, 2, 0); P5_SB; P5_PV0(1); P5_SB; P5_PV1(1); P5_LDVR(Vf, sc_, 3, 4); P5_SB; P5_X(C1, m1, 2, 1); P5_SB; P5_Q(N0, N1, 5); P5_SB; \
            P5_PVL(2); P5_SB; P5_X(C1, m1, 3, 0); P5_SB; P5_PV0(2); P5_SB; P5_PV1(2); P5_SB; P5_X(C1, m1, 3, 1); P5_SB; P5_Q(N0, N1, 6); P5_SB; P5_Q(N0, N1, 7); P5_SB; \
            P5_PVL(3); P5_PV0(3); P5_PV1(3); P5_SB; \
            mc0 = mn0; mc1 = mn1; } while (0)
        int kt = 0;
        for (; kt + 2 <= nkt; kt += 2) {
            const int t3 = kt + 3 < nkt ? kt + 3 : nkt - 1, t4 = kt + 4 < nkt ? kt + 4 : nkt - 1;
            const u32x4 k3 = *(const u32x4*)(kg + (size_t)t3 * 64 * KVW), v3 = *(const u32x4*)(vg + t3 * 64);
            const u32x4 k4 = *(const u32x4*)(kg + (size_t)t4 * 64 * KVW), v4 = *(const u32x4*)(vg + t4 * 64);
            const int sA = P5_SLOT(0), sB = P5_SLOT(1), sC = P5_SLOT(2), sD = P5_SLOT(3), sE = P5_SLOT(4);
            P5_STEP(pa0, pa1, pb0, pb1, kt, sA, sB);
            P5_STEP(pb0, pb1, pa0, pa1, kt + 1, sB, sC);
            if (kt + 3 < nkt) { *(LAS u32x4*)(F.lds + P5_KBUF + sD * 8192 + ldsK) = k3; *(LAS u32x4*)(F.lds + P5_VBUF + sD * 8192 + ldsK) = v3; }
            if (kt + 4 < nkt) { *(LAS u32x4*)(F.lds + P5_KBUF + sE * 8192 + ldsK) = k4; *(LAS u32x4*)(F.lds + P5_VBUF + sE * 8192 + ldsK) = v4; }
            s0 = sC;
            __syncthreads();
        }
        if (kt < nkt) { const int sA = P5_SLOT(0), sB = P5_SLOT(1); P5_STEP(pa0, pa1, pb0, pb1, kt, sA, sB); __syncthreads(); }
#undef P5_STEP
#undef P5_SLOT
        const float inv = 1.f / Ls[0];
        LAS bf16_t* stg = (LAS bf16_t*)(F.lds + P5_STG) + w * (32 * 72);
#pragma unroll
        for (int r2 = 0; r2 < 16; ++r2) { const int dim = crow32(r2, hi);
            stg[q32 * 72 + dim] = (bf16_t)f2bf(O0[r2] * inv); stg[q32 * 72 + dim + 32] = (bf16_t)f2bf(O1[r2] * inv); }
        LDS_WAIT(); asm volatile("" ::: "memory");
#pragma unroll
        for (int i = 0; i < 4; ++i) { const int row = i * 8 + (lane >> 3), ch = lane & 7;
            const u32x4 v = *(const LAS u32x4*)(stg + row * 72 + ch * 8);
            *(u32x4*)(AO + (size_t)(b * SEQ + t0 + 32 * (w & 1) + row) * AW + h * 64 + ch * 8) = v; }
    }
#undef P5_QK
}
namespace pg8 {
template <bool ADD> struct EpiGate {
    static constexpr int PERM = 3; static constexpr bool IDEMP = !ADD;
    const bf16_t* G; int ldg; bf16_t* O;
    __device__ __forceinline__ void operator()(const f32x4 (&acc)[2][2][4][2], const Unit& u, int wr, int wc, int fr, int fq) const {
        const int row0 = u.row0 + wr * 64 + fr; const int col0 = u.pn * BM + wc * 64 + 8 * fq;
#pragma unroll
        for (int ai = 0; ai < 2; ++ai)
#pragma unroll
            for (int m = 0; m < 4; ++m) { const size_t row = (size_t)(row0 + ai * HALF + m * 16);
#pragma unroll
                for (int bj = 0; bj < 2; ++bj) { const f32x4 v0 = acc[ai][bj][m][0], v1 = acc[ai][bj][m][1];
                    const u32x4 g = *(const u32x4*)(G + row * ldg + col0 + bj * 32);
                    float r[8] = {v0[0] * sigmoid_f(bf_lo(g.x)), v0[1] * sigmoid_f(bf_hi(g.x)), v0[2] * sigmoid_f(bf_lo(g.y)), v0[3] * sigmoid_f(bf_hi(g.y)),
                                  v1[0] * sigmoid_f(bf_lo(g.z)), v1[1] * sigmoid_f(bf_hi(g.z)), v1[2] * sigmoid_f(bf_lo(g.w)), v1[3] * sigmoid_f(bf_hi(g.w))};
                    bf16_t* op = O + row * D + col0 + bj * 32;
                    if (ADD) { const u32x4 o = *(const u32x4*)op;
                        r[0] += bf_lo(o.x); r[1] += bf_hi(o.x); r[2] += bf_lo(o.y); r[3] += bf_hi(o.y); r[4] += bf_lo(o.z); r[5] += bf_hi(o.z); r[6] += bf_lo(o.w); r[7] += bf_hi(o.w); }
                    u32x4 w; w.x = cvt_pk_bf16(r[0], r[1]); w.y = cvt_pk_bf16(r[2], r[3]); w.z = cvt_pk_bf16(r[4], r[5]); w.w = cvt_pk_bf16(r[6], r[7]);
                    *(u32x4*)op = w; } }
    }
};
struct EpiX1 {
    static constexpr int PERM = 0; static constexpr bool IDEMP = true;
    const float* X; const float* gate; float* O;
    __device__ __forceinline__ void operator()(const f32x4 (&acc)[2][2][4][2], const Unit& u, int wr, int wc, int fr, int fq) const {
        const int row0 = u.row0 + wr * 64 + fr; const int col0 = u.pn * BM + wc * 32 + 4 * fq; const float* gp = gate + (size_t)(u.row0 / SEQ) * 6 * D;
#pragma unroll
        for (int bj = 0; bj < 2; ++bj)
#pragma unroll
            for (int n = 0; n < 2; ++n) { const int c = col0 + bj * HALF + n * 16; const f32x4 gv = *(const f32x4*)(gp + c);
#pragma unroll
                for (int ai = 0; ai < 2; ++ai)
#pragma unroll
                    for (int m = 0; m < 4; ++m) { const size_t off = (size_t)(row0 + ai * HALF + m * 16) * D + c;
                        const f32x4 xv = *(const f32x4*)(X + off); const f32x4 ov = xv + gv * acc[ai][bj][m][n]; EPI_ST16(O + off, __builtin_bit_cast(u32x4, ov)); } }
    }
};
struct EpiY1 {
    static constexpr int PERM = 3; static constexpr bool IDEMP = true;
    const float* gate; bf16_t* O;
    __device__ __forceinline__ void operator()(const f32x4 (&acc)[2][2][4][2], const Unit& u, int wr, int wc, int fr, int fq) const {
        const int row0 = u.row0 + wr * 64 + fr; const int col0 = u.pn * BM + wc * 64 + 8 * fq; const float* gp = gate + (size_t)(u.row0 / SEQ) * 6 * D + col0;
#pragma unroll
        for (int bj = 0; bj < 2; ++bj) { const f32x4 g0 = *(const f32x4*)(gp + bj * 32), g1 = *(const f32x4*)(gp + bj * 32 + 4);
#pragma unroll
            for (int ai = 0; ai < 2; ++ai)
#pragma unroll
                for (int m = 0; m < 4; ++m) { bf16_t* rowp = O + (size_t)(row0 + ai * HALF + m * 16) * D + col0;
                    const f32x4 v0 = g0 * acc[ai][bj][m][0], v1 = g1 * acc[ai][bj][m][1];
                    u32x4 w; w.x = cvt_pk_bf16(v0[0], v0[1]); w.y = cvt_pk_bf16(v0[2], v0[3]); w.z = cvt_pk_bf16(v1[0], v1[1]); w.w = cvt_pk_bf16(v1[2], v1[3]);
                    EPI_ST16(rowp + bj * 32, w); } }
    }
};
struct EpiRouter {
    static constexpr int PERM = 0; static constexpr bool IDEMP = true;
    float* O;
    __device__ __forceinline__ void operator()(const f32x4 (&acc)[2][2][4][2], const Unit& u, int wr, int wc, int fr, int fq) const {
        const int row0 = u.row0 + wr * 64 + fr; const int ncols = (u.e & 1) ? 64 : 128, coff = ((u.e & 1) ? 128 : 0) + (u.e >> 1) * 192;
#pragma unroll
        for (int n = 0; n < 2; ++n) { const int c = wc * 32 + n * 16 + 4 * fq;
            if (c < ncols) {
#pragma unroll
                for (int ai = 0; ai < 2; ++ai)
#pragma unroll
                    for (int m = 0; m < 4; ++m) *(f32x4*)(O + (size_t)(row0 + ai * HALF + m * 16) * 384 + coff + c) = acc[ai][0][m][n]; } }
    }
};
struct EpiSwiglu {
    static constexpr int PERM = 1; static constexpr bool IDEMP = true;
    bf16_t* O;
    __device__ __forceinline__ void operator()(const f32x4 (&acc)[2][2][4][2], const Unit& u, int wr, int wc, int fr, int fq) const {
        const int row0 = u.row0 + wr * 64 + fr; const int col0 = u.pn * HALF + wc * 32 + 8 * fq;
#pragma unroll
        for (int ai = 0; ai < 2; ++ai)
#pragma unroll
            for (int m = 0; m < 4; ++m) { const f32x4 a0 = acc[ai][0][m][0], a1 = acc[ai][0][m][1], b0 = acc[ai][1][m][0], b1 = acc[ai][1][m][1];
                u32x4 w; w.x = cvt_pk_bf16(silu_f(a0[0]) * b0[0], silu_f(a0[1]) * b0[1]); w.y = cvt_pk_bf16(silu_f(a0[2]) * b0[2], silu_f(a0[3]) * b0[3]);
                w.z = cvt_pk_bf16(silu_f(a1[0]) * b1[0], silu_f(a1[1]) * b1[1]); w.w = cvt_pk_bf16(silu_f(a1[2]) * b1[2], silu_f(a1[3]) * b1[3]);
                EPI_ST16(O + (size_t)(row0 + ai * HALF + m * 16) * DE + col0, w); }
    }
};
constexpr float YB_SCALE = 1.f;
struct EpiFp8 {
    static constexpr int PERM = 2; static constexpr bool IDEMP = true;
    unsigned char* O; int nostore;
    __device__ __forceinline__ void operator()(const f32x4 (&acc)[2][2][4][2], const Unit& u, int wr, int wc, int fr, int fq) const {
        if (nostore == 2) { asm volatile("" :: "v"(acc[0][0][0][0]), "v"(acc[1][1][3][1])); return; }
        const int row0 = u.row0 + wr * 64 + fr; const int col0 = u.pn * BM + wc * 64 + 16 * fq;
#pragma unroll
        for (int ai = 0; ai < 2; ++ai)
#pragma unroll
            for (int m = 0; m < 4; ++m) { unsigned char* rowp = O + (size_t)(row0 + ai * HALF + m * 16) * D + col0; unsigned wv[4];
#pragma unroll
                for (int bj = 0; bj < 2; ++bj) { const f32x4 v0 = acc[ai][bj][m][0], v1 = acc[ai][bj][m][1];
                    int w0 = __builtin_amdgcn_cvt_pk_fp8_f32(v0[0], v0[1], 0, false); w0 = __builtin_amdgcn_cvt_pk_fp8_f32(v0[2], v0[3], w0, true);
                    int w1 = __builtin_amdgcn_cvt_pk_fp8_f32(v1[0], v1[1], 0, false); w1 = __builtin_amdgcn_cvt_pk_fp8_f32(v1[2], v1[3], w1, true);
                    wv[2 * bj] = (unsigned)w0; wv[2 * bj + 1] = (unsigned)w1; }
                if (!nostore) *(u32x4*)rowp = (u32x4){wv[0], wv[1], wv[2], wv[3]};     else asm volatile("" :: "v"(wv[0]), "v"(wv[1]), "v"(wv[2]), "v"(wv[3])); }
    }
};
struct RouterOrder {
    const char* Ahi; const char* Alo; const char* Bx; const char* By; int G, c; int krep = 1;
    __device__ __forceinline__ bool next(int i, Unit& u) const {
        const int L = i * G + c; if (L >= 256) return false;
        const int which = (L >> 6) & 1, kh = L >> 7;
        u.e = which | (kh << 1); u.pm = L & 63; u.pn = 0; u.row0 = u.pm * BM;
        u.A = (which ? Alo : Ahi) + (size_t)u.pm * BM * D * 2 + (size_t)kh * (D / 2) * 2; u.B = (which ? By : Bx) + (size_t)kh * (D / 2) * 2; return true;
    }
    __device__ __forceinline__ const LAS int* list(int) const { return nullptr; }
    __device__ __forceinline__ void a_ready(const Unit&) const {}
    __device__ __forceinline__ void done(const Unit&) const {}
};
struct MoeOrder {
    const char* A; const char* W; const LAS int* tstart; const LAS int* lists; int G, c, npn_shift, a_tile_bytes; size_t w_exp_bytes, w_tile_bytes;
    const LAS int* uexp;
    int krep = 1;
    int L0 = 0, Llim = 0x7fffffff;
    unsigned* done_cnt = nullptr;
    unsigned* ready_cnt = nullptr;
    __device__ __forceinline__ int find_expert(int tile) const {
        int e = 0;
#pragma unroll 1
        for (int step = 32; step > 0; step >>= 1) if (e + step <= 64 && tstart[e + step] <= tile) e += step;
        if (e < 64 && tstart[e + 1] <= tile) e += 1;
        return e;
    }
    __device__ __forceinline__ void fill_table(LAS int* tab, int tid) const {
        if (tid < 32) { const int L = L0 + tid * G + c; const int tile = L >> npn_shift; tab[tid] = (L < Llim && tile < tstart[65]) ? find_expert(tile) : -1; }
    }
    __device__ __forceinline__ bool next(int i, Unit& u) const {
        const int e = i < 32 ? uexp[i] : -1; if (e < 0) return false;
        const int L = L0 + i * G + c; const int tile = L >> npn_shift;
        u.e = e; u.pm = tile; u.pn = L & ((1 << npn_shift) - 1); u.row0 = tile * BM;
        u.A = A + (size_t)tile * a_tile_bytes; u.B = W + (size_t)e * w_exp_bytes + (size_t)u.pn * w_tile_bytes; return true;
    }
    __device__ __forceinline__ const LAS int* list(int i) const { return lists + i * 256; }
    __device__ __forceinline__ void a_ready(const Unit& u) const {
        if (ready_cnt == nullptr) return;
        if (threadIdx.x < 64) {
            unsigned spins = 0;
            while ((unsigned)__builtin_amdgcn_readfirstlane((int)__hip_atomic_load(ready_cnt + u.pm, __ATOMIC_RELAXED, __HIP_MEMORY_SCOPE_AGENT)) < 32u) { __builtin_amdgcn_s_sleep(2); if (++spins > (1u << 20)) break; }
            __builtin_amdgcn_fence(__ATOMIC_ACQUIRE, "agent");
            asm volatile("s_waitcnt vmcnt(0)" ::: "memory");
        }
        asm volatile("" ::: "memory"); __builtin_amdgcn_s_barrier(); asm volatile("" ::: "memory");
    }
    __device__ __forceinline__ void done(const Unit& u) const {
        if (done_cnt != nullptr && (threadIdx.x & 63) == 0) (void)__hip_atomic_fetch_add(done_cnt + u.pm, 1u, __ATOMIC_RELAXED, __HIP_MEMORY_SCOPE_AGENT);
    }
};
}

__device__ __forceinline__ void p8_norm2(const Frame& F) {
    LAS float* sh = (LAS float*)F.lds; LAS float* sc = sh + D;
    const float* MOD = (const float*)(F.ws + WS_MOD);
    for (int blk = F.bid; blk < NTOK / 64; blk += F.G) {
        const int b = blk / (SEQ / 64);
        __syncthreads();
        for (int i = F.tid; i < D; i += NTHREADS) { sh[i] = MOD[b * 6 * D + 3 * D + i]; sc[i] = (1.f + MOD[b * 6 * D + 4 * D + i]) * F.in[4][i]; }
        __syncthreads();
        for (int j = 0; j < 8; ++j) {
            const int t = blk * 64 + F.wave * 8 + j;
            const f32x4* xr = (const f32x4*)(F.in[0] + (size_t)t * D) + F.lane; const u32x2* yr = (const u32x2*)((const bf16_t*)(F.ws + WS_Y1) + (size_t)t * D) + F.lane;
            f32x4 v[8]; float s = 0.f;
#pragma unroll
            for (int q = 0; q < 8; ++q) { const u32x2 yv = yr[64 * q]; v[q] = xr[64 * q] + (f32x4){bf_lo(yv.x), bf_hi(yv.x), bf_lo(yv.y), bf_hi(yv.y)}; s += (v[q].x * v[q].x + v[q].y * v[q].y) + (v[q].z * v[q].z + v[q].w * v[q].w); }
            const float r = rsqrtf(wave_sum(s) * (1.f / D) + EPS);
            u32x2* oh = (u32x2*)((bf16_t*)(F.ws + WS_HB) + (size_t)t * D) + F.lane;
            u32x2* ol = (u32x2*)((bf16_t*)(F.ws + WS_HLO) + (size_t)t * D) + F.lane;
#pragma unroll
            for (int q = 0; q < 8; ++q) { const int c0 = 4 * F.lane + 256 * q;
                const f32x4 a = *(const LAS f32x4*)(sc + c0), bb = *(const LAS f32x4*)(sh + c0);
                const float y0 = v[q].x * r * a.x + bb.x, y1 = v[q].y * r * a.y + bb.y, y2 = v[q].z * r * a.z + bb.z, y3 = v[q].w * r * a.w + bb.w;
                u32x2 wh; wh.x = pk2(y0, y1); wh.y = pk2(y2, y3);
                u32x2 wl; wl.x = pk2(y0 - bf_lo(wh.x), y1 - bf_hi(wh.x)); wl.y = pk2(y2 - bf_lo(wh.y), y3 - bf_hi(wh.y));
                oh[64 * q] = wh; ol[64 * q] = wl; }
        }
    }
}

__device__ __forceinline__ void p10a_route(const Frame& F) {
    const float* RLOG = (const float*)(F.ws + WS_RLOG); const float* rbias = F.in[17];
    int* TOKE = (int*)(F.ws + WS_TOKE); float* TOKW = (float*)(F.ws + WS_TOKW); int* TOKRANK = (int*)(F.ws + WS_TOKRANK); int* BLKBASE = (int*)(F.ws + WS_BLKBASE);
    LAS int* hist = (LAS int*)F.lds;
    const int e = F.lane; const float rb = rbias[e];
    for (int blk = F.bid; blk < NTOK / 64; blk += F.G) {
        __syncthreads();
        if (F.tid < 64) hist[F.tid] = 0;
        __syncthreads();
        for (int j = 0; j < 8; ++j) {
            const int t = blk * 64 + F.wave * 8 + j;
            const float* rl = RLOG + (size_t)t * 384;
            const float logit = ((rl[e] + rl[192 + e]) + (rl[64 + e] + rl[256 + e])) + (rl[128 + e] + rl[320 + e]);
            const float s = 1.f / (1.f + expf(-logit)), sel = s + rb;
            float m1 = sel;
            m1 = fmaxf(m1, __shfl_xor(m1, 1)); m1 = fmaxf(m1, __shfl_xor(m1, 2)); m1 = fmaxf(m1, __shfl_xor(m1, 4));
            const unsigned long long ismax = __ballot(sel == m1);
            const int firstmax = __ffsll((long long)((ismax >> (e & ~7)) & 0xffull)) - 1 + (e & ~7);
            float m2 = (e == firstmax) ? -3.0e38f : sel;
            m2 = fmaxf(m2, __shfl_xor(m2, 1)); m2 = fmaxf(m2, __shfl_xor(m2, 2)); m2 = fmaxf(m2, __shfl_xor(m2, 4));
            const float gs = m1 + m2; const int g = e >> 3;
            int grank = 0;
#pragma unroll
            for (int g2 = 0; g2 < 8; ++g2) { const float o = __shfl(gs, g2 * 8); grank += (o > gs || (o == gs && g2 < g)) ? 1 : 0; }
            const float cand = grank < 4 ? sel : -1.0e30f;
            int rank = 0;
#pragma unroll
            for (int e2 = 0; e2 < 64; ++e2) { const float o = __shfl(cand, e2); rank += (o > cand || (o == cand && e2 < e)) ? 1 : 0; }
            const bool chosen = rank < 8;
            const float wsum = wave_sum(chosen ? s : 0.f);
            if (chosen) {
                const int lr = __hip_atomic_fetch_add(&hist[e], 1, __ATOMIC_RELAXED, __HIP_MEMORY_SCOPE_WORKGROUP);
                TOKE[t * 8 + rank] = e; TOKW[t * 8 + rank] = s / wsum * 2.5f; TOKRANK[t * 8 + rank] = lr;
            }
        }
        __syncthreads();
        if (F.tid < 64) { const int base = (int)atomicAdd(F.ctl + CW_CNT + F.tid, (unsigned)hist[F.tid]); BLKBASE[blk * 64 + F.tid] = base; }
    }
}
__device__ __forceinline__ void moe_tile_table(const Frame& F, LAS int* tst) {
    __syncthreads();
    if (F.tid == 0) { int o = 0; for (int e = 0; e < 64; ++e) { tst[e] = o; o += ((int)F.ctl[CW_CNT + e] + 255) >> 8; } tst[64] = o; tst[65] = o + NTOK / 256; }
    __syncthreads();
}
__device__ __forceinline__ int moe_tail_units(int T) {
    const int rem = (4 * T) & 255, ntail = rem ? 256 - rem : 0;
    const int R = max(0, (8 * T - TAIL_CAP * ntail + 255) >> 8);
    return max(0, 8 * T - 256 * R);
}
__device__ __forceinline__ void p10b_lists(const Frame& F) {
    const int* TOKE = (const int*)(F.ws + WS_TOKE); const int* TOKRANK = (const int*)(F.ws + WS_TOKRANK); const int* BLKBASE = (const int*)(F.ws + WS_BLKBASE);
    int* TOKPOS = (int*)(F.ws + WS_TOKPOS); int* SRT = (int*)(F.ws + WS_SRT);
    LAS int* tst = (LAS int*)F.lds;
    moe_tile_table(F, tst);
    for (int blk = F.bid; blk < NTOK / 64; blk += F.G) {
        { const int i = blk * 512 + F.tid;
          const int e = TOKE[i], pos = tst[e] * 256 + BLKBASE[blk * 64 + e] + TOKRANK[i];
          SRT[pos] = i >> 3; TOKPOS[i] = pos; }
        if (F.tid < 64) SRT[tst[64] * 256 + blk * 64 + F.tid] = blk * 64 + F.tid;
    }
    for (int e = F.bid; e < 64; e += F.G) {
        const int lo = tst[e] * 256 + (int)F.ctl[CW_CNT + e], hi = tst[e + 1] * 256;
        for (int p = lo + F.tid; p < hi; p += NTHREADS) SRT[p] = 0;
    }
}
__device__ __forceinline__ void p13_combine(const Frame& F) {
    const unsigned char* YB = (const unsigned char*)(F.ws + WS_YB); const int* TOKPOS = (const int*)(F.ws + WS_TOKPOS); const float* TOKW = (const float*)(F.ws + WS_TOKW);
    const float* MOD = (const float*)(F.ws + WS_MOD);
    LAS int* tst = (LAS int*)F.lds;
    moe_tile_table(F, tst);
    const int sh0 = tst[64] * 256;
    const int gw = F.bid * NWAVES + F.wave, NGW = F.G * NWAVES;
    for (int t = gw; t < NTOK; t += NGW) {
        const int b = t / SEQ;
        int pos[9]; float wk[9];
#pragma unroll
        for (int k = 0; k < 8; ++k) { pos[k] = TOKPOS[t * 8 + k]; wk[k] = TOKW[t * 8 + k] * (1.f / pg8::YB_SCALE); }
        pos[8] = sh0 + t; wk[8] = 1.f / pg8::YB_SCALE;
        float* orow = F.out + (size_t)t * D; const float* g2 = MOD + (size_t)b * 6 * D + 5 * D; const float* xrow = F.in[0] + (size_t)t * D; const bf16_t* yrow = (const bf16_t*)(F.ws + WS_Y1) + (size_t)t * D;
#pragma unroll 2
        for (int q = 0; q < 8; ++q) { const int c = 4 * F.lane + 256 * q;
            float a0 = 0.f, a1 = 0.f, a2 = 0.f, a3 = 0.f;
#pragma unroll
            for (int k = 0; k < 9; ++k) { const int y = *(const int*)(YB + (size_t)pos[k] * D + c);
                const f32x2 lo = __builtin_amdgcn_cvt_pk_f32_fp8(y, false), hi2 = __builtin_amdgcn_cvt_pk_f32_fp8(y, true);
                a0 += wk[k] * lo.x; a1 += wk[k] * lo.y; a2 += wk[k] * hi2.x; a3 += wk[k] * hi2.y; }
            const u32x2 yv = *(const u32x2*)(yrow + c); const f32x4 xv = *(const f32x4*)(xrow + c) + (f32x4){bf_lo(yv.x), bf_hi(yv.x), bf_lo(yv.y), bf_hi(yv.y)}, gv = *(const f32x4*)(g2 + c);
            *(f32x4*)(orow + c) = (f32x4){xv.x + gv.x * a0, xv.y + gv.y * a1, xv.z + gv.z * a2, xv.w + gv.w * a3}; }
    }
}
constexpr int N_PHASES = 16;
__global__ void __launch_bounds__(NTHREADS, 2) mk_fwd(Args args) {
    extern __shared__ __attribute__((aligned(16))) unsigned char lds_raw[];
    Frame F;
    F.lds = (LAS unsigned char*)lds_raw; F.ws = args.ws; F.ctl = (unsigned*)(args.ws + WS_CTL); F.in = args.in; F.out = args.out;
    F.tid = threadIdx.x; F.lane = F.tid & 63; F.wave = __builtin_amdgcn_readfirstlane(F.tid >> 6); F.G = gridDim.x; F.bid = blockIdx.x;
    volatile LAS unsigned* MISC = (volatile LAS unsigned*)(F.lds + MISC_OFF);
    if (F.tid < 64) MISC[F.tid] = 0u;
    __syncthreads();
    const int vcu = (F.G % 8 == 0) ? (F.bid & 7) * (F.G >> 3) + (F.bid >> 3) : F.bid;
    const int lo = args.ph_lo, hi = args.ph_hi;
    const bool need_bar = (hi - lo) > 1;
    XcdBarrier bar; bar.bar = F.ctl + CW_BAR + args.bar_region * XCD_BAR_WORDS; bar.x = 0; bar.st = MISC + 8;
    if (need_bar) bar = xcd_barrier_post(F.ctl + CW_BAR + args.bar_region * XCD_BAR_WORDS, MISC + 8);
#define IN(k) (lo <= (k) && (k) < hi)
#define SEAM(k) do { if (IN(k) && IN((k) + 1)) xcd_barrier(bar); } while (0)
#ifndef DUP_MASK
#define DUP_MASK 0
#endif
#define PHASE_NOSEAM(k, ...) if (IN(k)) { __VA_ARGS__ if ((DUP_MASK >> (k)) & 1) { xcd_barrier(bar); __VA_ARGS__ } }
#define PHASE(k, ...) if (IN(k)) { __VA_ARGS__ if ((DUP_MASK >> (k)) & 1) { xcd_barrier(bar); __VA_ARGS__ } } SEAM(k);

    PHASE(0, p0_prologue(F);)
    PHASE(1, p1_norm1(F);)
#ifdef CVT_XCD
    PHASE(2,  if (F.G != 256) { pg8::PlainOrder S; S.init(F.ws + WS_HB, F.ws + WS_WINT, NTOK, TOTP, D, F.G, F.bid); pg8::EpiBf16 E{(bf16_t*)(F.ws + WS_PROJ), TOTP}; pg8::gemm_phase<pg8::EpiBf16, pg8::PlainOrder, false>(F.lds, D, S, E); cvt_run<true>(F, NITEMS_EXP, 0, F.G); }
        else { const int xcd = F.bid & 7, jx = F.bid >> 3;
            int wg0 = 0, it0 = 0, nu = 0, it1 = 0;
            { int wacc = 0, iacc = 0;
              for (int x = 0; x < 8; ++x) { const int n_x = (P2_NU >> (4 * x)) & 15; const int q_x = (int)(((long long)NITEMS_EXP * ((P2_CV >> (4 * x)) & 15)) / P2_CVSUM);
                  if (x == xcd) { wg0 = wacc; nu = n_x; it0 = iacc; it1 = (x == 7) ? NITEMS_EXP : iacc + q_x; } wacc += 32 * n_x; iacc += q_x; } }
            { Frame Fx = F; Fx.bid = jx; cvt_run<true>(Fx, it1, 0, 32, it0); }
            pg8::XcdRunOrder S; S.A = (const char*)(F.ws + WS_HB); S.Bt = (const char*)(F.ws + WS_WINT); S.K = D; S.nM = NTOK / 256; S.nN = TOTP / 256; S.wg0 = wg0; S.wpx = 32; S.j = jx; S.nu = nu;
            pg8::EpiBf16 E{(bf16_t*)(F.ws + WS_PROJ), TOTP}; pg8::gemm_phase<pg8::EpiBf16, pg8::XcdRunOrder, false>(F.lds, D, S, E); })
#elif defined(CVT_OVERLAP) && !defined(CVT_IN_ATTN) && !defined(CVT_P0_ON)
    PHASE(2,  constexpr int NU = (NTOK / 256) * (TOTP / 256);
        if (F.G <= CVT_NG) { pg8::PlainOrder S; S.init(F.ws + WS_HB, F.ws + WS_WINT, NTOK, TOTP, D, F.G, F.bid); pg8::EpiBf16 E{(bf16_t*)(F.ws + WS_PROJ), TOTP}; pg8::gemm_phase<pg8::EpiBf16, pg8::PlainOrder, false>(F.lds, D, S, E); cvt_run<true>(F, NITEMS_EXP, 0, F.G); }
        else { pg8::PlainOrder S; pg8::EpiBf16 E{(bf16_t*)(F.ws + WS_PROJ), TOTP};
            if (F.bid < CVT_NG) {
#if defined(STAG2) && STAG2 > 0
                { const unsigned long long t0_ = __builtin_amdgcn_s_memrealtime(); const unsigned long long dl_ = (unsigned long long)((F.bid & 7) * STAG2); while (__builtin_amdgcn_s_memrealtime() - t0_ < dl_) __builtin_amdgcn_s_sleep(8); }
#endif
                S.init(F.ws + WS_HB, F.ws + WS_WINT, NTOK, TOTP, D, CVT_NG, F.bid);
#ifdef KREP_P2
 S.krep = KREP_P2;
#endif
 S.Lend = CVT_NG * CVT_UG < NU ? CVT_NG * CVT_UG : NU; }
            else { cvt_run<true>(F, NITEMS_EXP, CVT_NG, F.G - CVT_NG); S.init(F.ws + WS_HB, F.ws + WS_WINT, NTOK, TOTP, D, F.G - CVT_NG, F.bid - CVT_NG); S.L0 = CVT_NG * CVT_UG < NU ? CVT_NG * CVT_UG : NU; }

#ifdef P2X
            if (F.bid < CVT_NG) { pg8::EpiBf16 E0{(bf16_t*)(F.ws + WS_PROJ), TOTP, P2X == 1 ? 1 : 0}; pg8::gemm_phase<pg8::EpiBf16, pg8::PlainOrder, false>(F.lds, D, S, E0); }
#endif
            pg8::gemm_phase<pg8::EpiBf16, pg8::PlainOrder, false>(F.lds, D, S, E); })
#else
    PHASE(2,  pg8::PlainOrder S; S.init(F.ws + WS_HB, F.ws + WS_WINT, NTOK, TOTP, D, F.G, F.bid); pg8::EpiBf16 E{(bf16_t*)(F.ws + WS_PROJ), TOTP}; pg8::gemm_phase<pg8::EpiBf16, pg8::PlainOrder, false>(F.lds, D, S, E);)
#endif
    PHASE(3, p3_mix(F);)
#ifdef CVT_IN_ATTN
    PHASE(4, if (F.G <= CVT_NG2) { p4_index(F); cvt_run<true>(F, CVT_SPLIT, 0, F.G); } else if (F.bid < CVT_NG2) { Frame Fg = F; Fg.G = CVT_NG2; p4_index(Fg); } else { cvt_run<true>(F, CVT_SPLIT, CVT_NG2, F.G - CVT_NG2); })
    PHASE(5, if (F.G <= CVT_NG2) { p5_attn(F); cvt_run<true>(F, NITEMS_EXP, 0, F.G, CVT_SPLIT); } else if (F.bid < CVT_NG2) { Frame Fg = F; Fg.G = CVT_NG2; p5_attn(Fg); } else { cvt_run<true>(F, NITEMS_EXP, CVT_NG2, F.G - CVT_NG2, CVT_SPLIT); })
#else
    PHASE(4, p4_index(F);)
    PHASE(5, p5_attn(F);)
#endif
    PHASE_NOSEAM(6,  pg8::PlainOrder S; S.init(F.ws + WS_UMIX, F.ws + WS_WCVT, NTOK, D, CW, F.G, F.bid); pg8::EpiGate<false> E{(const bf16_t*)(F.ws + WS_PROJ) + O_GA, TOTP, (bf16_t*)(F.ws + WS_HB)}; pg8::gemm_phase<pg8::EpiGate<false>, pg8::PlainOrder, false>(F.lds, CW, S, E);)
    PHASE(7,  pg8::PlainOrder S; S.init(F.ws + WS_AO, F.ws + WS_WATT, NTOK, D, AW, F.G, F.bid); pg8::EpiGate<true> E{(const bf16_t*)(F.ws + WS_PROJ) + O_GB, TOTP, (bf16_t*)(F.ws + WS_HB)}; pg8::gemm_phase<pg8::EpiGate<true>, pg8::PlainOrder, false>(F.lds, AW, S, E);)
    PHASE(8,  pg8::PlainOrder S; S.init(F.ws + WS_HB, F.ws + WS_WOT, NTOK, D, D, F.G, F.bid); pg8::EpiY1 E{(const float*)(F.ws + WS_MOD) + 2 * D, (bf16_t*)(F.ws + WS_Y1)}; pg8::gemm_phase<pg8::EpiY1, pg8::PlainOrder, false>(F.lds, D, S, E);)
    PHASE(9, p8_norm2(F);)
    PHASE(10,  pg8::RouterOrder S{(const char*)(F.ws + WS_HB), (const char*)(F.ws + WS_HLO), (const char*)(F.ws + WS_WRX), (const char*)(F.ws + WS_WRY), F.G, F.bid}; pg8::EpiRouter E{(float*)(F.ws + WS_RLOG)}; pg8::gemm_phase<pg8::EpiRouter, pg8::RouterOrder, false>(F.lds, D / 2, S, E, D);)
    PHASE(11, p10a_route(F);)
    PHASE(12, p10b_lists(F);)
    PHASE(13,  LAS int* tst = (LAS int*)(F.lds + LIST_OFF + 11264); LAS int* lists = (LAS int*)(F.lds + LIST_OFF); moe_tile_table(F, tst); const int* SRT = (const int*)(F.ws + WS_SRT); for (int i = 0; i < 11; ++i) { const int tile = (i * F.G + vcu) >> 2; if (tile >= tst[65]) break; if (F.tid < 256) lists[i * 256 + F.tid] = SRT[tile * 256 + F.tid]; } __syncthreads(); pg8::MoeOrder S{(const char*)(F.ws + WS_HB), (const char*)(F.ws + WS_W13T), tst, lists, F.G, vcu, 2, 0, (size_t)1024 * D * 2, (size_t)256 * D * 2, tst + 96}; S.fill_table(tst + 96, F.tid); __syncthreads(); S.Llim = 4 * tst[65]; S.done_cnt = F.ctl + CW_TDONE; pg8::EpiSwiglu E{(bf16_t*)(F.ws + WS_HH)}; pg8::gemm_phase<pg8::EpiSwiglu, pg8::MoeOrder, true>(F.lds, D, S, E);
               { const int T_ = tst[65], rem_ = (4 * T_) & 255, ntail_ = rem_ ? 256 - rem_ : 0; const int M_ = moe_tail_units(T_);
                 if (M_ > 0 && vcu >= rem_) { pg8::MoeOrder S2{(const char*)(F.ws + WS_HH), (const char*)(F.ws + WS_W2T), tst, nullptr, ntail_, vcu - rem_, 3, 256 * DE * 2, (size_t)D * DE * 2, (size_t)256 * DE * 2, tst + 128}; S2.Llim = M_; S2.ready_cnt = F.ctl + CW_TDONE;
                   S2.fill_table(tst + 128, F.tid); __syncthreads(); pg8::EpiFp8 E2{(unsigned char*)(F.ws + WS_YB), 0}; pg8::gemm_phase<pg8::EpiFp8, pg8::MoeOrder, false>(F.lds, DE, S2, E2); } })
#ifndef STAG14
#define STAG14 0
#endif
    PHASE(14,  if (STAG14 && vcu >= 8) { const unsigned long long t0_ = __builtin_amdgcn_s_memrealtime(); const unsigned long long dl_ = (unsigned long long)((vcu & 7) * STAG14); while (__builtin_amdgcn_s_memrealtime() - t0_ < dl_) __builtin_amdgcn_s_sleep(8); }
               LAS int* tst = (LAS int*)(F.lds + LIST_OFF + 11264); moe_tile_table(F, tst); pg8::MoeOrder S{(const char*)(F.ws + WS_HH), (const char*)(F.ws + WS_W2T), tst, nullptr, F.G, vcu, 3, 256 * DE * 2, (size_t)D * DE * 2, (size_t)256 * DE * 2, tst + 96}; S.L0 = moe_tail_units(tst[65]); S.Llim = 8 * tst[65]; S.fill_table(tst + 96, F.tid); __syncthreads(); pg8::EpiFp8 E{(unsigned char*)(F.ws + WS_YB), 0};
#if defined(P14X)
               { pg8::EpiFp8 E0{(unsigned char*)(F.ws + WS_YB), P14X == 1 ? 1 : (P14X == 3 ? 2 : 0)}; pg8::gemm_phase<pg8::EpiFp8, pg8::MoeOrder, false>(F.lds, DE, S, E0); xcd_barrier(bar); }
#endif
               pg8::gemm_phase<pg8::EpiFp8, pg8::MoeOrder, false>(F.lds, DE, S, E);)
#ifdef P15_DELAY
    PHASE(15, { const unsigned long long t0_ = __builtin_amdgcn_s_memrealtime(); while (__builtin_amdgcn_s_memrealtime() - t0_ < (unsigned long long)P15_DELAY) __builtin_amdgcn_s_sleep(8); } p13_combine(F);)
#else
    PHASE(15, p13_combine(F);)
#endif
#undef IN
#undef SEAM
}

static int g_grid = 0;
static bool mk_setup(size_t ws_size) {
    if (g_grid == 0) {
        if (ws_size < WS_END) { fprintf(stderr, "kernel_launch: workspace too small: %zu < %zu\n", ws_size, (size_t)WS_END); g_grid = -1; return false; }
        int dev = 0, cus = 0, per_cu = 0;
        if (hipGetDevice(&dev) != hipSuccess || hipDeviceGetAttribute(&cus, hipDeviceAttributeMultiprocessorCount, dev) != hipSuccess) { g_grid = -1; return false; }
        if (hipFuncSetAttribute((const void*)mk_fwd, hipFuncAttributeMaxDynamicSharedMemorySize, LDS_BYTES) != hipSuccess) { fprintf(stderr, "kernel_launch: hipFuncSetAttribute failed\n"); g_grid = -1; return false; }
        if (hipOccupancyMaxActiveBlocksPerMultiprocessor(&per_cu, (const void*)mk_fwd, NTHREADS, LDS_BYTES) != hipSuccess || per_cu < 1) { fprintf(stderr, "kernel_launch: occupancy query says %d\n", per_cu); }
        (void)hipGetLastError();
        g_grid = cus;
    }
    return g_grid > 0;
}
static void mk_launch(const Args& a0, int lo, int hi, int region, hipStream_t stream) {
    Args a = a0; a.ph_lo = lo; a.ph_hi = hi; a.bar_region = region;
    hipLaunchKernelGGL(mk_fwd, dim3(g_grid), dim3(NTHREADS), LDS_BYTES, stream, a);
}
#ifndef MK_N_LAUNCHES
#define MK_N_LAUNCHES 1
#endif
extern "C" void kernel_launch(void* const* d_in, const int* in_sizes, int n_in, void* d_out, int out_size, void* d_ws, size_t ws_size, hipStream_t stream) {
    if (!mk_setup(ws_size)) return;
    (void)hipMemsetAsync((char*)d_ws + WS_CTL, 0, CTL_ZERO_BYTES, stream);
    Args a{};
    for (int i = 0; i < 24; ++i) a.in[i] = (const float*)d_in[i];
    a.out = (float*)d_out; a.ws = (unsigned char*)d_ws;
    if (MK_N_LAUNCHES == 1) mk_launch(a, 0, N_PHASES, 0, stream);
    else for (int p = 0; p < N_PHASES; ++p) mk_launch(a, p, p + 1, 0, stream);
}
```

```cpp
#include <hip/hip_runtime.h>
#define CVT_OVERLAP 1
#ifndef P2_NU
#define P2_NU 0x679AABCDull
#endif
#ifndef P2_CV
#define P2_CV 0xA9644210ull
#endif
#define P2_CVSUM (((P2_CV >> 0) & 15) + ((P2_CV >> 4) & 15) + ((P2_CV >> 8) & 15) + ((P2_CV >> 12) & 15) + ((P2_CV >> 16) & 15) + ((P2_CV >> 20) & 15) + ((P2_CV >> 24) & 15) + ((P2_CV >> 28) & 15))
#ifndef CVT_UG
#define CVT_UG 13
#endif
#ifndef CVT_NG2
#define CVT_NG2 216
#endif
#ifndef CVT_SPLIT
#define CVT_SPLIT 47000
#endif
#ifndef CVT_NG
#define CVT_NG 192
#endif
#include <cstdint>
#include <cstdio>

#define LAS __attribute__((address_space(3)))
#define GAS __attribute__((address_space(1)))
typedef unsigned short bf16_t;
typedef short bf16x8 __attribute__((ext_vector_type(8)));
typedef short bf16x4 __attribute__((ext_vector_type(4)));
typedef float f32x2 __attribute__((ext_vector_type(2)));
typedef float f32x4 __attribute__((ext_vector_type(4)));
typedef float f32x16 __attribute__((ext_vector_type(16)));
typedef unsigned u32x2 __attribute__((ext_vector_type(2)));
typedef unsigned u32x4 __attribute__((ext_vector_type(4)));

constexpr int D = 2048, BATCH = 4, SEQ = 4096, NTOK = BATCH * SEQ;
constexpr int CW = 1024, NH = 16, NKV = 4, HD = 64, AW = 1024, KVW = 256, IH = 16, IDIM = 64, NSEL = 256;
constexpr int NE = 64, TOPK = 8, DE = 512;
constexpr int TOT = 9808, TOTP = 9984;
constexpr int O_CB = 0, O_CC = 1024, O_CU = 2048, O_Q = 3072, O_K = 4096, O_V = 4352, O_QI = 4608, O_KI = 5632, O_WI = 5696, O_GA = 5712, O_GB = 7760;
constexpr float EPS = 1e-6f;
constexpr int MAXPOS = NTOK * 8 + NE * 256 + NTOK;
constexpr int SH_POS0 = NTOK * 8 + NE * 256;

__device__ __forceinline__ unsigned f2bf(float f) { unsigned u = __builtin_bit_cast(unsigned, f); return (u + 0x7fffu + ((u >> 16) & 1u)) >> 16; }
__device__ __forceinline__ unsigned pk2(float lo, float hi) { return f2bf(lo) | (f2bf(hi) << 16); }
typedef __bf16 bf16x2_hw __attribute__((ext_vector_type(2)));
__device__ __forceinline__ unsigned cvt_pk_bf16(float lo, float hi) { const f32x2 v = {lo, hi}; const bf16x2_hw b = __builtin_convertvector(v, bf16x2_hw); return __builtin_bit_cast(unsigned, b); }
__device__ __forceinline__ float bf_lo(unsigned w) { return __builtin_bit_cast(float, w << 16); }
__device__ __forceinline__ float bf_hi(unsigned w) { return __builtin_bit_cast(float, w & 0xffff0000u); }
__device__ __forceinline__ float bf2f(bf16_t h) { return __builtin_bit_cast(float, (unsigned)h << 16); }
__device__ __forceinline__ float sigmoid_f(float x) { return __builtin_amdgcn_rcpf(1.f + __expf(-x)); }
__device__ __forceinline__ float silu_f(float x) { return x * __builtin_amdgcn_rcpf(1.f + __expf(-x)); }
__device__ __forceinline__ float wave_sum(float v) {
#pragma unroll
    for (int o = 1; o < 64; o <<= 1) v += __shfl_xor(v, o);
    return v;
}
#ifndef EPI_PLAIN_STORES
#define EPI_ST16(ptr_, v_) asm volatile("global_store_dwordx4 %0, %1, off sc1" :: "v"(ptr_), "v"(v_) : "memory")
#else
#define EPI_ST16(ptr_, v_) (*(u32x4*)(ptr_) = (v_))
#endif
#define LDS_WAIT() asm volatile("s_waitcnt lgkmcnt(0)" ::: "memory")
#define VM_WAIT() asm volatile("s_waitcnt vmcnt(0)" ::: "memory")

#define XB_TMO      128
#define XB_XCNT(j)  (256  + 64 * (j))
#define XB_XSUB(j)  (1280 + 64 * (j))
#define XB_XGEN(j)  (2304 + 64 * (j))
#define XB_TOP      3328
#define XB_TOPGEN   3392
#define XCD_BAR_WORDS 3456
#define XB_SPIN_CAP (1u << 22)

__device__ __forceinline__ unsigned xb_ld(unsigned* p)              { return __hip_atomic_load(p, __ATOMIC_RELAXED, __HIP_MEMORY_SCOPE_AGENT); }
__device__ __forceinline__ unsigned xb_add(unsigned* p, unsigned v) { return __hip_atomic_fetch_add(p, v, __ATOMIC_RELAXED, __HIP_MEMORY_SCOPE_AGENT); }
__device__ __forceinline__ unsigned xb_xcc_id() { return (unsigned)__builtin_amdgcn_s_getreg((3 << 11) | 20) & 0xFu; }
#define XB_SPIN(cond, bar) do { unsigned _sp = 0; while (cond) { __builtin_amdgcn_s_sleep(1); \
    if ((++_sp & 255u) == 0u) { if (xb_ld(&(bar)[XB_TMO])) break; if (_sp > XB_SPIN_CAP) { atomicAdd(&(bar)[XB_TMO], 1u); break; } } } } while (0)

struct XcdBarrier { unsigned* bar; unsigned x; volatile LAS unsigned* st; };

__device__ __forceinline__ XcdBarrier xcd_barrier_post(unsigned* bar, volatile LAS unsigned* st) {
    XcdBarrier b; b.bar = bar; b.x = xb_xcc_id(); b.st = st;
    if (threadIdx.x == 0) (void)xb_add(&bar[XB_XCNT(b.x)], 1u);
    return b;
}
__device__ __forceinline__ void xcd_barrier_complete(unsigned* bar, unsigned x, unsigned& nloc, unsigned& nx) {
    const unsigned G = gridDim.x * gridDim.y * gridDim.z;
    unsigned sum, cnt, mine, sp = 0u;
    for (;;) {
        sum = 0u; cnt = 0u; mine = 0u;
#pragma unroll
        for (unsigned j = 0; j < 16; ++j) { const unsigned c = xb_ld(&bar[XB_XCNT(j)]); sum += c; cnt += (c > 0u) ? 1u : 0u; mine = (j == x) ? c : mine; }
        if (sum == G) break;
        __builtin_amdgcn_s_sleep(1);
        if ((++sp & 255u) == 0u) { if (xb_ld(&bar[XB_TMO])) break; if (sp > XB_SPIN_CAP) { atomicAdd(&bar[XB_TMO], 1u); break; } }
    }
    nloc = mine > 0u ? mine : 1u; nx = cnt > 0u ? cnt : 1u;
}
__device__ __forceinline__ void xcd_barrier(const XcdBarrier& b) {
    asm volatile("s_waitcnt vmcnt(0)" ::: "memory");
    __syncthreads();
    if (threadIdx.x == 0) {
        unsigned* bar = b.bar;
        __builtin_amdgcn_s_waitcnt(0);
        unsigned nloc = b.st[0], nx = b.st[1];
        if (nloc == 0u) { xcd_barrier_complete(bar, b.x, nloc, nx); b.st[0] = nloc; b.st[1] = nx; }
        const unsigned old = xb_add(&bar[XB_XSUB(b.x)], 1u);
        const unsigned gen = old / nloc;
        if (old + 1u == (gen + 1u) * nloc) {
            __builtin_amdgcn_fence(__ATOMIC_RELEASE, "agent");
            asm volatile("s_waitcnt vmcnt(0)" ::: "memory");
            const unsigned og = xb_add(&bar[XB_TOP], 1u);
            const unsigned tg = og / nx;
            if (og + 1u == (tg + 1u) * nx) xb_add(&bar[XB_TOPGEN], 1u);
            else XB_SPIN(xb_ld(&bar[XB_TOPGEN]) == tg, bar);
            __builtin_amdgcn_fence(__ATOMIC_ACQUIRE, "agent");
            xb_add(&bar[XB_XGEN(b.x)], 1u);
            asm volatile("s_waitcnt vmcnt(0)" ::: "memory");
        } else {
            XB_SPIN(xb_ld(&bar[XB_XGEN(b.x)]) == gen, bar);
            __builtin_amdgcn_fence(__ATOMIC_ACQUIRE, "agent");
            asm volatile("s_waitcnt vmcnt(0)" ::: "memory");
        }
    }
    __syncthreads();
}

namespace pg8 {
constexpr int BM = 256, BK = 64, HALF = 128, HTB = HALF * BK * 2, STAGE_BYTES = 8 * HTB;
__host__ __device__ __forceinline__ int lds_byte(int r, int c) { const int st = (r >> 4) * 2 + (c >> 5), rr = r & 15, cc = c & 31, ob = rr * 64 + cc * 2; return st * 1024 + (ob ^ (((ob >> 9) & 1) << 5)); }
__host__ __device__ __forceinline__ void stage_rc(int b, int& R, int& C) { const int st = b / 1024, sb = b % 1024, swz = sb ^ (((sb >> 9) & 1) << 5); R = (st >> 1) * 16 + swz / 64; C = (st & 1) * 32 + (swz % 64) / 2; }
__host__ __device__ __forceinline__ int perm32(int rho) { const int n = rho >> 4, i = rho & 15; return 8 * (i >> 2) + 4 * n + (i & 3); }

struct Unit { const char* A; const char* B; int pm, pn, e, row0; };

template <class Epi, class Sched, bool GATHER>
__device__ __forceinline__ void gemm_phase(LAS unsigned char* lds, const int K, const Sched& S, const Epi& E, const int LD = 0) {
    const int tid = threadIdx.x, wid = __builtin_amdgcn_readfirstlane(tid >> 6), lane = tid & 63, wr = wid >> 2, wc = wid & 3, fr = lane & 15, fq = lane >> 4;
    const int nt = K / BK; const int PK = LD ? LD : K;
    unsigned voffA[2][2], voffB[2][2]; int RA[2], CA2[2];
#pragma unroll
    for (int i = 0; i < 2; ++i) { int R, C; stage_rc(tid * 16 + i * 8192, R, C);
        RA[i] = R; CA2[i] = C * 2;
#pragma unroll
        for (int bj = 0; bj < 2; ++bj) { const int Rb = (int)Epi::PERM == 2 ? (64 * (R >> 5) + 16 * ((R >> 2) & 3) + 8 * bj + 4 * ((R >> 4) & 1) + (R & 3))
                                                       : (int)Epi::PERM == 3 ? (64 * (R >> 5) + 32 * bj + 8 * ((R >> 2) & 3) + 4 * ((R >> 4) & 1) + (R & 3))
                                                       : ((int)Epi::PERM == 1 ? ((R & ~31) + perm32(R & 31)) : R) + bj * HALF;
            voffB[bj][i] = (unsigned)(Rb * PK + C) * 2u; }
        voffA[0][i] = (unsigned)(R * PK + C) * 2u; voffA[1][i] = (unsigned)((R + HALF) * PK + C) * 2u; }
    const size_t kstep = (size_t)(BK * 2);
    const unsigned ldsw = (unsigned)wid * 1024u;
    const int aoff = lds_byte(wr * 64 + fr, fq * 8), boff = lds_byte(wc * 32 + fr, fq * 8);
#define PG8_SA(b, h) (((b) * 2 + (h)) * HTB)
#define PG8_SB(b, h) ((4 + (b) * 2 + (h)) * HTB)
#define PG8_STAGE(bufoff, gbase, voff) do { _Pragma("unroll") for (int _i = 0; _i < 2; ++_i) \
        __builtin_amdgcn_global_load_lds((const unsigned*)((const char*)(gbase) + (voff)[_i]), (LAS unsigned*)(lds + (bufoff) + ldsw + _i * 8192), 16, 0, 0); } while (0)
#define PG8_LDA(dst, b, h) do { _Pragma("unroll") for (int m = 0; m < 4; ++m) _Pragma("unroll") for (int k = 0; k < 2; ++k) dst[m][k] = *(const LAS bf16x8*)(lds + PG8_SA(b, h) + aoff + m * 2048 + k * 1024); } while (0)
#define PG8_LDB(dst, b, h) do { _Pragma("unroll") for (int n = 0; n < 2; ++n) _Pragma("unroll") for (int k = 0; k < 2; ++k) dst[n][k] = *(const LAS bf16x8*)(lds + PG8_SB(b, h) + boff + n * 2048 + k * 1024); } while (0)
#define PG8_MMA(ai, bj, At, Bt) do { __builtin_amdgcn_s_setprio(1); _Pragma("unroll") for (int m = 0; m < 4; ++m) _Pragma("unroll") for (int n = 0; n < 2; ++n) _Pragma("unroll") for (int k = 0; k < 2; ++k) \
        acc[ai][bj][m][n] = __builtin_amdgcn_mfma_f32_16x16x32_bf16(Bt[n][k], At[m][k], acc[ai][bj][m][n], 0, 0, 0); __builtin_amdgcn_s_setprio(0); } while (0)
#define PG8_WAIT_V(n) asm volatile("s_waitcnt vmcnt(" #n ")" ::: "memory")
#define PG8_WAIT_L(n) asm volatile("s_waitcnt lgkmcnt(" #n ")" ::: "memory")
#define PG8_BAR __builtin_amdgcn_s_barrier()
#define PG8_SCHED __builtin_amdgcn_sched_barrier(0)
#define PG8_GLIST(ui_) do { if constexpr (GATHER) { const LAS int* L_ = S.list(ui_); _Pragma("unroll") for (int h_ = 0; h_ < 2; ++h_) _Pragma("unroll") for (int i_ = 0; i_ < 2; ++i_) \
        voffA[h_][i_] = (unsigned)L_[h_ * HALF + RA[i_]] * (unsigned)(PK * 2) + (unsigned)CA2[i_]; } } while (0)
    Unit cur, nxt; int ui = 0;
    PG8_WAIT_V(0); __syncthreads();
    if (!S.next(0, cur)) return;
    S.a_ready(cur);
    Unit prevu = cur; bool have_prev = false;
    PG8_GLIST(0);
    f32x4 acc[2][2][4][2];
#pragma unroll
    for (int a = 0; a < 2; ++a)
#pragma unroll
        for (int b = 0; b < 2; ++b)
#pragma unroll
            for (int m = 0; m < 4; ++m)
#pragma unroll
                for (int n = 0; n < 2; ++n) acc[a][b][m][n] = (f32x4){0.f, 0.f, 0.f, 0.f};
    bf16x8 At[4][2], B0[2][2], B1[2][2];
    const char* cA = cur.A; const char* cB = cur.B;
    PG8_STAGE(PG8_SB(0, 0), cB, voffB[0]); PG8_STAGE(PG8_SB(0, 1), cB, voffB[1]); PG8_STAGE(PG8_SA(0, 0), cA, voffA[0]); PG8_STAGE(PG8_SA(0, 1), cA, voffA[1]);
    if (wr == 1) PG8_BAR;
    PG8_WAIT_V(2); PG8_BAR;
    PG8_STAGE(PG8_SB(1, 0), cB + kstep, voffB[0]); PG8_STAGE(PG8_SA(1, 0), cA + kstep, voffA[0]); PG8_STAGE(PG8_SB(1, 1), cB + kstep, voffB[1]);
    PG8_WAIT_V(6); PG8_BAR;
    for (;;) {
        const bool has_next = S.next(ui + 1, nxt);
        const char* nA = has_next ? nxt.A : cA; const char* nB = has_next ? nxt.B : cB;
#ifndef KREP
#define KREP 1
#endif
        const int krep_ = S.krep > 1 ? S.krep : KREP;
#pragma unroll 1
        for (int kr_ = 0; kr_ < krep_; ++kr_) {
        if (kr_) {
#pragma unroll
            for (int a = 0; a < 2; ++a)
#pragma unroll
                for (int b = 0; b < 2; ++b)
#pragma unroll
                    for (int m = 0; m < 4; ++m)
#pragma unroll
                        for (int n = 0; n < 2; ++n) acc[a][b][m][n] = (f32x4){0.f, 0.f, 0.f, 0.f};
        }
        for (int t = 0; t < nt; t += 2) {
            const bool lastt = (t == nt - 2), last = lastt && (kr_ == krep_ - 1);
            if (lastt && !last) {   }
            const char* a1 = cA + (size_t)(t + 1) * kstep;
            const char* a2 = last ? nA : (lastt ? cA : cA + (size_t)(t + 2) * kstep); const char* b2 = last ? nB : (lastt ? cB : cB + (size_t)(t + 2) * kstep);
            const char* a3 = a2 + kstep; const char* b3 = b2 + kstep;
            if (last && has_next) S.a_ready(nxt);
            PG8_LDB(B0, 0, 0); PG8_LDB(B1, 0, 1); PG8_SCHED; PG8_LDA(At, 0, 0); PG8_STAGE(PG8_SA(1, 1), a1, voffA[1]);
            if (GATHER && last && has_next) { PG8_GLIST(ui + 1); }
            PG8_WAIT_V(8); PG8_WAIT_L(0); PG8_BAR; PG8_MMA(0, 0, At, B0); PG8_MMA(0, 1, At, B1); PG8_BAR; PG8_SCHED;
            PG8_LDA(At, 0, 1); PG8_STAGE(PG8_SB(0, 0), b2, voffB[0]); PG8_STAGE(PG8_SB(0, 1), b2, voffB[1]); PG8_STAGE(PG8_SA(0, 0), a2, voffA[0]);
            PG8_WAIT_V(8); PG8_WAIT_L(0); PG8_BAR; PG8_MMA(1, 0, At, B0); PG8_MMA(1, 1, At, B1); PG8_BAR; PG8_SCHED;
            PG8_LDB(B0, 1, 0); PG8_LDB(B1, 1, 1); PG8_SCHED; PG8_LDA(At, 1, 0); PG8_STAGE(PG8_SA(0, 1), a2, voffA[1]);
            PG8_WAIT_V(8); PG8_WAIT_L(0); PG8_BAR; PG8_MMA(0, 0, At, B0); PG8_MMA(0, 1, At, B1); PG8_BAR; PG8_SCHED;
            PG8_LDA(At, 1, 1); PG8_STAGE(PG8_SB(1, 0), b3, voffB[0]); PG8_STAGE(PG8_SB(1, 1), b3, voffB[1]); PG8_STAGE(PG8_SA(1, 0), a3, voffA[0]);
            PG8_WAIT_V(8); PG8_WAIT_L(0); PG8_BAR; PG8_MMA(1, 0, At, B0); PG8_MMA(1, 1, At, B1); PG8_BAR; PG8_SCHED;
        }
        }
        if (wr == 0) PG8_BAR;
#ifndef EPI_REP
#define EPI_REP 1
#endif
        if (have_prev) S.done(prevu);
#pragma unroll 1
        for (int er_ = 0; er_ < (Epi::IDEMP ? EPI_REP : 1); ++er_) E(acc, cur, wr, wc, fr, fq);
        prevu = cur; have_prev = true;
        if (!has_next) break;
#pragma unroll
        for (int a = 0; a < 2; ++a)
#pragma unroll
            for (int b = 0; b < 2; ++b)
#pragma unroll
                for (int m = 0; m < 4; ++m)
#pragma unroll
                    for (int n = 0; n < 2; ++n) acc[a][b][m][n] = (f32x4){0.f, 0.f, 0.f, 0.f};
        cur = nxt; cA = nA; cB = nB; ++ui;
        if (wr == 1) PG8_BAR;
    }
    PG8_WAIT_V(0);
    if (have_prev) S.done(prevu);
    PG8_BAR;
#undef PG8_SA
#undef PG8_SB
#undef PG8_STAGE
#undef PG8_LDA
#undef PG8_LDB
#undef PG8_MMA
#undef PG8_WAIT_V
#undef PG8_WAIT_L
#undef PG8_BAR
#undef PG8_SCHED
#undef PG8_GLIST
}

struct PlainOrder {
    int krep = 1;
    const char* A; const char* Bt; int K; int nM, nN, nwg, G, c, L0, Lend;
    __device__ void init(const void* A_, const void* Bt_, int M, int N, int K_, int G_, int c_) { A = (const char*)A_; Bt = (const char*)Bt_; K = K_; nM = M / BM; nN = N / BM; nwg = nM * nN; G = G_; c = c_; L0 = 0; Lend = nwg; }
    __device__ __forceinline__ bool next(int i, Unit& u) const {
        const long L = (long)L0 + (long)i * G + c; if (L >= Lend) return false;
        int wgid = (int)L; { const int q = nwg / 8, r = nwg % 8, xcd = wgid % 8, off = wgid / 8; wgid = (xcd < r ? xcd * (q + 1) : r * (q + 1) + (xcd - r) * q) + off; }
        const int nig = 8 * nN, gid = wgid / nig, fm = gid * 8, gsz = (nM - fm) < 8 ? (nM - fm) : 8;
        u.pm = fm + ((wgid % nig) % gsz); u.pn = (wgid % nig) / gsz; u.e = 0; u.row0 = u.pm * BM;
        u.A = A + (size_t)u.pm * BM * K * 2; u.B = Bt + (size_t)u.pn * BM * K * 2; return true;
    }
    __device__ __forceinline__ const LAS int* list(int) const { return nullptr; }
    __device__ __forceinline__ void a_ready(const Unit&) const {}
    __device__ __forceinline__ void done(const Unit&) const {}
};
struct XcdRunOrder {
    int krep = 1;
    const char* A; const char* Bt; int K, nM, nN, wg0, wpx, j, nu;
    __device__ __forceinline__ bool next(int i, Unit& u) const {
        if (i >= nu) return false;
        const int wgid = wg0 + i * wpx + j; if (wgid >= nM * nN) return false;
        const int nig = 8 * nN, gid = wgid / nig, fm = gid * 8, gsz = (nM - fm) < 8 ? (nM - fm) : 8;
        u.pm = fm + ((wgid % nig) % gsz); u.pn = (wgid % nig) / gsz; u.e = 0; u.row0 = u.pm * BM;
        u.A = A + (size_t)u.pm * BM * K * 2; u.B = Bt + (size_t)u.pn * BM * K * 2; return true;
    }
    __device__ __forceinline__ const LAS int* list(int) const { return nullptr; }
    __device__ __forceinline__ void a_ready(const Unit&) const {}
    __device__ __forceinline__ void done(const Unit&) const {}
};

struct EpiBf16 {
    static constexpr int PERM = 3; static constexpr bool IDEMP = true;
    bf16_t* O; int ldc; int nostore = 0;
    __device__ __forceinline__ void operator()(const f32x4 (&acc)[2][2][4][2], const Unit& u, int wr, int wc, int fr, int fq) const {
        const int row0 = u.row0 + wr * 64 + fr; const int col0 = u.pn * BM + wc * 64 + 8 * fq;
#pragma unroll
        for (int ai = 0; ai < 2; ++ai)
#pragma unroll
            for (int m = 0; m < 4; ++m) { bf16_t* rowp = O + (size_t)(row0 + ai * HALF + m * 16) * ldc + col0;
#pragma unroll
                for (int bj = 0; bj < 2; ++bj) { const f32x4 v0 = acc[ai][bj][m][0], v1 = acc[ai][bj][m][1];
                    u32x4 w; w.x = cvt_pk_bf16(v0[0], v0[1]); w.y = cvt_pk_bf16(v0[2], v0[3]); w.z = cvt_pk_bf16(v1[0], v1[1]); w.w = cvt_pk_bf16(v1[2], v1[3]);
                    if (!nostore) EPI_ST16(rowp + bj * 32, w);
                    else asm volatile("" :: "v"(w.x), "v"(w.y), "v"(w.z), "v"(w.w)); } }
    }
};
}
constexpr size_t MiB = 1u << 20;
constexpr size_t WS_CTL = 0, CTL_ZERO_BYTES = 128 * 1024;
constexpr size_t WS_MOD = 1 * MiB;
constexpr size_t WS_MODP = WS_MOD + 256 * 1024;
constexpr size_t WS_TOKE = 3 * MiB, WS_TOKW = WS_TOKE + 512 * 1024, WS_TOKPOS = WS_TOKW + 512 * 1024, WS_TOKRANK = WS_TOKPOS + 512 * 1024;
constexpr size_t WS_BLKBASE = WS_TOKRANK + 512 * 1024;
constexpr size_t WS_SRT = 6 * MiB;
constexpr size_t WS_W2T = 8 * MiB;
constexpr size_t WS_HH = 138 * MiB;
#ifndef YB_MIB
#define YB_MIB 691
#endif
constexpr size_t WS_YB = (size_t)YB_MIB * MiB;
constexpr size_t WS_W13T = 298 * MiB;
constexpr size_t WS_MASKB = 558 * MiB;
constexpr size_t WS_HB = 558 * MiB;
constexpr size_t WS_WINT = 622 * MiB;
constexpr size_t WS_WCVT = 661 * MiB, WS_WATT = 665 * MiB, WS_WOT = 669 * MiB, WS_WRX = 677 * MiB, WS_WRY = 678 * MiB;
constexpr size_t WS_RLOG = 760 * MiB;
constexpr size_t WS_PROJ = 691 * MiB;
constexpr size_t WS_Y1 = 1011 * MiB;
constexpr size_t WS_HLO = WS_PROJ;
constexpr size_t WS_UMIX = 1003 * MiB, WS_AO = 1035 * MiB, WS_KN = 1067 * MiB, WS_VT = 1075 * MiB, WS_KIN = 1083 * MiB, WS_MASK = 1085 * MiB, WS_END = 1093 * MiB;
constexpr int CW_TMO = 0, CW_BAR = 4096, CW_CNT = 16384  , CW_CUR = 16384 + 64, CW_TDONE = 20000  ;
#ifndef TAIL_CAP_N
#define TAIL_CAP_N 3
#endif
constexpr int TAIL_CAP = TAIL_CAP_N;

constexpr int RING_BYTES = 131072;
constexpr int LIST_OFF = RING_BYTES;
constexpr int LDS_BYTES = 163840;
constexpr int MISC_OFF = LDS_BYTES - 256;
constexpr int NWAVES = 8, NTHREADS = 512;

struct Args {
    const float* in[24]; float* out; unsigned char* ws; int ph_lo, ph_hi, bar_region, pad;
};

struct Frame {
    LAS unsigned char* lds; unsigned* ctl; unsigned char* ws; const float* const* in; float* out;
    int tid, lane, wave, G, bid;
};
struct CvtItem { const float* W; bf16_t* dst; bf16_t* dst2; int K, N, k0, n0, mode; };
__device__ __forceinline__ void cvt_load(const CvtItem& it, f32x4 (&v)[8], int lane) {
    const int row = lane >> 3; int n = it.n0 + (lane & 7) * 4; n = n < it.N ? n : 0;
    const float* p = it.W + (size_t)(it.k0 + row) * it.N + n;
#pragma unroll
    for (int i = 0; i < 8; ++i) v[i] = __builtin_nontemporal_load((const f32x4*)(p + (size_t)(8 * i) * it.N));
}
template <bool MODES>
__device__ __forceinline__ void cvt_store(const CvtItem& it, const f32x4 (&v)[8], LAS float* scr, int lane) {
    const int row = lane >> 3, c4 = (lane & 7) * 4; const float keep = (it.n0 + c4 < it.N) ? 1.f : 0.f;
#pragma unroll
    for (int i = 0; i < 8; ++i) { LAS float* d = scr + (8 * i + row) * 33 + c4; d[0] = v[i].x * keep; d[1] = v[i].y * keep; d[2] = v[i].z * keep; d[3] = v[i].w * keep; }
    LDS_WAIT(); asm volatile("" ::: "memory");
    const int c = lane & 7; const int K = it.K;
    float x[4][8];
#pragma unroll
    for (int j = 0; j < 4; ++j) { const LAS float* s = scr + (8 * c) * 33 + (lane >> 3) + 8 * j;
#pragma unroll
        for (int q = 0; q < 8; ++q) x[j][q] = s[q * 33]; }
    LDS_WAIT(); asm volatile("" ::: "memory");
    bf16_t* dp = it.dst + (size_t)(lane >> 3) * K + it.k0 + 8 * c;
#pragma unroll
    for (int j = 0; j < 4; ++j) {
        u32x4 o; o.x = cvt_pk_bf16(x[j][0], x[j][1]); o.y = cvt_pk_bf16(x[j][2], x[j][3]); o.z = cvt_pk_bf16(x[j][4], x[j][5]); o.w = cvt_pk_bf16(x[j][6], x[j][7]);
        if (MODES && it.mode == 2) {
            o.x = cvt_pk_bf16(x[j][0] - bf_lo(o.x), x[j][1] - bf_hi(o.x)); o.y = cvt_pk_bf16(x[j][2] - bf_lo(o.y), x[j][3] - bf_hi(o.y));
            o.z = cvt_pk_bf16(x[j][4] - bf_lo(o.z), x[j][5] - bf_hi(o.z)); o.w = cvt_pk_bf16(x[j][6] - bf_lo(o.w), x[j][7] - bf_hi(o.w)); }
        __builtin_nontemporal_store(o, (u32x4*)(dp + (size_t)(8 * j) * K));
        if (MODES && it.mode == 1) __builtin_nontemporal_store(o, (u32x4*)(it.dst2 + (size_t)((lane >> 3) + 8 * j) * K + it.k0 + 8 * c)); }
}
constexpr int NB_IN = (TOT + 31) / 32;
constexpr int I_IN = (D / 64) * NB_IN, I_CV = (CW / 64) * (D / 32), I_AT = I_CV, I_O = (D / 64) * (D / 32), I_R = (D / 64) * 2 * 2;
constexpr int I_13 = (D / 64) * (DE / 32)  , I_2 = (DE / 64) * (D / 32)  ;
constexpr int NITEMS_SMALL = I_IN + I_CV + I_AT + I_O + I_R, NITEMS_EXP = 130 * I_13 + 65 * I_2;
__device__ __forceinline__ CvtItem small_item(const Frame& F, int r) {
    CvtItem it; it.dst2 = nullptr; it.mode = 0;
    if (r < I_IN) { const int kb = r / NB_IN, nb = r % NB_IN; it.W = F.in[7]; it.K = D; it.N = TOT; it.k0 = 64 * kb; it.n0 = 32 * nb; it.dst = (bf16_t*)(F.ws + WS_WINT) + (size_t)(32 * nb) * D; return it; } r -= I_IN;
    if (r < I_CV) { const int kb = r / (D / 32), nb = r % (D / 32); it.W = F.in[9]; it.K = CW; it.N = D; it.k0 = 64 * kb; it.n0 = 32 * nb; it.dst = (bf16_t*)(F.ws + WS_WCVT) + (size_t)(32 * nb) * CW; return it; } r -= I_CV;
    if (r < I_AT) { const int kb = r / (D / 32), nb = r % (D / 32); it.W = F.in[14]; it.K = AW; it.N = D; it.k0 = 64 * kb; it.n0 = 32 * nb; it.dst = (bf16_t*)(F.ws + WS_WATT) + (size_t)(32 * nb) * AW; return it; } r -= I_AT;
    if (r < I_O) { const int kb = r / (D / 32), nb = r % (D / 32); it.W = F.in[15]; it.K = D; it.N = D; it.k0 = 64 * kb; it.n0 = 32 * nb; it.dst = (bf16_t*)(F.ws + WS_WOT) + (size_t)(32 * nb) * D; return it; } r -= I_O;
    { it.mode = 1 + (r & 1); const int q = r >> 1, kb = q / 2, nb = q % 2; it.W = F.in[16]; it.K = D; it.N = NE; it.k0 = 64 * kb; it.n0 = 32 * nb;
      it.dst = (bf16_t*)(F.ws + WS_WRX) + (size_t)((it.mode == 2 ? 64 : 0) + 32 * nb) * D; it.dst2 = (bf16_t*)(F.ws + WS_WRY) + (size_t)(32 * nb) * D; return it; }
}
__device__ __forceinline__ CvtItem expert_item(const Frame& F, int r) {
    CvtItem it; it.dst2 = nullptr; it.mode = 0;
    const bool up = r < 130 * I_13; const int r2 = up ? r : r - 130 * I_13;
    const int mtx = r2 >> 9, q = r2 & 511;
    const int kb = up ? (q >> 4) : (q >> 6), nb = up ? (q & 15) : (q & 63);
    const int is3 = ((mtx >= 64 && mtx < 128) || mtx == 129) ? 1 : 0; const int e = mtx < 64 ? mtx : (mtx < 128 ? mtx - 64 : 64);
    const float* Wup = mtx < 64 ? F.in[18] + (size_t)mtx * D * DE : (mtx < 128 ? F.in[19] + (size_t)(mtx - 64) * D * DE : (mtx == 128 ? F.in[21] : F.in[22]));
    const float* Wdn = mtx < 64 ? F.in[20] + (size_t)mtx * DE * D : F.in[23];
    const int n0 = 32 * nb; const int drow = e * 1024 + (n0 >> 7) * 256 + is3 * 128 + (n0 & 127);
    it.W = up ? Wup : Wdn; it.K = up ? D : DE; it.N = up ? DE : D; it.k0 = 64 * kb; it.n0 = n0;
    it.dst = up ? (bf16_t*)(F.ws + WS_W13T) + (size_t)drow * D : (bf16_t*)(F.ws + WS_W2T) + ((size_t)mtx * D + n0) * DE;
    return it;
}
template <bool EXPERTS>
__device__ __forceinline__ void cvt_run(const Frame& F, int n, int blk0, int nblk, int first = 0) {
    LAS float* scr = (LAS float*)(F.lds + F.wave * 16384);
    const int gw = first + (F.bid - blk0) * NWAVES + F.wave, S = nblk * NWAVES;
    const int cnt = gw < n ? (n - gw + S - 1) / S : 0; if (cnt == 0) return;
    CvtItem i0, i1, i2, i3; f32x4 v0[8], v1[8], v2[8], v3[8];
#define CV_LD(I, V, k_) do { const int kk_ = (k_) < cnt ? (k_) : cnt - 1; I = EXPERTS ? expert_item(F, gw + kk_ * S) : small_item(F, gw + kk_ * S); cvt_load(I, V, F.lane); } while (0)
    CV_LD(i0, v0, 0); CV_LD(i1, v1, 1); CV_LD(i2, v2, 2);
    int k = 0;
    for (; k + 4 <= cnt; k += 4) {
        CV_LD(i3, v3, k + 3); cvt_store<!EXPERTS>(i0, v0, scr, F.lane);
        CV_LD(i0, v0, k + 4); cvt_store<!EXPERTS>(i1, v1, scr, F.lane);
        CV_LD(i1, v1, k + 5); cvt_store<!EXPERTS>(i2, v2, scr, F.lane);
        CV_LD(i2, v2, k + 6); cvt_store<!EXPERTS>(i3, v3, scr, F.lane);
    }
    if (k < cnt) cvt_store<!EXPERTS>(i0, v0, scr, F.lane);
    if (k + 1 < cnt) cvt_store<!EXPERTS>(i1, v1, scr, F.lane);
    if (k + 2 < cnt) cvt_store<!EXPERTS>(i2, v2, scr, F.lane);
#undef CV_LD
}

__device__ __forceinline__ void p0_prologue(const Frame& F) {
    const float* c_in = F.in[1]; const float* w_ada = F.in[5];
    LAS float* scr = (LAS float*)(F.lds + F.wave * 16384);
    const int gw = F.bid * NWAVES + F.wave, NGW = F.G * NWAVES;
    for (int task = gw; task < 192 * 8; task += NGW) {
        const int kc = task & 7, cc = task >> 3, kbase = kc * 256;
#pragma unroll
        for (int b = 0; b < 4; ++b)
#pragma unroll
            for (int j = 0; j < 4; ++j) { const int k = F.lane + 64 * j; scr[b * 256 + k] = silu_f(c_in[b * D + kbase + k]); }
        LDS_WAIT(); asm volatile("" ::: "memory");
        float a0 = 0.f, a1 = 0.f, a2 = 0.f, a3 = 0.f;
        const float* wp = w_ada + (size_t)kbase * (6 * D) + cc * 64 + F.lane;
#pragma unroll 16
        for (int k = 0; k < 256; ++k) { const float w = wp[(size_t)k * (6 * D)];
            a0 += scr[k] * w; a1 += scr[256 + k] * w; a2 += scr[512 + k] * w; a3 += scr[768 + k] * w; }
        float* mp = (float*)(F.ws + WS_MODP) + (size_t)kc * (4 * 6 * D) + cc * 64 + F.lane;
        mp[0] = a0; mp[6 * D] = a1; mp[2 * 6 * D] = a2; mp[3 * 6 * D] = a3;
        LDS_WAIT(); asm volatile("" ::: "memory");
    }
    cvt_run<false>(F, NITEMS_SMALL, 0, F.G);
#ifndef CVT_OVERLAP
    cvt_run<true>(F, NITEMS_EXP, 0, F.G);
#endif
#ifdef CVT_P0_ON
    if (F.bid < CVT_P0_ON) cvt_run<true>(F, NITEMS_EXP, 0, CVT_P0_ON);
#endif
    {
        const u32x4 z = {0u, 0u, 0u, 0u};
        const int gt = gw * 64 + F.lane, NGT = NGW * 64;
        u32x4* p1 = (u32x4*)((bf16_t*)(F.ws + WS_WINT) + (size_t)9824 * D); for (int i = gt; i < 160 * 256; i += NGT) p1[i] = z;
        u32x4* p2 = (u32x4*)((bf16_t*)(F.ws + WS_WRX) + (size_t)128 * D); for (int i = gt; i < 128 * 256; i += NGT) p2[i] = z;
        u32x4* p3 = (u32x4*)((bf16_t*)(F.ws + WS_WRY) + (size_t)64 * D); for (int i = gt; i < 192 * 256; i += NGT) p3[i] = z;
    }
}

__device__ __forceinline__ float mod_value(const Frame& F, int idx) {
    const float* mp = (const float*)(F.ws + WS_MODP) + idx; float s = 0.f;
#pragma unroll
    for (int p = 0; p < 8; ++p) s += mp[(size_t)p * (4 * 6 * D)];
    return s + F.in[6][idx % (6 * D)];
}

__device__ __forceinline__ void p1_norm1(const Frame& F) {
    LAS float* sh = (LAS float*)F.lds;
    LAS float* sc = sh + D;
    float* MOD = (float*)(F.ws + WS_MOD);
    for (int idx = F.bid * NTHREADS + F.tid; idx < 4 * 6 * D; idx += F.G * NTHREADS) MOD[idx] = mod_value(F, idx);
    for (int blk = F.bid; blk < NTOK / 64; blk += F.G) {
        const int b = blk / (SEQ / 64);
        __syncthreads();
        for (int i = F.tid; i < D; i += NTHREADS) { sh[i] = mod_value(F, b * 6 * D + i); sc[i] = (1.f + mod_value(F, b * 6 * D + D + i)) * F.in[3][i]; }
        __syncthreads();
        for (int j = 0; j < 8; ++j) {
            const int t = blk * 64 + F.wave * 8 + j;
            const f32x4* xr = (const f32x4*)(F.in[0] + (size_t)t * D) + F.lane;
            f32x4 v[8]; float s = 0.f;
#pragma unroll
            for (int q = 0; q < 8; ++q) { v[q] = xr[64 * q]; s += (v[q].x * v[q].x + v[q].y * v[q].y) + (v[q].z * v[q].z + v[q].w * v[q].w); }
            const float r = rsqrtf(wave_sum(s) * (1.f / D) + EPS);
            u32x2* o = (u32x2*)((bf16_t*)(F.ws + WS_HB) + (size_t)t * D) + F.lane;
#pragma unroll
            for (int q = 0; q < 8; ++q) { const int c0 = 4 * F.lane + 256 * q;
                const f32x4 a = *(const LAS f32x4*)(sc + c0), bb = *(const LAS f32x4*)(sh + c0);
                u32x2 w; w.x = pk2(v[q].x * r * a.x + bb.x, v[q].y * r * a.y + bb.y); w.y = pk2(v[q].z * r * a.z + bb.z, v[q].w * r * a.w + bb.w);
                o[64 * q] = w; }
        }
    }
}

__device__ __forceinline__ void p3_mix(const Frame& F) {
    const bf16_t* PROJ = (const bf16_t*)(F.ws + WS_PROJ);
    bf16_t* UMIX = (bf16_t*)(F.ws + WS_UMIX); bf16_t* KN = (bf16_t*)(F.ws + WS_KN); bf16_t* VT = (bf16_t*)(F.ws + WS_VT); bf16_t* KIN = (bf16_t*)(F.ws + WS_KIN);
    const float* conv_w = F.in[8];
    LAS bf16_t* tile = (LAS bf16_t*)F.lds;
    const int c0 = F.lane * 16;
    float w0[16], w1[16], w2[16];
#pragma unroll
    for (int i = 0; i < 16; ++i) { w0[i] = conv_w[c0 + i]; w1[i] = conv_w[CW + c0 + i]; w2[i] = conv_w[2 * CW + c0 + i]; }
    const float* knw = F.in[11]; float kw4[4];
#pragma unroll
    for (int i = 0; i < 4; ++i) kw4[i] = knw[(F.lane & 15) * 4 + i];
    const float iw = F.in[12][F.lane], ib = F.in[13][F.lane];
    for (int blk = F.bid; blk < NTOK / 64; blk += F.G) {
        const int tok0 = blk * 64, b = tok0 / SEQ, tt0 = tok0 % SEQ;
        __syncthreads();
#pragma unroll
        for (int it = 0; it < 4; ++it) { const int idx = it * NTHREADS + F.tid, tk = idx >> 5, ch = idx & 31;
            const u32x4 v = *(const u32x4*)(PROJ + (size_t)(tok0 + tk) * TOTP + O_V + ch * 8);
            const unsigned wv[4] = {v.x, v.y, v.z, v.w};
#pragma unroll
            for (int j = 0; j < 4; ++j) { tile[(ch * 8 + 2 * j) * 72 + tk] = (bf16_t)(wv[j] & 0xffffu); tile[(ch * 8 + 2 * j + 1) * 72 + tk] = (bf16_t)(wv[j] >> 16); } }
        __syncthreads();
#pragma unroll
        for (int it = 0; it < 4; ++it) { const int idx = it * NTHREADS + F.tid, col = idx >> 3, ch = idx & 7;
            const int g16 = ch >> 1, c1 = ch & 1;
            const u32x2 v0 = *(const LAS u32x2*)(tile + col * 72 + 16 * g16 + 4 * c1), v1 = *(const LAS u32x2*)(tile + col * 72 + 16 * g16 + 8 + 4 * c1);
            *(u32x4*)(VT + ((size_t)(b * 256 + col)) * SEQ + tt0 + ch * 8) = (u32x4){v0.x, v0.y, v1.x, v1.y}; }
        float vm1[16], vm2[16];
        {
            const int t = tok0 + F.wave * 8, tt = t % SEQ;
#pragma unroll
            for (int back = 1; back <= 2; ++back) {
                float* dst = back == 1 ? vm1 : vm2;
                if (tt >= back) {
                    const bf16_t* p = PROJ + (size_t)(t - back) * TOTP;
                    const u32x4 a0 = *(const u32x4*)(p + O_CC + c0), a1 = *(const u32x4*)(p + O_CC + c0 + 8), b0 = *(const u32x4*)(p + O_CU + c0), b1 = *(const u32x4*)(p + O_CU + c0 + 8);
                    const unsigned aw[8] = {a0.x, a0.y, a0.z, a0.w, a1.x, a1.y, a1.z, a1.w}, bw[8] = {b0.x, b0.y, b0.z, b0.w, b1.x, b1.y, b1.z, b1.w};
#pragma unroll
                    for (int i = 0; i < 8; ++i) { dst[2 * i] = bf_lo(aw[i]) * bf_lo(bw[i]); dst[2 * i + 1] = bf_hi(aw[i]) * bf_hi(bw[i]); }
                } else {
#pragma unroll
                    for (int i = 0; i < 16; ++i) dst[i] = 0.f;
                }
            }
        }
        for (int j = 0; j < 8; ++j) {
            const int t = tok0 + F.wave * 8 + j;
            const bf16_t* p = PROJ + (size_t)t * TOTP;
            const u32x4 a0 = *(const u32x4*)(p + O_CC + c0), a1 = *(const u32x4*)(p + O_CC + c0 + 8), b0 = *(const u32x4*)(p + O_CU + c0), b1 = *(const u32x4*)(p + O_CU + c0 + 8);
            const u32x4 g0 = *(const u32x4*)(p + O_CB + c0), g1 = *(const u32x4*)(p + O_CB + c0 + 8);
            const unsigned aw[8] = {a0.x, a0.y, a0.z, a0.w, a1.x, a1.y, a1.z, a1.w}, bw[8] = {b0.x, b0.y, b0.z, b0.w, b1.x, b1.y, b1.z, b1.w}, gw[8] = {g0.x, g0.y, g0.z, g0.w, g1.x, g1.y, g1.z, g1.w};
            float v0[16]; unsigned ow[8];
#pragma unroll
            for (int i = 0; i < 8; ++i) { v0[2 * i] = bf_lo(aw[i]) * bf_lo(bw[i]); v0[2 * i + 1] = bf_hi(aw[i]) * bf_hi(bw[i]); }
#pragma unroll
            for (int i = 0; i < 8; ++i) {
                const float y0 = w0[2 * i] * vm2[2 * i] + w1[2 * i] * vm1[2 * i] + w2[2 * i] * v0[2 * i];
                const float y1 = w0[2 * i + 1] * vm2[2 * i + 1] + w1[2 * i + 1] * vm1[2 * i + 1] + w2[2 * i + 1] * v0[2 * i + 1];
                ow[i] = pk2(bf_lo(gw[i]) * y0, bf_hi(gw[i]) * y1); }
            u32x4* o = (u32x4*)(UMIX + (size_t)t * CW + c0);
            o[0] = (u32x4){ow[0], ow[1], ow[2], ow[3]}; o[1] = (u32x4){ow[4], ow[5], ow[6], ow[7]};
#pragma unroll
            for (int i = 0; i < 16; ++i) { vm2[i] = vm1[i]; vm1[i] = v0[i]; }
            { const u32x2 kv = *(const u32x2*)(p + O_K + F.lane * 4);
              float k0 = bf_lo(kv.x), k1 = bf_hi(kv.x), k2 = bf_lo(kv.y), k3 = bf_hi(kv.y);
              float s = (k0 * k0 + k1 * k1) + (k2 * k2 + k3 * k3);
              s += __shfl_xor(s, 1); s += __shfl_xor(s, 2); s += __shfl_xor(s, 4); s += __shfl_xor(s, 8);
              const float r = rsqrtf(s * (1.f / 64.f) + EPS);
              u32x2 ov; ov.x = pk2(k0 * r * kw4[0], k1 * r * kw4[1]); ov.y = pk2(k2 * r * kw4[2], k3 * r * kw4[3]);
              *(u32x2*)(KN + (size_t)t * KVW + F.lane * 4) = ov; }
            { const float xv = bf2f(p[O_KI + F.lane]);
              const float mu = wave_sum(xv) * (1.f / 64.f), dx = xv - mu, var = wave_sum(dx * dx) * (1.f / 64.f);
              KIN[(size_t)t * IDIM + F.lane] = (bf16_t)f2bf(dx * rsqrtf(var + EPS) * iw + ib); }
        }
    }
}

__device__ __forceinline__ unsigned f2key(float f) { const unsigned u = __float_as_uint(f); return (u & 0x80000000u) ? ~u : (u | 0x80000000u); }
__device__ __forceinline__ unsigned fxkey(float v) { const int q = (int)__builtin_fmaf(v, 131072.f, 524289.f); return (unsigned)(q < 1 ? 1 : (q > 1048574 ? 1048574 : q)); }
__device__ __forceinline__ int crow32(int r, int hi) { return (r & 3) + 8 * (r >> 2) + 4 * hi; }

__device__ __forceinline__ void p4_index(const Frame& F) {
    const bf16_t* PROJ = (const bf16_t*)(F.ws + WS_PROJ); const bf16_t* KIN = (const bf16_t*)(F.ws + WS_KIN);
    unsigned* MASK = (unsigned*)(F.ws + WS_MASK);
    LAS unsigned* SCK = (LAS unsigned*)F.lds;
    LAS float* WQ = (LAS float*)(F.lds + LIST_OFF);
    LAS bf16_t* UQ = (LAS bf16_t*)(F.lds + LIST_OFF + 512);
    const int lane = F.lane, n32 = lane & 31, hi = lane >> 5, w = F.wave;
    constexpr int NUNITS = BATCH * (SEQ / 8);
    for (int r = 0;; ++r) {
        const int L = r * F.G + ((r & 1) ? (F.G - 1 - F.bid) : F.bid);
        if (L >= NUNITS) break;
        const int b = L & 3, qg = (SEQ / 8 - 1) - (L >> 2), t0 = qg * 8;
        const int nkt = (t0 + 7) / 32 + 1;
        bf16x8 Af[4][4];
        {
            const int qsel = (n32 >> 2) & 1, head = (n32 & 3) + 4 * (n32 >> 3);
#pragma unroll
            for (int rt = 0; rt < 4; ++rt) {
                const bf16_t* p = PROJ + (size_t)(b * SEQ + t0 + 2 * rt + qsel) * TOTP + O_QI + head * 64 + 8 * hi;
#pragma unroll
                for (int ks = 0; ks < 4; ++ks) Af[rt][ks] = *(const bf16x8*)(p + 16 * ks);
            }
        }
        bf16x8 B0[4], B1[4];
#define P4_LDB(dst, kt_) do { const bf16_t* kp_ = KIN + (size_t)(b * SEQ + (kt_) * 32 + n32) * IDIM + 8 * hi; _Pragma("unroll") for (int ks = 0; ks < 4; ++ks) dst[ks] = *(const bf16x8*)(kp_ + 16 * ks); } while (0)
        if (w < nkt) P4_LDB(B0, w);
        { const int q = F.tid >> 6, d = F.tid & 63; const bf16_t* rowp = PROJ + (size_t)(b * SEQ + t0 + q) * TOTP; const bf16_t* qp = rowp + O_QI + d;
          const u32x4 wa = *(const u32x4*)(rowp + O_WI), wb = *(const u32x4*)(rowp + O_WI + 8); const bf16_t wmine = rowp[O_WI + (d & 15)];
          bf16_t qv[16];
#pragma unroll
          for (int h2 = 0; h2 < 16; ++h2) qv[h2] = qp[h2 * 64];
          __syncthreads();
          const unsigned ww[8] = {wa.x, wa.y, wa.z, wa.w, wb.x, wb.y, wb.z, wb.w}; float uacc = 0.f;
#pragma unroll
          for (int h2 = 0; h2 < 16; ++h2) { const float wq = ((h2 & 1) ? bf_hi(ww[h2 >> 1]) : bf_lo(ww[h2 >> 1])) * (0.25f * 0.125f); uacc += wq * bf2f(qv[h2]); }
          UQ[q * 64 + d] = (bf16_t)f2bf(uacc);
          if (d < 16) WQ[q * 16 + d] = bf2f(wmine) * (0.25f * 0.125f); }
        __syncthreads();
        bf16x8 A5[4];
        { const int qm = n32 < 4 ? 2 * n32 : 2 * (n32 - 4) + 1;
#pragma unroll
          for (int ks = 0; ks < 4; ++ks) { const bf16x8 v = *(const LAS bf16x8*)(UQ + (qm & 7) * 64 + 16 * ks + 8 * hi); A5[ks] = n32 < 8 ? v : (bf16x8){0, 0, 0, 0, 0, 0, 0, 0}; } }
#define P4_TILE(Bc, kt_) do { f32x16 lin = {}; _Pragma("unroll") for (int ks = 0; ks < 4; ++ks) lin = __builtin_amdgcn_mfma_f32_32x32x16_bf16(A5[ks], Bc[ks], lin, 0, 0, 0); \
        _Pragma("unroll") for (int rt = 0; rt < 4; ++rt) { \
            f32x16 acc = {}; _Pragma("unroll") for (int ks = 0; ks < 4; ++ks) acc = __builtin_amdgcn_mfma_f32_32x32x16_bf16(Af[rt][ks], Bc[ks], acc, 0, 0, 0); \
            const LAS f32x4* wv = (const LAS f32x4*)(WQ + (2 * rt + hi) * 16); float s_ = lin[rt]; \
            _Pragma("unroll") for (int i4 = 0; i4 < 4; ++i4) { const f32x4 ww = wv[i4]; \
                s_ += ww.x * __builtin_fabsf(acc[4 * i4]) + ww.y * __builtin_fabsf(acc[4 * i4 + 1]) + ww.z * __builtin_fabsf(acc[4 * i4 + 2]) + ww.w * __builtin_fabsf(acc[4 * i4 + 3]); } \
            SCK[(2 * rt + hi) * SEQ + (kt_) * 32 + n32] = fxkey(0.5f * s_); } } while (0)
#ifndef P4_REP_SC
#define P4_REP_SC 1
#endif
#ifndef P4_REP_SEL
#define P4_REP_SEL 1
#endif
#pragma unroll 1
        for (int rep_ = 0; rep_ < P4_REP_SC; ++rep_) { if (rep_ && w < nkt) P4_LDB(B0, w);
        for (int kt = w; kt < nkt; kt += 16) {
            if (kt + 8 < nkt) P4_LDB(B1, kt + 8);
            P4_TILE(B0, kt);
            if (kt + 8 < nkt) {
                if (kt + 16 < nkt) P4_LDB(B0, kt + 16);
                P4_TILE(B1, kt + 8);
            }
        }
        }
#undef P4_LDB
#undef P4_TILE
        __syncthreads();
#ifndef P4_REP_SEL
#define P4_REP_SEL 1
#endif
#pragma unroll 1
        for (int rep2_ = 0; rep2_ < P4_REP_SEL; ++rep2_) {
            const int t = t0 + w, jmax = t >> 6;
            unsigned key[64];
#pragma unroll
            for (int g8 = 0; g8 < 8; ++g8) {
                if (g8 * 8 <= jmax) {
#pragma unroll
                    for (int jj = 0; jj < 8; ++jj) { const int j = g8 * 8 + jj, s = j * 64 + lane; const unsigned v = SCK[w * SEQ + s]; key[j] = (s <= t) ? v : 0u; }
                } else {
#pragma unroll
                    for (int jj = 0; jj < 8; ++jj) key[g8 * 8 + jj] = 0u;
                }
            }
#define P4_CNT8(g8_, op_, cand_, c_) do { unsigned long long m0_, m1_, m2_, m3_, m4_, m5_, m6_, m7_; \
                asm volatile("v_cmp_" op_ "_u32_e64 %0, %8, %16\n\tv_cmp_" op_ "_u32_e64 %1, %9, %16\n\tv_cmp_" op_ "_u32_e64 %2, %10, %16\n\tv_cmp_" op_ "_u32_e64 %3, %11, %16\n\t" \
                             "v_cmp_" op_ "_u32_e64 %4, %12, %16\n\tv_cmp_" op_ "_u32_e64 %5, %13, %16\n\tv_cmp_" op_ "_u32_e64 %6, %14, %16\n\tv_cmp_" op_ "_u32_e64 %7, %15, %16" \
                    : "=&s"(m0_), "=&s"(m1_), "=&s"(m2_), "=&s"(m3_), "=&s"(m4_), "=&s"(m5_), "=&s"(m6_), "=&s"(m7_) \
                    : "v"(key[(g8_) * 8 + 0]), "v"(key[(g8_) * 8 + 1]), "v"(key[(g8_) * 8 + 2]), "v"(key[(g8_) * 8 + 3]), "v"(key[(g8_) * 8 + 4]), "v"(key[(g8_) * 8 + 5]), "v"(key[(g8_) * 8 + 6]), "v"(key[(g8_) * 8 + 7]), "s"(cand_)); \
                c_ += (__popcll(m0_) + __popcll(m1_)) + (__popcll(m2_) + __popcll(m3_)) + (__popcll(m4_) + __popcll(m5_)) + (__popcll(m6_) + __popcll(m7_)); } while (0)
            unsigned TH = 0u; bool exact = false; int rem = 0;
            if (t + 1 <= NSEL) { TH = 1u; exact = true; }
            else {
#pragma unroll 1
                for (int bit = 19; bit >= 0; --bit) {
                    const unsigned cand = (unsigned)__builtin_amdgcn_readfirstlane((int)(TH | (1u << bit)));
                    int c = 0;
#pragma unroll
                    for (int g8 = 0; g8 < 8; ++g8) { if (g8 * 8 <= jmax) P4_CNT8(g8, "ge", cand, c); }
                    if (c >= NSEL) TH = cand;
                    if (c == NSEL) { exact = true; break; }
                }
                if (!exact) { int cgt = 0; const unsigned ths = (unsigned)__builtin_amdgcn_readfirstlane((int)TH);
#pragma unroll
                    for (int g8 = 0; g8 < 8; ++g8) { if (g8 * 8 <= jmax) P4_CNT8(g8, "gt", ths, cgt); }
                    rem = NSEL - cgt; }
            }
            unsigned char* mrow = (unsigned char*)(F.ws + WS_MASKB) + ((size_t)(b * SEQ + t)) * SEQ + (((lane >> 2) & 1) * 32 + (lane >> 3) * 4 + (lane & 3));
#pragma unroll
            for (int g8 = 0; g8 < 8; ++g8) {
                if (g8 * 8 <= jmax) {
#pragma unroll
                    for (int jj = 0; jj < 8; ++jj) { const int j = g8 * 8 + jj;
                        unsigned long long m;
                        if (exact) m = __ballot(key[j] >= TH);
                        else {
                            m = __ballot(key[j] > TH);
                            unsigned long long e = __ballot(key[j] == TH);
                            while (rem > 0 && e) { const unsigned long long bitv = e & (~e + 1ull); m |= bitv; e ^= bitv; --rem; }
                        }
                        unsigned bytev; asm volatile("s_nop 1\n\tv_cndmask_b32_e64 %0, 0, %1, %2" : "=v"(bytev) : "v"(0xFFu), "s"(m));
                        asm volatile("global_store_byte %0, %1, off offset:%2" :: "v"(mrow), "v"(bytev), "n"(j * 64) : "memory"); }
                }
            }
        }
#undef P4_CNT8
    }
}

constexpr int P5_KBUF = 0, P5_VBUF = 49152, P5_STG = 98304, P5_BIAS = 135168, P5_BTW = 324, P5_END = P5_BIAS + 16 * P5_BTW * 4;
static_assert(P5_END <= MISC_OFF, "P5 LDS map");
__device__ __forceinline__ int t5_bucket(int n) {
    if (n < 16) return n;
    const int large = 16 + (int)(__logf((float)n * (1.f / 16.f)) * (16.f / 2.0794415416798357f));
    return large < 31 ? large : 31;
}
__device__ __forceinline__ void p5_attn(const Frame& F) {
    const bf16_t* PROJ = (const bf16_t*)(F.ws + WS_PROJ); const bf16_t* KN = (const bf16_t*)(F.ws + WS_KN); const bf16_t* VT = (const bf16_t*)(F.ws + WS_VT);
    const unsigned* MASK = (const unsigned*)(F.ws + WS_MASK); bf16_t* AO = (bf16_t*)(F.ws + WS_AO);
    const float* rel_bias = F.in[2]; const float* qnw = F.in[10];
    const int lane = F.lane, q32 = lane & 31, hi = lane >> 5, w = F.wave, tid = F.tid;
    constexpr float LOG2E = 1.4426950408889634f;
    LAS float* BT = (LAS float*)(F.lds + P5_BIAS);
    __syncthreads();
    for (int i = tid; i < 16 * P5_BTW; i += NTHREADS) { const int h = i / P5_BTW, d = i % P5_BTW - 64;
        BT[i] = (d >= 0 && d < 128) ? (rel_bias[t5_bucket(d) * NH + h] - rel_bias[31 * NH + h]) * LOG2E : 0.f; }
    __syncthreads();
    constexpr int NUNITS = BATCH * NKV * (SEQ / 64);
    const int kkey = tid >> 3, kch = tid & 7;
    const int ldsK = kkey * 128 + ((kch ^ ((kkey >> 1) & 7)) * 16);
    const bf16x8 ones = {0x3f80, 0x3f80, 0x3f80, 0x3f80, 0x3f80, 0x3f80, 0x3f80, 0x3f80};
#define P5_QK(p0_, p1_, kslot_) do { const LAS unsigned char* kb_ = F.lds + P5_KBUF + (kslot_) * 8192; p0_ = (f32x16){}; p1_ = (f32x16){}; \
        _Pragma("unroll") for (int ks = 0; ks < 4; ++ks) { const int ch = 2 * ks + hi; \
            const bf16x8 a0 = *(const LAS bf16x8*)(kb_ + q32 * 128 + ((ch ^ ((q32 >> 1) & 7)) * 16)); \
            const bf16x8 a1 = *(const LAS bf16x8*)(kb_ + (q32 + 32) * 128 + ((ch ^ (((q32 + 32) >> 1) & 7)) * 16)); \
            p0_ = __builtin_amdgcn_mfma_f32_32x32x16_bf16(a0, Qf[ks], p0_, 0, 0, 0); p1_ = __builtin_amdgcn_mfma_f32_32x32x16_bf16(a1, Qf[ks], p1_, 0, 0, 0); } } while (0)
#define P5_LDK(Kf_, kslot_) P5_LDKR(Kf_, kslot_, 0, 4)
#define P5_LDKR(Kf_, kslot_, k0_, k1_) do { const LAS unsigned char* kb_ = F.lds + P5_KBUF + (kslot_) * 8192; \
        _Pragma("unroll") for (int ks = (k0_); ks < (k1_); ++ks) { const int ch = 2 * ks + hi; \
            Kf_[2 * ks] = *(const LAS bf16x8*)(kb_ + q32 * 128 + ((ch ^ ((q32 >> 1) & 7)) * 16)); \
            Kf_[2 * ks + 1] = *(const LAS bf16x8*)(kb_ + (q32 + 32) * 128 + ((ch ^ (((q32 + 32) >> 1) & 7)) * 16)); } } while (0)
#define P5_QKF(p0_, p1_, Kf_) do { p0_ = (f32x16){}; p1_ = (f32x16){}; \
        _Pragma("unroll") for (int ks = 0; ks < 4; ++ks) { p0_ = __builtin_amdgcn_mfma_f32_32x32x16_bf16(Kf_[2 * ks], Qf[ks], p0_, 0, 0, 0); p1_ = __builtin_amdgcn_mfma_f32_32x32x16_bf16(Kf_[2 * ks + 1], Qf[ks], p1_, 0, 0, 0); } } while (0)
#define P5_LDVR(Vf_, vslot_, s0_, s1_) do { const LAS unsigned char* vb_ = F.lds + P5_VBUF + (vslot_) * 8192; \
        _Pragma("unroll") for (int s = (s0_); s < (s1_); ++s) _Pragma("unroll") for (int blk = 0; blk < 2; ++blk) { const int dim = q32 + 32 * blk, swz = (dim >> 1) & 7; \
            Vf_[2 * s + blk] = *(const LAS bf16x8*)(vb_ + dim * 128 + (((2 * s + hi) ^ swz) * 16)); } } while (0)
    for (int r = 0;; ++r) {
        const int L = r * F.G + ((r & 1) ? (F.G - 1 - F.bid) : F.bid);
        if (L >= NUNITS) break;
        const int bg = L & 15, b = bg >> 2, g = bg & 3, qt = (SEQ / 64 - 1) - (L >> 4), t0 = qt * 64;
        const int h = 4 * g + (w >> 1), tq = t0 + 32 * (w & 1) + q32;
        const int nkt = qt + 1;
        bf16x8 Qf[4];
        {
            const bf16_t* qp = PROJ + (size_t)(b * SEQ + tq) * TOTP + O_Q + h * 64 + 8 * hi;
            u32x4 raw[4]; float ss = 0.f;
#pragma unroll
            for (int ks = 0; ks < 4; ++ks) { raw[ks] = *(const u32x4*)(qp + 16 * ks); const unsigned xw[4] = {raw[ks].x, raw[ks].y, raw[ks].z, raw[ks].w};
#pragma unroll
                for (int i = 0; i < 4; ++i) { const float a = bf_lo(xw[i]), c = bf_hi(xw[i]); ss += a * a + c * c; } }
            ss += __shfl_xor(ss, 32);
            const float rs = rsqrtf(ss * (1.f / 64.f) + EPS) * (0.125f * LOG2E);
#pragma unroll
            for (int ks = 0; ks < 4; ++ks) { const unsigned xw[4] = {raw[ks].x, raw[ks].y, raw[ks].z, raw[ks].w}; const float* wn = qnw + 16 * ks + 8 * hi; u32x4 o;
                unsigned ow[4];
#pragma unroll
                for (int i = 0; i < 4; ++i) ow[i] = pk2(bf_lo(xw[i]) * rs * wn[2 * i], bf_hi(xw[i]) * rs * wn[2 * i + 1]);
                o = (u32x4){ow[0], ow[1], ow[2], ow[3]}; Qf[ks] = __builtin_bit_cast(bf16x8, o); }
        }
        const bf16_t* kg = KN + (size_t)(b * SEQ) * KVW + g * 64 + kkey * KVW + kch * 8;
        const bf16_t* vg = VT + ((size_t)((b * 4 + g) * 64 + kkey)) * SEQ + kch * 8;
        const unsigned char* mg = (const unsigned char*)(F.ws + WS_MASKB) + ((size_t)(b * SEQ + tq)) * SEQ + hi * 32;
        f32x16 O0 = {}, O1 = {}, Ls = {};
        __syncthreads();
        { const int t1 = nkt > 1 ? 1 : 0, t2 = nkt > 2 ? 2 : nkt - 1;
          const u32x4 kv0 = *(const u32x4*)kg, vv0 = *(const u32x4*)vg;
          const u32x4 kv1 = *(const u32x4*)(kg + (size_t)t1 * 64 * KVW), vv1 = *(const u32x4*)(vg + t1 * 64);
          const u32x4 kv2 = *(const u32x4*)(kg + (size_t)t2 * 64 * KVW), vv2 = *(const u32x4*)(vg + t2 * 64);
          *(LAS u32x4*)(F.lds + P5_KBUF + ldsK) = kv0; *(LAS u32x4*)(F.lds + P5_VBUF + ldsK) = vv0;
          *(LAS u32x4*)(F.lds + P5_KBUF + 8192 + ldsK) = kv1; *(LAS u32x4*)(F.lds + P5_VBUF + 8192 + ldsK) = vv1;
          *(LAS u32x4*)(F.lds + P5_KBUF + 16384 + ldsK) = kv2; *(LAS u32x4*)(F.lds + P5_VBUF + 16384 + ldsK) = vv2; }
        u32x4 mc0 = *(const u32x4*)mg, mc1 = *(const u32x4*)(mg + 16);
        __syncthreads();
        f32x16 pa0, pa1, pb0, pb1; bf16x8 Kf[8], Vf[8]; P5_LDK(Kf, 0); P5_QKF(pa0, pa1, Kf);
        int s0 = 0;
#define P5_SLOT(j_) ((s0 + (j_)) >= 6 ? (s0 + (j_)) - 6 : (s0 + (j_)))
#define P5_SDW(za_, zb_, xa_, xb_, mw_, SA_, SB_) asm("v_exp_f32 %0, %2\n\tv_exp_f32 %1, %3\n\tv_and_b32_sdwa %0, %0, sext(%4) dst_sel:DWORD dst_unused:UNUSED_PAD src0_sel:DWORD src1_sel:" SA_ "\n\t" \
            "v_and_b32_sdwa %1, %1, sext(%4) dst_sel:DWORD dst_unused:UNUSED_PAD src0_sel:DWORD src1_sel:" SB_ : "=&v"(za_), "=&v"(zb_) : "v"(xa_), "v"(xb_), "v"(mw_))
#define P5_X(PP, MM, s_, h_) do { _Pragma("unroll") for (int i_ = 0; i_ < 4; i_ += 2) { \
            const int ra_ = 8 * ((s_) & 1) + 4 * (h_) + i_, rb_ = ra_ + 1; \
              \
            float za_, zb_; { const unsigned mw_ = MM[ra_ >> 2]; \
            if ((ra_ & 3) == 0) P5_SDW(za_, zb_, PP[ra_], PP[rb_], mw_, "BYTE_0", "BYTE_1"); else P5_SDW(za_, zb_, PP[ra_], PP[rb_], mw_, "BYTE_2", "BYTE_3"); } \
            pw[s_][2 * (h_) + (i_ >> 1)] = cvt_pk_bf16(za_, zb_); } } while (0)
#define P5_SB __builtin_amdgcn_sched_barrier(0)
#define P5_Q(N0, N1, j_) do { if ((j_) == 0) N0 = __builtin_amdgcn_mfma_f32_32x32x16_bf16(Kf[0], Qf[0], (f32x16){}, 0, 0, 0); \
            else if ((j_) == 1) N1 = __builtin_amdgcn_mfma_f32_32x32x16_bf16(Kf[1], Qf[0], (f32x16){}, 0, 0, 0); \
            else if ((j_) & 1) N1 = __builtin_amdgcn_mfma_f32_32x32x16_bf16(Kf[j_], Qf[(j_) >> 1], N1, 0, 0, 0); \
            else N0 = __builtin_amdgcn_mfma_f32_32x32x16_bf16(Kf[j_], Qf[(j_) >> 1], N0, 0, 0, 0); } while (0)
#define P5_PB(s_) __builtin_bit_cast(bf16x8, ((u32x4){pw[s_][0], pw[s_][1], pw[s_][2], pw[s_][3]}))
#define P5_PVL(s_) Ls = __builtin_amdgcn_mfma_f32_32x32x16_bf16(ones, P5_PB(s_), Ls, 0, 0, 0)
#define P5_PV0(s_) O0 = __builtin_amdgcn_mfma_f32_32x32x16_bf16(Vf[2 * (s_)], P5_PB(s_), O0, 0, 0, 0)
#define P5_PV1(s_) O1 = __builtin_amdgcn_mfma_f32_32x32x16_bf16(Vf[2 * (s_) + 1], P5_PB(s_), O1, 0, 0, 0)
#define P5_STEP(C0, C1, N0, N1, kt_, sc_, sn_) do { \
            const int t1 = (kt_) + 1 < nkt ? (kt_) + 1 : (kt_); \
            const u32x4 mn0 = *(const u32x4*)(mg + t1 * 64), mn1 = *(const u32x4*)(mg + t1 * 64 + 16); \
            P5_LDKR(Kf, sn_, 0, 2); P5_LDVR(Vf, sc_, 0, 2); \
            const u32x4 m0 = mc0, m1 = mc1; \
            if ((kt_) + 3 > qt) { \
                const LAS float* bt = BT + (w >> 1 | (g << 2)) * P5_BTW + (tq - (kt_) * 64 - 4 * hi + 64);     \
                _Pragma("unroll") for (int r2 = 0; r2 < 16; ++r2) { const int kk = (r2 & 3) + 8 * (r2 >> 2); C0[r2] += bt[-kk]; C1[r2] += bt[-kk - 32]; } \
            } \
            unsigned pw[4][4]; \
            P5_SB; P5_Q(N0, N1, 0); P5_SB; P5_X(C0, m0, 0, 0); P5_SB; P5_Q(N0, N1, 1); P5_SB; P5_Q(N0, N1, 2); P5_SB; P5_X(C0, m0, 0, 1); P5_SB; P5_Q(N0, N1, 3); P5_LDKR(Kf, sn_, 2, 4); P5_SB; \
            P5_PVL(0); P5_SB; P5_X(C0, m0, 1, 0); P5_SB; P5_PV0(0); P5_SB; P5_PV1(0); P5_LDVR(Vf, sc_, 2, 3); P5_SB; P5_X(C0, m0, 1, 1); P5_SB; P5_Q(N0, N1, 4); P5_SB; \
            P5_PVL(1); P5_SB; P5_X(C1, m1, 2, 0); P5_SB; P5_PV0(1); P5_SB; P5_PV1(1); P5_LDVR(Vf, sc_, 3, 4); P5_SB; P5_X(C1, m1, 2, 1); P5_SB; P5_Q(N0, N1, 5); P5_SB; \
            P5_PVL(2); P5_SB; P5_X(C1, m1, 3, 0); P5_SB; P5_PV0(2); P5_SB; P5_PV1(2); P5_SB; P5_X(C1, m1, 3, 1); P5_SB; P5_Q(N0, N1, 6); P5_SB; P5_Q(N0, N1, 7); P5_SB; \
            P5_PVL(3); P5_PV0(3); P5_PV1(3); P5_SB; \
            mc0 = mn0; mc1 = mn1; } while (0)
        int kt = 0;
        for (; kt + 2 <= nkt; kt += 2) {
            const int t3 = kt + 3 < nkt ? kt + 3 : nkt - 1, t4 = kt + 4 < nkt ? kt + 4 : nkt - 1;
            const u32x4 k3 = *(const u32x4*)(kg + (size_t)t3 * 64 * KVW), v3 = *(const u32x4*)(vg + t3 * 64);
            const u32x4 k4 = *(const u32x4*)(kg + (size_t)t4 * 64 * KVW), v4 = *(const u32x4*)(vg + t4 * 64);
            const int sA = P5_SLOT(0), sB = P5_SLOT(1), sC = P5_SLOT(2), sD = P5_SLOT(3), sE = P5_SLOT(4);
            P5_STEP(pa0, pa1, pb0, pb1, kt, sA, sB);
            P5_STEP(pb0, pb1, pa0, pa1, kt + 1, sB, sC);
            if (kt + 3 < nkt) { *(LAS u32x4*)(F.lds + P5_KBUF + sD * 8192 + ldsK) = k3; *(LAS u32x4*)(F.lds + P5_VBUF + sD * 8192 + ldsK) = v3; }
            if (kt + 4 < nkt) { *(LAS u32x4*)(F.lds + P5_KBUF + sE * 8192 + ldsK) = k4; *(LAS u32x4*)(F.lds + P5_VBUF + sE * 8192 + ldsK) = v4; }
            s0 = sC;
            __syncthreads();
        }
        if (kt < nkt) { const int sA = P5_SLOT(0), sB = P5_SLOT(1); P5_STEP(pa0, pa1, pb0, pb1, kt, sA, sB); __syncthreads(); }
#undef P5_STEP
#undef P5_SLOT
        const float inv = 1.f / Ls[0];
        LAS bf16_t* stg = (LAS bf16_t*)(F.lds + P5_STG) + w * (32 * 72);
#pragma unroll
        for (int r2 = 0; r2 < 16; ++r2) { const int dim = crow32(r2, hi);
            stg[q32 * 72 + dim] = (bf16_t)f2bf(O0[r2] * inv); stg[q32 * 72 + dim + 32] = (bf16_t)f2bf(O1[r2] * inv); }
        LDS_WAIT(); asm volatile("" ::: "memory");
#pragma unroll
        for (int i = 0; i < 4; ++i) { const int row = i * 8 + (lane >> 3), ch = lane & 7;
            const u32x4 v = *(const LAS u32x4*)(stg + row * 72 + ch * 8);
            *(u32x4*)(AO + (size_t)(b * SEQ + t0 + 32 * (w & 1) + row) * AW + h * 64 + ch * 8) = v; }
    }
#undef P5_QK
}
namespace pg8 {
template <bool ADD> struct EpiGate {
    static constexpr int PERM = 3; static constexpr bool IDEMP = !ADD;
    const bf16_t* G; int ldg; bf16_t* O;
    __device__ __forceinline__ void operator()(const f32x4 (&acc)[2][2][4][2], const Unit& u, int wr, int wc, int fr, int fq) const {
        const int row0 = u.row0 + wr * 64 + fr; const int col0 = u.pn * BM + wc * 64 + 8 * fq;
#pragma unroll
        for (int ai = 0; ai < 2; ++ai)
#pragma unroll
            for (int m = 0; m < 4; ++m) { const size_t row = (size_t)(row0 + ai * HALF + m * 16);
#pragma unroll
                for (int bj = 0; bj < 2; ++bj) { const f32x4 v0 = acc[ai][bj][m][0], v1 = acc[ai][bj][m][1];
                    const u32x4 g = *(const u32x4*)(G + row * ldg + col0 + bj * 32);
                    float r[8] = {v0[0] * sigmoid_f(bf_lo(g.x)), v0[1] * sigmoid_f(bf_hi(g.x)), v0[2] * sigmoid_f(bf_lo(g.y)), v0[3] * sigmoid_f(bf_hi(g.y)),
                                  v1[0] * sigmoid_f(bf_lo(g.z)), v1[1] * sigmoid_f(bf_hi(g.z)), v1[2] * sigmoid_f(bf_lo(g.w)), v1[3] * sigmoid_f(bf_hi(g.w))};
                    bf16_t* op = O + row * D + col0 + bj * 32;
                    if (ADD) { const u32x4 o = *(const u32x4*)op;
                        r[0] += bf_lo(o.x); r[1] += bf_hi(o.x); r[2] += bf_lo(o.y); r[3] += bf_hi(o.y); r[4] += bf_lo(o.z); r[5] += bf_hi(o.z); r[6] += bf_lo(o.w); r[7] += bf_hi(o.w); }
                    u32x4 w; w.x = cvt_pk_bf16(r[0], r[1]); w.y = cvt_pk_bf16(r[2], r[3]); w.z = cvt_pk_bf16(r[4], r[5]); w.w = cvt_pk_bf16(r[6], r[7]);
                    *(u32x4*)op = w; } }
    }
};
struct EpiX1 {
    static constexpr int PERM = 0; static constexpr bool IDEMP = true;
    const float* X; const float* gate; float* O;
    __device__ __forceinline__ void operator()(const f32x4 (&acc)[2][2][4][2], const Unit& u, int wr, int wc, int fr, int fq) const {
        const int row0 = u.row0 + wr * 64 + fr; const int col0 = u.pn * BM + wc * 32 + 4 * fq; const float* gp = gate + (size_t)(u.row0 / SEQ) * 6 * D;
#pragma unroll
        for (int bj = 0; bj < 2; ++bj)
#pragma unroll
            for (int n = 0; n < 2; ++n) { const int c = col0 + bj * HALF + n * 16; const f32x4 gv = *(const f32x4*)(gp + c);
#pragma unroll
                for (int ai = 0; ai < 2; ++ai)
#pragma unroll
                    for (int m = 0; m < 4; ++m) { const size_t off = (size_t)(row0 + ai * HALF + m * 16) * D + c;
                        const f32x4 xv = *(const f32x4*)(X + off); const f32x4 ov = xv + gv * acc[ai][bj][m][n]; EPI_ST16(O + off, __builtin_bit_cast(u32x4, ov)); } }
    }
};
struct EpiY1 {
    static constexpr int PERM = 3; static constexpr bool IDEMP = true;
    const float* gate; bf16_t* O;
    __device__ __forceinline__ void operator()(const f32x4 (&acc)[2][2][4][2], const Unit& u, int wr, int wc, int fr, int fq) const {
        const int row0 = u.row0 + wr * 64 + fr; const int col0 = u.pn * BM + wc * 64 + 8 * fq; const float* gp = gate + (size_t)(u.row0 / SEQ) * 6 * D + col0;
#pragma unroll
        for (int bj = 0; bj < 2; ++bj) { const f32x4 g0 = *(const f32x4*)(gp + bj * 32), g1 = *(const f32x4*)(gp + bj * 32 + 4);
#pragma unroll
            for (int ai = 0; ai < 2; ++ai)
#pragma unroll
                for (int m = 0; m < 4; ++m) { bf16_t* rowp = O + (size_t)(row0 + ai * HALF + m * 16) * D + col0;
                    const f32x4 v0 = g0 * acc[ai][bj][m][0], v1 = g1 * acc[ai][bj][m][1];
                    u32x4 w; w.x = cvt_pk_bf16(v0[0], v0[1]); w.y = cvt_pk_bf16(v0[2], v0[3]); w.z = cvt_pk_bf16(v1[0], v1[1]); w.w = cvt_pk_bf16(v1[2], v1[3]);
                    EPI_ST16(rowp + bj * 32, w); } }
    }
};
struct EpiRouter {
    static constexpr int PERM = 0; static constexpr bool IDEMP = true;
    float* O;
    __device__ __forceinline__ void operator()(const f32x4 (&acc)[2][2][4][2], const Unit& u, int wr, int wc, int fr, int fq) const {
        const int row0 = u.row0 + wr * 64 + fr; const int ncols = (u.e & 1) ? 64 : 128, coff = ((u.e & 1) ? 128 : 0) + (u.e >> 1) * 192;
#pragma unroll
        for (int n = 0; n < 2; ++n) { const int c = wc * 32 + n * 16 + 4 * fq;
            if (c < ncols) {
#pragma unroll
                for (int ai = 0; ai < 2; ++ai)
#pragma unroll
                    for (int m = 0; m < 4; ++m) *(f32x4*)(O + (size_t)(row0 + ai * HALF + m * 16) * 384 + coff + c) = acc[ai][0][m][n]; } }
    }
};
struct EpiSwiglu {
    static constexpr int PERM = 1; static constexpr bool IDEMP = true;
    bf16_t* O;
    __device__ __forceinline__ void operator()(const f32x4 (&acc)[2][2][4][2], const Unit& u, int wr, int wc, int fr, int fq) const {
        const int row0 = u.row0 + wr * 64 + fr; const int col0 = u.pn * HALF + wc * 32 + 8 * fq;
#pragma unroll
        for (int ai = 0; ai < 2; ++ai)
#pragma unroll
            for (int m = 0; m < 4; ++m) { const f32x4 a0 = acc[ai][0][m][0], a1 = acc[ai][0][m][1], b0 = acc[ai][1][m][0], b1 = acc[ai][1][m][1];
                u32x4 w; w.x = cvt_pk_bf16(silu_f(a0[0]) * b0[0], silu_f(a0[1]) * b0[1]); w.y = cvt_pk_bf16(silu_f(a0[2]) * b0[2], silu_f(a0[3]) * b0[3]);
                w.z = cvt_pk_bf16(silu_f(a1[0]) * b1[0], silu_f(a1[1]) * b1[1]); w.w = cvt_pk_bf16(silu_f(a1[2]) * b1[2], silu_f(a1[3]) * b1[3]);
                EPI_ST16(O + (size_t)(row0 + ai * HALF + m * 16) * DE + col0, w); }
    }
};
constexpr float YB_SCALE = 1.f;
struct EpiFp8 {
    static constexpr int PERM = 2; static constexpr bool IDEMP = true;
    unsigned char* O; int nostore;
    __device__ __forceinline__ void operator()(const f32x4 (&acc)[2][2][4][2], const Unit& u, int wr, int wc, int fr, int fq) const {
        if (nostore == 2) { asm volatile("" :: "v"(acc[0][0][0][0]), "v"(acc[1][1][3][1])); return; }
        const int row0 = u.row0 + wr * 64 + fr; const int col0 = u.pn * BM + wc * 64 + 16 * fq;
#pragma unroll
        for (int ai = 0; ai < 2; ++ai)
#pragma unroll
            for (int m = 0; m < 4; ++m) { unsigned char* rowp = O + (size_t)(row0 + ai * HALF + m * 16) * D + col0; unsigned wv[4];
#pragma unroll
                for (int bj = 0; bj < 2; ++bj) { const f32x4 v0 = acc[ai][bj][m][0], v1 = acc[ai][bj][m][1];
                    int w0 = __builtin_amdgcn_cvt_pk_fp8_f32(v0[0], v0[1], 0, false); w0 = __builtin_amdgcn_cvt_pk_fp8_f32(v0[2], v0[3], w0, true);
                    int w1 = __builtin_amdgcn_cvt_pk_fp8_f32(v1[0], v1[1], 0, false); w1 = __builtin_amdgcn_cvt_pk_fp8_f32(v1[2], v1[3], w1, true);
                    wv[2 * bj] = (unsigned)w0; wv[2 * bj + 1] = (unsigned)w1; }
                if (!nostore) *(u32x4*)rowp = (u32x4){wv[0], wv[1], wv[2], wv[3]};     else asm volatile("" :: "v"(wv[0]), "v"(wv[1]), "v"(wv[2]), "v"(wv[3])); }
    }
};
struct RouterOrder {
    const char* Ahi; const char* Alo; const char* Bx; const char* By; int G, c; int krep = 1;
    __device__ __forceinline__ bool next(int i, Unit& u) const {
        const int L = i * G + c; if (L >= 256) return false;
        const int which = (L >> 6) & 1, kh = L >> 7;
        u.e = which | (kh << 1); u.pm = L & 63; u.pn = 0; u.row0 = u.pm * BM;
        u.A = (which ? Alo : Ahi) + (size_t)u.pm * BM * D * 2 + (size_t)kh * (D / 2) * 2; u.B = (which ? By : Bx) + (size_t)kh * (D / 2) * 2; return true;
    }
    __device__ __forceinline__ const LAS int* list(int) const { return nullptr; }
    __device__ __forceinline__ void a_ready(const Unit&) const {}
    __device__ __forceinline__ void done(const Unit&) const {}
};
struct MoeOrder {
    const char* A; const char* W; const LAS int* tstart; const LAS int* lists; int G, c, npn_shift, a_tile_bytes; size_t w_exp_bytes, w_tile_bytes;
    const LAS int* uexp;
    int krep = 1;
    int L0 = 0, Llim = 0x7fffffff;
    unsigned* done_cnt = nullptr;
    unsigned* ready_cnt = nullptr;
    __device__ __forceinline__ int find_expert(int tile) const {
        int e = 0;
#pragma unroll 1
        for (int step = 32; step > 0; step >>= 1) if (e + step <= 64 && tstart[e + step] <= tile) e += step;
        if (e < 64 && tstart[e + 1] <= tile) e += 1;
        return e;
    }
    __device__ __forceinline__ void fill_table(LAS int* tab, int tid) const {
        if (tid < 32) { const int L = L0 + tid * G + c; const int tile = L >> npn_shift; tab[tid] = (L < Llim && tile < tstart[65]) ? find_expert(tile) : -1; }
    }
    __device__ __forceinline__ bool next(int i, Unit& u) const {
        const int e = i < 32 ? uexp[i] : -1; if (e < 0) return false;
        const int L = L0 + i * G + c; const int tile = L >> npn_shift;
        u.e = e; u.pm = tile; u.pn = L & ((1 << npn_shift) - 1); u.row0 = tile * BM;
        u.A = A + (size_t)tile * a_tile_bytes; u.B = W + (size_t)e * w_exp_bytes + (size_t)u.pn * w_tile_bytes; return true;
    }
    __device__ __forceinline__ const LAS int* list(int i) const { return lists + i * 256; }
    __device__ __forceinline__ void a_ready(const Unit& u) const {
        if (ready_cnt == nullptr) return;
        if (threadIdx.x < 64) {
            unsigned spins = 0;
            while ((unsigned)__builtin_amdgcn_readfirstlane((int)__hip_atomic_load(ready_cnt + u.pm, __ATOMIC_RELAXED, __HIP_MEMORY_SCOPE_AGENT)) < 32u) { __builtin_amdgcn_s_sleep(2); if (++spins > (1u << 20)) break; }
            __builtin_amdgcn_fence(__ATOMIC_ACQUIRE, "agent");
            asm volatile("s_waitcnt vmcnt(0)" ::: "memory");
        }
        asm volatile("" ::: "memory"); __builtin_amdgcn_s_barrier(); asm volatile("" ::: "memory");
    }
    __device__ __forceinline__ void done(const Unit& u) const {
        if (done_cnt != nullptr && (threadIdx.x & 63) == 0) (void)__hip_atomic_fetch_add(done_cnt + u.pm, 1u, __ATOMIC_RELAXED, __HIP_MEMORY_SCOPE_AGENT);
    }
};
}

__device__ __forceinline__ void p8_norm2(const Frame& F) {
    LAS float* sh = (LAS float*)F.lds; LAS float* sc = sh + D;
    const float* MOD = (const float*)(F.ws + WS_MOD);
    for (int blk = F.bid; blk < NTOK / 64; blk += F.G) {
        const int b = blk / (SEQ / 64);
        __syncthreads();
        for (int i = F.tid; i < D; i += NTHREADS) { sh[i] = MOD[b * 6 * D + 3 * D + i]; sc[i] = (1.f + MOD[b * 6 * D + 4 * D + i]) * F.in[4][i]; }
        __syncthreads();
        for (int j = 0; j < 8; ++j) {
            const int t = blk * 64 + F.wave * 8 + j;
            const f32x4* xr = (const f32x4*)(F.in[0] + (size_t)t * D) + F.lane; const u32x2* yr = (const u32x2*)((const bf16_t*)(F.ws + WS_Y1) + (size_t)t * D) + F.lane;
            f32x4 v[8]; float s = 0.f;
#pragma unroll
            for (int q = 0; q < 8; ++q) { const u32x2 yv = yr[64 * q]; v[q] = xr[64 * q] + (f32x4){bf_lo(yv.x), bf_hi(yv.x), bf_lo(yv.y), bf_hi(yv.y)}; s += (v[q].x * v[q].x + v[q].y * v[q].y) + (v[q].z * v[q].z + v[q].w * v[q].w); }
            const float r = rsqrtf(wave_sum(s) * (1.f / D) + EPS);
            u32x2* oh = (u32x2*)((bf16_t*)(F.ws + WS_HB) + (size_t)t * D) + F.lane;
            u32x2* ol = (u32x2*)((bf16_t*)(F.ws + WS_HLO) + (size_t)t * D) + F.lane;
#pragma unroll
            for (int q = 0; q < 8; ++q) { const int c0 = 4 * F.lane + 256 * q;
                const f32x4 a = *(const LAS f32x4*)(sc + c0), bb = *(const LAS f32x4*)(sh + c0);
                const float y0 = v[q].x * r * a.x + bb.x, y1 = v[q].y * r * a.y + bb.y, y2 = v[q].z * r * a.z + bb.z, y3 = v[q].w * r * a.w + bb.w;
                u32x2 wh; wh.x = pk2(y0, y1); wh.y = pk2(y2, y3);
                u32x2 wl; wl.x = pk2(y0 - bf_lo(wh.x), y1 - bf_hi(wh.x)); wl.y = pk2(y2 - bf_lo(wh.y), y3 - bf_hi(wh.y));
                oh[64 * q] = wh; ol[64 * q] = wl; }
        }
    }
}

__device__ __forceinline__ void p10a_route(const Frame& F) {
    const float* RLOG = (const float*)(F.ws + WS_RLOG); const float* rbias = F.in[17];
    int* TOKE = (int*)(F.ws + WS_TOKE); float* TOKW = (float*)(F.ws + WS_TOKW); int* TOKRANK = (int*)(F.ws + WS_TOKRANK); int* BLKBASE = (int*)(F.ws + WS_BLKBASE);
    LAS int* hist = (LAS int*)F.lds;
    const int e = F.lane; const float rb = rbias[e];
    for (int blk = F.bid; blk < NTOK / 64; blk += F.G) {
        __syncthreads();
        if (F.tid < 64) hist[F.tid] = 0;
        __syncthreads();
        for (int j = 0; j < 8; ++j) {
            const int t = blk * 64 + F.wave * 8 + j;
            const float* rl = RLOG + (size_t)t * 384;
            const float logit = ((rl[e] + rl[192 + e]) + (rl[64 + e] + rl[256 + e])) + (rl[128 + e] + rl[320 + e]);
            const float s = 1.f / (1.f + expf(-logit)), sel = s + rb;
            float m1 = sel;
            m1 = fmaxf(m1, __shfl_xor(m1, 1)); m1 = fmaxf(m1, __shfl_xor(m1, 2)); m1 = fmaxf(m1, __shfl_xor(m1, 4));
            const unsigned long long ismax = __ballot(sel == m1);
            const int firstmax = __ffsll((long long)((ismax >> (e & ~7)) & 0xffull)) - 1 + (e & ~7);
            float m2 = (e == firstmax) ? -3.0e38f : sel;
            m2 = fmaxf(m2, __shfl_xor(m2, 1)); m2 = fmaxf(m2, __shfl_xor(m2, 2)); m2 = fmaxf(m2, __shfl_xor(m2, 4));
            const float gs = m1 + m2; const int g = e >> 3;
            int grank = 0;
#pragma unroll
            for (int g2 = 0; g2 < 8; ++g2) { const float o = __shfl(gs, g2 * 8); grank += (o > gs || (o == gs && g2 < g)) ? 1 : 0; }
            const float cand = grank < 4 ? sel : -1.0e30f;
            int rank = 0;
#pragma unroll
            for (int e2 = 0; e2 < 64; ++e2) { const float o = __shfl(cand, e2); rank += (o > cand || (o == cand && e2 < e)) ? 1 : 0; }
            const bool chosen = rank < 8;
            const float wsum = wave_sum(chosen ? s : 0.f);
            if (chosen) {
                const int lr = __hip_atomic_fetch_add(&hist[e], 1, __ATOMIC_RELAXED, __HIP_MEMORY_SCOPE_WORKGROUP);
                TOKE[t * 8 + rank] = e; TOKW[t * 8 + rank] = s / wsum * 2.5f; TOKRANK[t * 8 + rank] = lr;
            }
        }
        __syncthreads();
        if (F.tid < 64) { const int base = (int)atomicAdd(F.ctl + CW_CNT + F.tid, (unsigned)hist[F.tid]); BLKBASE[blk * 64 + F.tid] = base; }
    }
}
__device__ __forceinline__ void moe_tile_table(const Frame& F, LAS int* tst) {
    __syncthreads();
    if (F.tid == 0) { int o = 0; for (int e = 0; e < 64; ++e) { tst[e] = o; o += ((int)F.ctl[CW_CNT + e] + 255) >> 8; } tst[64] = o; tst[65] = o + NTOK / 256; }
    __syncthreads();
}
__device__ __forceinline__ int moe_tail_units(int T) {
    const int rem = (4 * T) & 255, ntail = rem ? 256 - rem : 0;
    const int R = max(0, (8 * T - TAIL_CAP * ntail + 255) >> 8);
    return max(0, 8 * T - 256 * R);
}
__device__ __forceinline__ void p10b_lists(const Frame& F) {
    const int* TOKE = (const int*)(F.ws + WS_TOKE); const int* TOKRANK = (const int*)(F.ws + WS_TOKRANK); const int* BLKBASE = (const int*)(F.ws + WS_BLKBASE);
    int* TOKPOS = (int*)(F.ws + WS_TOKPOS); int* SRT = (int*)(F.ws + WS_SRT);
    LAS int* tst = (LAS int*)F.lds;
    moe_tile_table(F, tst);
    for (int blk = F.bid; blk < NTOK / 64; blk += F.G) {
        { const int i = blk * 512 + F.tid;
          const int e = TOKE[i], pos = tst[e] * 256 + BLKBASE[blk * 64 + e] + TOKRANK[i];
          SRT[pos] = i >> 3; TOKPOS[i] = pos; }
        if (F.tid < 64) SRT[tst[64] * 256 + blk * 64 + F.tid] = blk * 64 + F.tid;
    }
    for (int e = F.bid; e < 64; e += F.G) {
        const int lo = tst[e] * 256 + (int)F.ctl[CW_CNT + e], hi = tst[e + 1] * 256;
        for (int p = lo + F.tid; p < hi; p += NTHREADS) SRT[p] = 0;
    }
}
__device__ __forceinline__ void p13_combine(const Frame& F) {
    const unsigned char* YB = (const unsigned char*)(F.ws + WS_YB); const int* TOKPOS = (const int*)(F.ws + WS_TOKPOS); const float* TOKW = (const float*)(F.ws + WS_TOKW);
    const float* MOD = (const float*)(F.ws + WS_MOD);
    LAS int* tst = (LAS int*)F.lds;
    moe_tile_table(F, tst);
    const int sh0 = tst[64] * 256;
    const int gw = F.bid * NWAVES + F.wave, NGW = F.G * NWAVES;
    for (int t = gw; t < NTOK; t += NGW) {
        const int b = t / SEQ;
        int pos[9]; float wk[9];
#pragma unroll
        for (int k = 0; k < 8; ++k) { pos[k] = TOKPOS[t * 8 + k]; wk[k] = TOKW[t * 8 + k] * (1.f / pg8::YB_SCALE); }
        pos[8] = sh0 + t; wk[8] = 1.f / pg8::YB_SCALE;
        float* orow = F.out + (size_t)t * D; const float* g2 = MOD + (size_t)b * 6 * D + 5 * D; const float* xrow = F.in[0] + (size_t)t * D; const bf16_t* yrow = (const bf16_t*)(F.ws + WS_Y1) + (size_t)t * D;
#pragma unroll 2
        for (int q = 0; q < 8; ++q) { const int c = 4 * F.lane + 256 * q;
            float a0 = 0.f, a1 = 0.f, a2 = 0.f, a3 = 0.f;
#pragma unroll
            for (int k = 0; k < 9; ++k) { const int y = *(const int*)(YB + (size_t)pos[k] * D + c);
                const f32x2 lo = __builtin_amdgcn_cvt_pk_f32_fp8(y, false), hi2 = __builtin_amdgcn_cvt_pk_f32_fp8(y, true);
                a0 += wk[k] * lo.x; a1 += wk[k] * lo.y; a2 += wk[k] * hi2.x; a3 += wk[k] * hi2.y; }
            const u32x2 yv = *(const u32x2*)(yrow + c); const f32x4 xv = *(const f32x4*)(xrow + c) + (f32x4){bf_lo(yv.x), bf_hi(yv.x), bf_lo(yv.y), bf_hi(yv.y)}, gv = *(const f32x4*)(g2 + c);
            *(f32x4*)(orow + c) = (f32x4){xv.x + gv.x * a0, xv.y + gv.y * a1, xv.z + gv.z * a2, xv.w + gv.w * a3}; }
    }
}
constexpr int N_PHASES = 16;
__global__ void __launch_bounds__(NTHREADS, 2) mk_fwd(Args args) {
    extern __shared__ __attribute__((aligned(16))) unsigned char lds_raw[];
    Frame F;
    F.lds = (LAS unsigned char*)lds_raw; F.ws = args.ws; F.ctl = (unsigned*)(args.ws + WS_CTL); F.in = args.in; F.out = args.out;
    F.tid = threadIdx.x; F.lane = F.tid & 63; F.wave = __builtin_amdgcn_readfirstlane(F.tid >> 6); F.G = gridDim.x; F.bid = blockIdx.x;
    volatile LAS unsigned* MISC = (volatile LAS unsigned*)(F.lds + MISC_OFF);
    if (F.tid < 64) MISC[F.tid] = 0u;
    __syncthreads();
    const int vcu = (F.G % 8 == 0) ? (F.bid & 7) * (F.G >> 3) + (F.bid >> 3) : F.bid;
    const int lo = args.ph_lo, hi = args.ph_hi;
    const bool need_bar = (hi - lo) > 1;
    XcdBarrier bar; bar.bar = F.ctl + CW_BAR + args.bar_region * XCD_BAR_WORDS; bar.x = 0; bar.st = MISC + 8;
    if (need_bar) bar = xcd_barrier_post(F.ctl + CW_BAR + args.bar_region * XCD_BAR_WORDS, MISC + 8);
#define IN(k) (lo <= (k) && (k) < hi)
#define SEAM(k) do { if (IN(k) && IN((k) + 1)) xcd_barrier(bar); } while (0)
#ifndef DUP_MASK
#define DUP_MASK 0
#endif
#define PHASE_NOSEAM(k, ...) if (IN(k)) { __VA_ARGS__ if ((DUP_MASK >> (k)) & 1) { xcd_barrier(bar); __VA_ARGS__ } }
#define PHASE(k, ...) if (IN(k)) { __VA_ARGS__ if ((DUP_MASK >> (k)) & 1) { xcd_barrier(bar); __VA_ARGS__ } } SEAM(k);

    PHASE(0, p0_prologue(F);)
    PHASE(1, p1_norm1(F);)
#ifdef CVT_XCD
    PHASE(2,  if (F.G != 256) { pg8::PlainOrder S; S.init(F.ws + WS_HB, F.ws + WS_WINT, NTOK, TOTP, D, F.G, F.bid); pg8::EpiBf16 E{(bf16_t*)(F.ws + WS_PROJ), TOTP}; pg8::gemm_phase<pg8::EpiBf16, pg8::PlainOrder, false>(F.lds, D, S, E); cvt_run<true>(F, NITEMS_EXP, 0, F.G); }
        else { const int xcd = F.bid & 7, jx = F.bid >> 3;
            int wg0 = 0, it0 = 0, nu = 0, it1 = 0;
            { int wacc = 0, iacc = 0;
              for (int x = 0; x < 8; ++x) { const int n_x = (P2_NU >> (4 * x)) & 15; const int q_x = (int)(((long long)NITEMS_EXP * ((P2_CV >> (4 * x)) & 15)) / P2_CVSUM);
                  if (x == xcd) { wg0 = wacc; nu = n_x; it0 = iacc; it1 = (x == 7) ? NITEMS_EXP : iacc + q_x; } wacc += 32 * n_x; iacc += q_x; } }
            { Frame Fx = F; Fx.bid = jx; cvt_run<true>(Fx, it1, 0, 32, it0); }
            pg8::XcdRunOrder S; S.A = (const char*)(F.ws + WS_HB); S.Bt = (const char*)(F.ws + WS_WINT); S.K = D; S.nM = NTOK / 256; S.nN = TOTP / 256; S.wg0 = wg0; S.wpx = 32; S.j = jx; S.nu = nu;
            pg8::EpiBf16 E{(bf16_t*)(F.ws + WS_PROJ), TOTP}; pg8::gemm_phase<pg8::EpiBf16, pg8::XcdRunOrder, false>(F.lds, D, S, E); })
#elif defined(CVT_OVERLAP) && !defined(CVT_IN_ATTN) && !defined(CVT_P0_ON)
    PHASE(2,  constexpr int NU = (NTOK / 256) * (TOTP / 256);
        if (F.G <= CVT_NG) { pg8::PlainOrder S; S.init(F.ws + WS_HB, F.ws + WS_WINT, NTOK, TOTP, D, F.G, F.bid); pg8::EpiBf16 E{(bf16_t*)(F.ws + WS_PROJ), TOTP}; pg8::gemm_phase<pg8::EpiBf16, pg8::PlainOrder, false>(F.lds, D, S, E); cvt_run<true>(F, NITEMS_EXP, 0, F.G); }
        else { pg8::PlainOrder S; pg8::EpiBf16 E{(bf16_t*)(F.ws + WS_PROJ), TOTP};
            if (F.bid < CVT_NG) {
#if defined(STAG2) && STAG2 > 0
                { const unsigned long long t0_ = __builtin_amdgcn_s_memrealtime(); const unsigned long long dl_ = (unsigned long long)((F.bid & 7) * STAG2); while (__builtin_amdgcn_s_memrealtime() - t0_ < dl_) __builtin_amdgcn_s_sleep(8); }
#endif
                S.init(F.ws + WS_HB, F.ws + WS_WINT, NTOK, TOTP, D, CVT_NG, F.bid);
#ifdef KREP_P2
 S.krep = KREP_P2;
#endif
 S.Lend = CVT_NG * CVT_UG < NU ? CVT_NG * CVT_UG : NU; }
            else { cvt_run<true>(F, NITEMS_EXP, CVT_NG, F.G - CVT_NG); S.init(F.ws + WS_HB, F.ws + WS_WINT, NTOK, TOTP, D, F.G - CVT_NG, F.bid - CVT_NG); S.L0 = CVT_NG * CVT_UG < NU ? CVT_NG * CVT_UG : NU; }

#ifdef P2X
            if (F.bid < CVT_NG) { pg8::EpiBf16 E0{(bf16_t*)(F.ws + WS_PROJ), TOTP, P2X == 1 ? 1 : 0}; pg8::gemm_phase<pg8::EpiBf16, pg8::PlainOrder, false>(F.lds, D, S, E0); }
#endif
            pg8::gemm_phase<pg8::EpiBf16, pg8::PlainOrder, false>(F.lds, D, S, E); })
#else
    PHASE(2,  pg8::PlainOrder S; S.init(F.ws + WS_HB, F.ws + WS_WINT, NTOK, TOTP, D, F.G, F.bid); pg8::EpiBf16 E{(bf16_t*)(F.ws + WS_PROJ), TOTP}; pg8::gemm_phase<pg8::EpiBf16, pg8::PlainOrder, false>(F.lds, D, S, E);)
#endif
    PHASE(3, p3_mix(F);)
#ifdef CVT_IN_ATTN
    PHASE(4, if (F.G <= CVT_NG2) { p4_index(F); cvt_run<true>(F, CVT_SPLIT, 0, F.G); } else if (F.bid < CVT_NG2) { Frame Fg = F; Fg.G = CVT_NG2; p4_index(Fg); } else { cvt_run<true>(F, CVT_SPLIT, CVT_NG2, F.G - CVT_NG2); })
    PHASE(5, if (F.G <= CVT_NG2) { p5_attn(F); cvt_run<true>(F, NITEMS_EXP, 0, F.G, CVT_SPLIT); } else if (F.bid < CVT_NG2) { Frame Fg = F; Fg.G = CVT_NG2; p5_attn(Fg); } else { cvt_run<true>(F, NITEMS_EXP, CVT_NG2, F.G - CVT_NG2, CVT_SPLIT); })
#else
    PHASE(4, p4_index(F);)
    PHASE(5, p5_attn(F);)
#endif
    PHASE_NOSEAM(6,  pg8::PlainOrder S; S.init(F.ws + WS_UMIX, F.ws + WS_WCVT, NTOK, D, CW, F.G, F.bid); pg8::EpiGate<false> E{(const bf16_t*)(F.ws + WS_PROJ) + O_GA, TOTP, (bf16_t*)(F.ws + WS_HB)}; pg8::gemm_phase<pg8::EpiGate<false>, pg8::PlainOrder, false>(F.lds, CW, S, E);)
    PHASE(7,  pg8::PlainOrder S; S.init(F.ws + WS_AO, F.ws + WS_WATT, NTOK, D, AW, F.G, F.bid); pg8::EpiGate<true> E{(const bf16_t*)(F.ws + WS_PROJ) + O_GB, TOTP, (bf16_t*)(F.ws + WS_HB)}; pg8::gemm_phase<pg8::EpiGate<true>, pg8::PlainOrder, false>(F.lds, AW, S, E);)
    PHASE(8,  pg8::PlainOrder S; S.init(F.ws + WS_HB, F.ws + WS_WOT, NTOK, D, D, F.G, F.bid); pg8::EpiY1 E{(const float*)(F.ws + WS_MOD) + 2 * D, (bf16_t*)(F.ws + WS_Y1)}; pg8::gemm_phase<pg8::EpiY1, pg8::PlainOrder, false>(F.lds, D, S, E);)
    PHASE(9, p8_norm2(F);)
    PHASE(10,  pg8::RouterOrder S{(const char*)(F.ws + WS_HB), (const char*)(F.ws + WS_HLO), (const char*)(F.ws + WS_WRX), (const char*)(F.ws + WS_WRY), F.G, F.bid}; pg8::EpiRouter E{(float*)(F.ws + WS_RLOG)}; pg8::gemm_phase<pg8::EpiRouter, pg8::RouterOrder, false>(F.lds, D / 2, S, E, D);)
    PHASE(11, p10a_route(F);)
    PHASE(12, p10b_lists(F);)
    PHASE(13,  LAS int* tst = (LAS int*)(F.lds + LIST_OFF + 11264); LAS int* lists = (LAS int*)(F.lds + LIST_OFF); moe_tile_table(F, tst); const int* SRT = (const int*)(F.ws + WS_SRT); for (int i = 0; i < 11; ++i) { const int tile = (i * F.G + vcu) >> 2; if (tile >= tst[65]) break; if (F.tid < 256) lists[i * 256 + F.tid] = SRT[tile * 256 + F.tid]; } __syncthreads(); pg8::MoeOrder S{(const char*)(F.ws + WS_HB), (const char*)(F.ws + WS_W13T), tst, lists, F.G, vcu, 2, 0, (size_t)1024 * D * 2, (size_t)256 * D * 2, tst + 96}; S.fill_table(tst + 96, F.tid); __syncthreads(); S.Llim = 4 * tst[65]; S.done_cnt = F.ctl + CW_TDONE; pg8::EpiSwiglu E{(bf16_t*)(F.ws + WS_HH)}; pg8::gemm_phase<pg8::EpiSwiglu, pg8::MoeOrder, true>(F.lds, D, S, E);
               { const int T_ = tst[65], rem_ = (4 * T_) & 255, ntail_ = rem_ ? 256 - rem_ : 0; const int M_ = moe_tail_units(T_);
                 if (M_ > 0 && vcu >= rem_) { pg8::MoeOrder S2{(const char*)(F.ws + WS_HH), (const char*)(F.ws + WS_W2T), tst, nullptr, ntail_, vcu - rem_, 3, 256 * DE * 2, (size_t)D * DE * 2, (size_t)256 * DE * 2, tst + 128}; S2.Llim = M_; S2.ready_cnt = F.ctl + CW_TDONE;
                   S2.fill_table(tst + 128, F.tid); __syncthreads(); pg8::EpiFp8 E2{(unsigned char*)(F.ws + WS_YB), 0}; pg8::gemm_phase<pg8::EpiFp8, pg8::MoeOrder, false>(F.lds, DE, S2, E2); } })
#ifndef STAG14
#define STAG14 0
#endif
    PHASE(14,  if (STAG14 && vcu >= 8) { const unsigned long long t0_ = __builtin_amdgcn_s_memrealtime(); const unsigned long long dl_ = (unsigned long long)((vcu & 7) * STAG14); while (__builtin_amdgcn_s_memrealtime() - t0_ < dl_) __builtin_amdgcn_s_sleep(8); }
               LAS int* tst = (LAS int*)(F.lds + LIST_OFF + 11264); moe_tile_table(F, tst); pg8::MoeOrder S{(const char*)(F.ws + WS_HH), (const char*)(F.ws + WS_W2T), tst, nullptr, F.G, vcu, 3, 256 * DE * 2, (size_t)D * DE * 2, (size_t)256 * DE * 2, tst + 96}; S.L0 = moe_tail_units(tst[65]); S.Llim = 8 * tst[65]; S.fill_table(tst + 96, F.tid); __syncthreads(); pg8::EpiFp8 E{(unsigned char*)(F.ws + WS_YB), 0};
#if defined(P14X)
               { pg8::EpiFp8 E0{(unsigned char*)(F.ws + WS_YB), P14X == 1 ? 1 : (P14X == 3 ? 2 : 0)}; pg8::gemm_phase<pg8::EpiFp8, pg8::MoeOrder, false>(F.lds, DE, S, E0); xcd_barrier(bar); }
#endif
               pg8::gemm_phase<pg8::EpiFp8, pg8::MoeOrder, false>(F.lds, DE, S, E);)
#ifdef P15_DELAY
    PHASE(15, { const unsigned long long t0_ = __builtin_amdgcn_s_memrealtime(); while (__builtin_amdgcn_s_memrealtime() - t0_ < (unsigned long long)P15_DELAY) __builtin_amdgcn_s_sleep(8); } p13_combine(F);)
#else
    PHASE(15, p13_combine(F);)
#endif
#undef IN
#undef SEAM
}

static int g_grid = 0;
static bool mk_setup(size_t ws_size) {
    if (g_grid == 0) {
        if (ws_size < WS_END) { fprintf(stderr, "kernel_launch: workspace too small: %zu < %zu\n", ws_size, (size_t)WS_END); g_grid = -1; return false; }
        int dev = 0, cus = 0, per_cu = 0;
        if (hipGetDevice(&dev) != hipSuccess || hipDeviceGetAttribute(&cus, hipDeviceAttributeMultiprocessorCount, dev) != hipSuccess) { g_grid = -1; return false; }
        if (hipFuncSetAttribute((const void*)mk_fwd, hipFuncAttributeMaxDynamicSharedMemorySize, LDS_BYTES) != hipSuccess) { fprintf(stderr, "kernel_launch: hipFuncSetAttribute failed\n"); g_grid = -1; return false; }
        if (hipOccupancyMaxActiveBlocksPerMultiprocessor(&per_cu, (const void*)mk_fwd, NTHREADS, LDS_BYTES) != hipSuccess || per_cu < 1) { fprintf(stderr, "kernel_launch: occupancy query says %d\n", per_cu); }
        (void)hipGetLastError();
        g_grid = cus;
    }
    return g_grid > 0;
}
static void mk_launch(const Args& a0, int lo, int hi, int region, hipStream_t stream) {
    Args a = a0; a.ph_lo = lo; a.ph_hi = hi; a.bar_region = region;
    hipLaunchKernelGGL(mk_fwd, dim3(g_grid), dim3(NTHREADS), LDS_BYTES, stream, a);
}
#ifndef MK_N_LAUNCHES
#define MK_N_LAUNCHES 1
#endif
extern "C" void kernel_launch(void* const* d_in, const int* in_sizes, int n_in, void* d_out, int out_size, void* d_ws, size_t ws_size, hipStream_t stream) {
    if (!mk_setup(ws_size)) return;
    (void)hipMemsetAsync((char*)d_ws + WS_CTL, 0, CTL_ZERO_BYTES, stream);
    Args a{};
    for (int i = 0; i < 24; ++i) a.in[i] = (const float*)d_in[i];
    a.out = (float*)d_out; a.ws = (unsigned char*)d_ws;
    if (MK_N_LAUNCHES == 1) mk_launch(a, 0, N_PHASES, 0, stream);
    else for (int p = 0; p < N_PHASES; ++p) mk_launch(a, p, p + 1, 0, stream);
}
```

```cpp
#include <hip/hip_runtime.h>
#define CVT_OVERLAP 1
#ifndef P2_NU
#define P2_NU 0x679AABCDull
#endif
#ifndef P2_CV
#define P2_CV 0xA9644210ull
#endif
#define P2_CVSUM (((P2_CV >> 0) & 15) + ((P2_CV >> 4) & 15) + ((P2_CV >> 8) & 15) + ((P2_CV >> 12) & 15) + ((P2_CV >> 16) & 15) + ((P2_CV >> 20) & 15) + ((P2_CV >> 24) & 15) + ((P2_CV >> 28) & 15))
#ifndef CVT_UG
#define CVT_UG 13
#endif
#ifndef CVT_NG2
#define CVT_NG2 216
#endif
#ifndef CVT_SPLIT
#define CVT_SPLIT 47000
#endif
#ifndef CVT_NG
#define CVT_NG 192
#endif
#include <cstdint>
#include <cstdio>

#define LAS __attribute__((address_space(3)))
#define GAS __attribute__((address_space(1)))
typedef unsigned short bf16_t;
typedef short bf16x8 __attribute__((ext_vector_type(8)));
typedef short bf16x4 __attribute__((ext_vector_type(4)));
typedef float f32x2 __attribute__((ext_vector_type(2)));
typedef float f32x4 __attribute__((ext_vector_type(4)));
typedef float f32x16 __attribute__((ext_vector_type(16)));
typedef unsigned u32x2 __attribute__((ext_vector_type(2)));
typedef unsigned u32x4 __attribute__((ext_vector_type(4)));

constexpr int D = 2048, BATCH = 4, SEQ = 4096, NTOK = BATCH * SEQ;
constexpr int CW = 1024, NH = 16, NKV = 4, HD = 64, AW = 1024, KVW = 256, IH = 16, IDIM = 64, NSEL = 256;
constexpr int NE = 64, TOPK = 8, DE = 512;
constexpr int TOT = 9808, TOTP = 9984;
constexpr int O_CB = 0, O_CC = 1024, O_CU = 2048, O_Q = 3072, O_K = 4096, O_V = 4352, O_QI = 4608, O_KI = 5632, O_WI = 5696, O_GA = 5712, O_GB = 7760;
constexpr float EPS = 1e-6f;
constexpr int MAXPOS = NTOK * 8 + NE * 256 + NTOK;
constexpr int SH_POS0 = NTOK * 8 + NE * 256;

__device__ __forceinline__ unsigned f2bf(float f) { unsigned u = __builtin_bit_cast(unsigned, f); return (u + 0x7fffu + ((u >> 16) & 1u)) >> 16; }
__device__ __forceinline__ unsigned pk2(float lo, float hi) { return f2bf(lo) | (f2bf(hi) << 16); }
typedef __bf16 bf16x2_hw __attribute__((ext_vector_type(2)));
__device__ __forceinline__ unsigned cvt_pk_bf16(float lo, float hi) { const f32x2 v = {lo, hi}; const bf16x2_hw b = __builtin_convertvector(v, bf16x2_hw); return __builtin_bit_cast(unsigned, b); }
__device__ __forceinline__ float bf_lo(unsigned w) { return __builtin_bit_cast(float, w << 16); }
__device__ __forceinline__ float bf_hi(unsigned w) { return __builtin_bit_cast(float, w & 0xffff0000u); }
__device__ __forceinline__ float bf2f(bf16_t h) { return __builtin_bit_cast(float, (unsigned)h << 16); }
__device__ __forceinline__ float sigmoid_f(float x) { return __builtin_amdgcn_rcpf(1.f + __expf(-x)); }
__device__ __forceinline__ float silu_f(float x) { return x * __builtin_amdgcn_rcpf(1.f + __expf(-x)); }
#define DPP_ADD(v_, ctrl_) v_ += __builtin_bit_cast(float, __builtin_amdgcn_update_dpp(0, __builtin_bit_cast(int, v_), ctrl_, 0xf, 0xf, false))
__device__ __forceinline__ float row16_sum(float v) {
    DPP_ADD(v, 0xB1); DPP_ADD(v, 0x4E); DPP_ADD(v, 0x141); DPP_ADD(v, 0x140);
    return v;
}
__device__ __forceinline__ float wave_sum(float v) {
    v = row16_sum(v); const int iv = __builtin_bit_cast(int, v);
    return (__builtin_bit_cast(float, __builtin_amdgcn_readlane(iv, 0)) + __builtin_bit_cast(float, __builtin_amdgcn_readlane(iv, 16)))
         + (__builtin_bit_cast(float, __builtin_amdgcn_readlane(iv, 32)) + __builtin_bit_cast(float, __builtin_amdgcn_readlane(iv, 48)));
}
#ifndef EPI_PLAIN_STORES
#define EPI_ST16(ptr_, v_) asm volatile("global_store_dwordx4 %0, %1, off sc1" :: "v"(ptr_), "v"(v_) : "memory")
#else
#define EPI_ST16(ptr_, v_) (*(u32x4*)(ptr_) = (v_))
#endif
#define LDS_WAIT() asm volatile("s_waitcnt lgkmcnt(0)" ::: "memory")
#define VM_WAIT() asm volatile("s_waitcnt vmcnt(0)" ::: "memory")

#define XB_TMO      128
#define XB_XCNT(j)  (256  + 64 * (j))
#define XB_XSUB(j)  (1280 + 64 * (j))
#define XB_XGEN(j)  (2304 + 64 * (j))
#define XB_TOP      3328
#define XB_TOPGEN   3392
#define XCD_BAR_WORDS 3456
#define XB_SPIN_CAP (1u << 22)

__device__ __forceinline__ unsigned xb_ld(unsigned* p)              { return __hip_atomic_load(p, __ATOMIC_RELAXED, __HIP_MEMORY_SCOPE_AGENT); }
__device__ __forceinline__ unsigned xb_add(unsigned* p, unsigned v) { return __hip_atomic_fetch_add(p, v, __ATOMIC_RELAXED, __HIP_MEMORY_SCOPE_AGENT); }
__device__ __forceinline__ unsigned xb_xcc_id() { return (unsigned)__builtin_amdgcn_s_getreg((3 << 11) | 20) & 0xFu; }
#define XB_SPIN(cond, bar) do { unsigned _sp = 0; while (cond) { __builtin_amdgcn_s_sleep(1); \
    if ((++_sp & 255u) == 0u) { if (xb_ld(&(bar)[XB_TMO])) break; if (_sp > XB_SPIN_CAP) { atomicAdd(&(bar)[XB_TMO], 1u); break; } } } } while (0)

struct XcdBarrier { unsigned* bar; unsigned x; volatile LAS unsigned* st; };

__device__ __forceinline__ XcdBarrier xcd_barrier_post(unsigned* bar, volatile LAS unsigned* st) {
    XcdBarrier b; b.bar = bar; b.x = xb_xcc_id(); b.st = st;
    if (threadIdx.x == 0) (void)xb_add(&bar[XB_XCNT(b.x)], 1u);
    return b;
}
__device__ __forceinline__ void xcd_barrier_complete(unsigned* bar, unsigned x, unsigned& nloc, unsigned& nx) {
    const unsigned G = gridDim.x * gridDim.y * gridDim.z;
    unsigned sum, cnt, mine, sp = 0u;
    for (;;) {
        sum = 0u; cnt = 0u; mine = 0u;
#pragma unroll
        for (unsigned j = 0; j < 16; ++j) { const unsigned c = xb_ld(&bar[XB_XCNT(j)]); sum += c; cnt += (c > 0u) ? 1u : 0u; mine = (j == x) ? c : mine; }
        if (sum == G) break;
        __builtin_amdgcn_s_sleep(1);
        if ((++sp & 255u) == 0u) { if (xb_ld(&bar[XB_TMO])) break; if (sp > XB_SPIN_CAP) { atomicAdd(&bar[XB_TMO], 1u); break; } }
    }
    nloc = mine > 0u ? mine : 1u; nx = cnt > 0u ? cnt : 1u;
}
__device__ __forceinline__ void xcd_barrier(const XcdBarrier& b) {
    asm volatile("s_waitcnt vmcnt(0)" ::: "memory");
    __syncthreads();
    if (threadIdx.x == 0) {
        unsigned* bar = b.bar;
        __builtin_amdgcn_s_waitcnt(0);
        unsigned nloc = b.st[0], nx = b.st[1];
        if (nloc == 0u) { xcd_barrier_complete(bar, b.x, nloc, nx); b.st[0] = nloc; b.st[1] = nx; }
        const unsigned old = xb_add(&bar[XB_XSUB(b.x)], 1u);
        const unsigned gen = old / nloc;
        if (old + 1u == (gen + 1u) * nloc) {
            __builtin_amdgcn_fence(__ATOMIC_RELEASE, "agent");
            asm volatile("s_waitcnt vmcnt(0)" ::: "memory");
            const unsigned og = xb_add(&bar[XB_TOP], 1u);
            const unsigned tg = og / nx;
            if (og + 1u == (tg + 1u) * nx) xb_add(&bar[XB_TOPGEN], 1u);
            else XB_SPIN(xb_ld(&bar[XB_TOPGEN]) == tg, bar);
            __builtin_amdgcn_fence(__ATOMIC_ACQUIRE, "agent");
            xb_add(&bar[XB_XGEN(b.x)], 1u);
            asm volatile("s_waitcnt vmcnt(0)" ::: "memory");
        } else {
            XB_SPIN(xb_ld(&bar[XB_XGEN(b.x)]) == gen, bar);
            __builtin_amdgcn_fence(__ATOMIC_ACQUIRE, "agent");
            asm volatile("s_waitcnt vmcnt(0)" ::: "memory");
        }
    }
    __syncthreads();
}

namespace pg8 {
constexpr int BM = 256, BK = 64, HALF = 128, HTB = HALF * BK * 2, STAGE_BYTES = 8 * HTB;
__host__ __device__ __forceinline__ int lds_byte(int r, int c) { const int st = (r >> 4) * 2 + (c >> 5), rr = r & 15, cc = c & 31, ob = rr * 64 + cc * 2; return st * 1024 + (ob ^ (((ob >> 9) & 1) << 5)); }
__host__ __device__ __forceinline__ void stage_rc(int b, int& R, int& C) { const int st = b / 1024, sb = b % 1024, swz = sb ^ (((sb >> 9) & 1) << 5); R = (st >> 1) * 16 + swz / 64; C = (st & 1) * 32 + (swz % 64) / 2; }
__host__ __device__ __forceinline__ int perm32(int rho) { const int n = rho >> 4, i = rho & 15; return 8 * (i >> 2) + 4 * n + (i & 3); }

struct Unit { const char* A; const char* B; int pm, pn, e, row0; };

template <class Epi, class Sched, bool GATHER>
__device__ __forceinline__ void gemm_phase(LAS unsigned char* lds, const int K, const Sched& S, const Epi& E, const int LD = 0) {
    const int tid = threadIdx.x, wid = __builtin_amdgcn_readfirstlane(tid >> 6), lane = tid & 63, wr = wid >> 2, wc = wid & 3, fr = lane & 15, fq = lane >> 4;
    const int nt = K / BK; const int PK = LD ? LD : K;
    unsigned voffA[2][2], voffB[2][2]; int RA[2], CA2[2];
#pragma unroll
    for (int i = 0; i < 2; ++i) { int R, C; stage_rc(tid * 16 + i * 8192, R, C);
        RA[i] = R; CA2[i] = C * 2;
#pragma unroll
        for (int bj = 0; bj < 2; ++bj) { const int Rb = (int)Epi::PERM == 2 ? (64 * (R >> 5) + 16 * ((R >> 2) & 3) + 8 * bj + 4 * ((R >> 4) & 1) + (R & 3))
                                                       : (int)Epi::PERM == 3 ? (64 * (R >> 5) + 32 * bj + 8 * ((R >> 2) & 3) + 4 * ((R >> 4) & 1) + (R & 3))
                                                       : ((int)Epi::PERM == 1 ? ((R & ~31) + perm32(R & 31)) : R) + bj * HALF;
            voffB[bj][i] = (unsigned)(Rb * PK + C) * 2u; }
        voffA[0][i] = (unsigned)(R * PK + C) * 2u; voffA[1][i] = (unsigned)((R + HALF) * PK + C) * 2u; }
    const size_t kstep = (size_t)(BK * 2);
    const unsigned ldsw = (unsigned)wid * 1024u;
    const int aoff = lds_byte(wr * 64 + fr, fq * 8), boff = lds_byte(wc * 32 + fr, fq * 8);
#define PG8_SA(b, h) (((b) * 2 + (h)) * HTB)
#define PG8_SB(b, h) ((4 + (b) * 2 + (h)) * HTB)
#define PG8_STAGE(bufoff, gbase, voff) do { _Pragma("unroll") for (int _i = 0; _i < 2; ++_i) \
        __builtin_amdgcn_global_load_lds((const unsigned*)((const char*)(gbase) + (voff)[_i]), (LAS unsigned*)(lds + (bufoff) + ldsw + _i * 8192), 16, 0, 0); } while (0)
#define PG8_LDA(dst, b, h) do { _Pragma("unroll") for (int m = 0; m < 4; ++m) _Pragma("unroll") for (int k = 0; k < 2; ++k) dst[m][k] = *(const LAS bf16x8*)(lds + PG8_SA(b, h) + aoff + m * 2048 + k * 1024); } while (0)
#define PG8_LDB(dst, b, h) do { _Pragma("unroll") for (int n = 0; n < 2; ++n) _Pragma("unroll") for (int k = 0; k < 2; ++k) dst[n][k] = *(const LAS bf16x8*)(lds + PG8_SB(b, h) + boff + n * 2048 + k * 1024); } while (0)
#define PG8_MMA(ai, bj, At, Bt) do { __builtin_amdgcn_s_setprio(1); _Pragma("unroll") for (int m = 0; m < 4; ++m) _Pragma("unroll") for (int n = 0; n < 2; ++n) _Pragma("unroll") for (int k = 0; k < 2; ++k) \
        acc[ai][bj][m][n] = __builtin_amdgcn_mfma_f32_16x16x32_bf16(Bt[n][k], At[m][k], acc[ai][bj][m][n], 0, 0, 0); __builtin_amdgcn_s_setprio(0); } while (0)
#define PG8_WAIT_V(n) asm volatile("s_waitcnt vmcnt(" #n ")" ::: "memory")
#define PG8_WAIT_L(n) asm volatile("s_waitcnt lgkmcnt(" #n ")" ::: "memory")
#define PG8_BAR __builtin_amdgcn_s_barrier()
#define PG8_SCHED __builtin_amdgcn_sched_barrier(0)
#define PG8_GLIST(ui_) do { if constexpr (GATHER) { const LAS int* L_ = S.list(ui_); _Pragma("unroll") for (int h_ = 0; h_ < 2; ++h_) _Pragma("unroll") for (int i_ = 0; i_ < 2; ++i_) \
        voffA[h_][i_] = (unsigned)L_[h_ * HALF + RA[i_]] * (unsigned)(PK * 2) + (unsigned)CA2[i_]; } } while (0)
    Unit cur, nxt; int ui = 0;
    PG8_WAIT_V(0); __syncthreads();
    if (!S.next(0, cur)) return;
    S.a_ready(cur);
    Unit prevu = cur; bool have_prev = false;
    PG8_GLIST(0);
    f32x4 acc[2][2][4][2];
#pragma unroll
    for (int a = 0; a < 2; ++a)
#pragma unroll
        for (int b = 0; b < 2; ++b)
#pragma unroll
            for (int m = 0; m < 4; ++m)
#pragma unroll
                for (int n = 0; n < 2; ++n) acc[a][b][m][n] = (f32x4){0.f, 0.f, 0.f, 0.f};
    bf16x8 At[4][2], B0[2][2], B1[2][2];
    const char* cA = cur.A; const char* cB = cur.B;
    PG8_STAGE(PG8_SB(0, 0), cB, voffB[0]); PG8_STAGE(PG8_SB(0, 1), cB, voffB[1]); PG8_STAGE(PG8_SA(0, 0), cA, voffA[0]); PG8_STAGE(PG8_SA(0, 1), cA, voffA[1]);
    if (wr == 1) PG8_BAR;
    PG8_WAIT_V(2); PG8_BAR;
    PG8_STAGE(PG8_SB(1, 0), cB + kstep, voffB[0]); PG8_STAGE(PG8_SA(1, 0), cA + kstep, voffA[0]); PG8_STAGE(PG8_SB(1, 1), cB + kstep, voffB[1]);
    PG8_WAIT_V(6); PG8_BAR;
    for (;;) {
        const bool has_next = S.next(ui + 1, nxt);
        const char* nA = has_next ? nxt.A : cA; const char* nB = has_next ? nxt.B : cB;
#ifndef KREP
#define KREP 1
#endif
        const int krep_ = S.krep > 1 ? S.krep : KREP;
#pragma unroll 1
        for (int kr_ = 0; kr_ < krep_; ++kr_) {
        if (kr_) {
#pragma unroll
            for (int a = 0; a < 2; ++a)
#pragma unroll
                for (int b = 0; b < 2; ++b)
#pragma unroll
                    for (int m = 0; m < 4; ++m)
#pragma unroll
                        for (int n = 0; n < 2; ++n) acc[a][b][m][n] = (f32x4){0.f, 0.f, 0.f, 0.f};
        }
        for (int t = 0; t < nt; t += 2) {
            const bool lastt = (t == nt - 2), last = lastt && (kr_ == krep_ - 1);
            if (lastt && !last) {   }
            const char* a1 = cA + (size_t)(t + 1) * kstep;
            const char* a2 = last ? nA : (lastt ? cA : cA + (size_t)(t + 2) * kstep); const char* b2 = last ? nB : (lastt ? cB : cB + (size_t)(t + 2) * kstep);
            const char* a3 = a2 + kstep; const char* b3 = b2 + kstep;
            if (last && has_next) S.a_ready(nxt);
            PG8_LDB(B0, 0, 0); PG8_LDB(B1, 0, 1); PG8_SCHED; PG8_LDA(At, 0, 0); PG8_STAGE(PG8_SA(1, 1), a1, voffA[1]);
            if (GATHER && last && has_next) { PG8_GLIST(ui + 1); }
            PG8_WAIT_V(8); PG8_WAIT_L(0); PG8_BAR; PG8_MMA(0, 0, At, B0); PG8_MMA(0, 1, At, B1); PG8_BAR; PG8_SCHED;
            PG8_LDA(At, 0, 1); PG8_STAGE(PG8_SB(0, 0), b2, voffB[0]); PG8_STAGE(PG8_SB(0, 1), b2, voffB[1]); PG8_STAGE(PG8_SA(0, 0), a2, voffA[0]);
            PG8_WAIT_V(8); PG8_WAIT_L(0); PG8_BAR; PG8_MMA(1, 0, At, B0); PG8_MMA(1, 1, At, B1); PG8_BAR; PG8_SCHED;
            PG8_LDB(B0, 1, 0); PG8_LDB(B1, 1, 1); PG8_SCHED; PG8_LDA(At, 1, 0); PG8_STAGE(PG8_SA(0, 1), a2, voffA[1]);
            PG8_WAIT_V(8); PG8_WAIT_L(0); PG8_BAR; PG8_MMA(0, 0, At, B0); PG8_MMA(0, 1, At, B1); PG8_BAR; PG8_SCHED;
            PG8_LDA(At, 1, 1); PG8_STAGE(PG8_SB(1, 0), b3, voffB[0]); PG8_STAGE(PG8_SB(1, 1), b3, voffB[1]); PG8_STAGE(PG8_SA(1, 0), a3, voffA[0]);
            PG8_WAIT_V(8); PG8_WAIT_L(0); PG8_BAR; PG8_MMA(1, 0, At, B0); PG8_MMA(1, 1, At, B1); PG8_BAR; PG8_SCHED;
        }
        }
        if (wr == 0) PG8_BAR;
#ifndef EPI_REP
#define EPI_REP 1
#endif
        if (have_prev) S.done(prevu);
#pragma unroll 1
        for (int er_ = 0; er_ < (Epi::IDEMP ? EPI_REP : 1); ++er_) E(acc, cur, wr, wc, fr, fq);
        prevu = cur; have_prev = true;
        if (!has_next) break;
#pragma unroll
        for (int a = 0; a < 2; ++a)
#pragma unroll
            for (int b = 0; b < 2; ++b)
#pragma unroll
                for (int m = 0; m < 4; ++m)
#pragma unroll
                    for (int n = 0; n < 2; ++n) acc[a][b][m][n] = (f32x4){0.f, 0.f, 0.f, 0.f};
        cur = nxt; cA = nA; cB = nB; ++ui;
        if (wr == 1) PG8_BAR;
    }
    PG8_WAIT_V(0);
    if (have_prev) S.done(prevu);
    PG8_BAR;
#undef PG8_SA
#undef PG8_SB
#undef PG8_STAGE
#undef PG8_LDA
#undef PG8_LDB
#undef PG8_MMA
#undef PG8_WAIT_V
#undef PG8_WAIT_L
#undef PG8_BAR
#undef PG8_SCHED
#undef PG8_GLIST
}

struct PlainOrder {
    int krep = 1;
    const char* A; const char* Bt; int K; int nM, nN, nwg, G, c, L0, Lend;
    __device__ void init(const void* A_, const void* Bt_, int M, int N, int K_, int G_, int c_) { A = (const char*)A_; Bt = (const char*)Bt_; K = K_; nM = M / BM; nN = N / BM; nwg = nM * nN; G = G_; c = c_; L0 = 0; Lend = nwg; }
    __device__ __forceinline__ bool next(int i, Unit& u) const {
        const long L = (long)L0 + (long)i * G + c; if (L >= Lend) return false;
        int wgid = (int)L; { const int q = nwg / 8, r = nwg % 8, xcd = wgid % 8, off = wgid / 8; wgid = (xcd < r ? xcd * (q + 1) : r * (q + 1) + (xcd - r) * q) + off; }
        const int nig = 8 * nN, gid = wgid / nig, fm = gid * 8, gsz = (nM - fm) < 8 ? (nM - fm) : 8;
        u.pm = fm + ((wgid % nig) % gsz); u.pn = (wgid % nig) / gsz; u.e = 0; u.row0 = u.pm * BM;
        u.A = A + (size_t)u.pm * BM * K * 2; u.B = Bt + (size_t)u.pn * BM * K * 2; return true;
    }
    __device__ __forceinline__ const LAS int* list(int) const { return nullptr; }
    __device__ __forceinline__ void a_ready(const Unit&) const {}
    __device__ __forceinline__ void done(const Unit&) const {}
};
struct XcdRunOrder {
    int krep = 1;
    const char* A; const char* Bt; int K, nM, nN, wg0, wpx, j, nu;
    __device__ __forceinline__ bool next(int i, Unit& u) const {
        if (i >= nu) return false;
        const int wgid = wg0 + i * wpx + j; if (wgid >= nM * nN) return false;
        const int nig = 8 * nN, gid = wgid / nig, fm = gid * 8, gsz = (nM - fm) < 8 ? (nM - fm) : 8;
        u.pm = fm + ((wgid % nig) % gsz); u.pn = (wgid % nig) / gsz; u.e = 0; u.row0 = u.pm * BM;
        u.A = A + (size_t)u.pm * BM * K * 2; u.B = Bt + (size_t)u.pn * BM * K * 2; return true;
    }
    __device__ __forceinline__ const LAS int* list(int) const { return nullptr; }
    __device__ __forceinline__ void a_ready(const Unit&) const {}
    __device__ __forceinline__ void done(const Unit&) const {}
};

struct EpiBf16 {
    static constexpr int PERM = 3; static constexpr bool IDEMP = true;
    bf16_t* O; int ldc; int nostore = 0;
    __device__ __forceinline__ void operator()(const f32x4 (&acc)[2][2][4][2], const Unit& u, int wr, int wc, int fr, int fq) const {
        const int row0 = u.row0 + wr * 64 + fr; const int col0 = u.pn * BM + wc * 64 + 8 * fq;
#pragma unroll
        for (int ai = 0; ai < 2; ++ai)
#pragma unroll
            for (int m = 0; m < 4; ++m) { bf16_t* rowp = O + (size_t)(row0 + ai * HALF + m * 16) * ldc + col0;
#pragma unroll
                for (int bj = 0; bj < 2; ++bj) { const f32x4 v0 = acc[ai][bj][m][0], v1 = acc[ai][bj][m][1];
                    u32x4 w; w.x = cvt_pk_bf16(v0[0], v0[1]); w.y = cvt_pk_bf16(v0[2], v0[3]); w.z = cvt_pk_bf16(v1[0], v1[1]); w.w = cvt_pk_bf16(v1[2], v1[3]);
                    if (!nostore) EPI_ST16(rowp + bj * 32, w);
                    else asm volatile("" :: "v"(w.x), "v"(w.y), "v"(w.z), "v"(w.w)); } }
    }
};
}
constexpr size_t MiB = 1u << 20;
constexpr size_t WS_CTL = 0, CTL_ZERO_BYTES = 128 * 1024;
constexpr size_t WS_MOD = 1 * MiB;
constexpr size_t WS_MODP = WS_MOD + 256 * 1024;
constexpr size_t WS_TOKE = 3 * MiB, WS_TOKW = WS_TOKE + 512 * 1024, WS_TOKPOS = WS_TOKW + 512 * 1024, WS_TOKRANK = WS_TOKPOS + 512 * 1024;
constexpr size_t WS_BLKBASE = WS_TOKRANK + 512 * 1024;
constexpr size_t WS_SRT = 6 * MiB;
constexpr size_t WS_W2T = 8 * MiB;
constexpr size_t WS_HH = 138 * MiB;
#ifndef YB_MIB
#define YB_MIB 691
#endif
constexpr size_t WS_YB = (size_t)YB_MIB * MiB;
constexpr size_t WS_W13T = 298 * MiB;
constexpr size_t WS_MASKB = 558 * MiB;
constexpr size_t WS_HB = 558 * MiB;
constexpr size_t WS_WINT = 622 * MiB;
constexpr size_t WS_WCVT = 661 * MiB, WS_WATT = 665 * MiB, WS_WOT = 669 * MiB, WS_WRX = 677 * MiB, WS_WRY = 678 * MiB;
constexpr size_t WS_RLOG = 760 * MiB;
constexpr size_t WS_PROJ = 691 * MiB;
constexpr size_t WS_Y1 = 1011 * MiB;
constexpr size_t WS_HLO = WS_PROJ;
constexpr size_t WS_UMIX = 1003 * MiB, WS_AO = 1035 * MiB, WS_KN = 1067 * MiB, WS_VT = 1075 * MiB, WS_KIN = 1083 * MiB, WS_MASK = 1085 * MiB, WS_END = 1093 * MiB;
constexpr int CW_TMO = 0, CW_BAR = 4096, CW_CNT = 16384  , CW_CUR = 16384 + 64, CW_TDONE = 20000  ;
#ifndef TAIL_CAP_N
#define TAIL_CAP_N 3
#endif
constexpr int TAIL_CAP = TAIL_CAP_N;

constexpr int RING_BYTES = 131072;
constexpr int LIST_OFF = RING_BYTES;
constexpr int LDS_BYTES = 163840;
constexpr int MISC_OFF = LDS_BYTES - 256;
constexpr int NWAVES = 8, NTHREADS = 512;

struct Args {
    const float* in[24]; float* out; unsigned char* ws; int ph_lo, ph_hi, bar_region, pad;
};

struct Frame {
    LAS unsigned char* lds; unsigned* ctl; unsigned char* ws; const float* const* in; float* out;
    int tid, lane, wave, G, bid;
};
struct CvtItem { const float* W; bf16_t* dst; bf16_t* dst2; int K, N, k0, n0, mode; };
__device__ __forceinline__ void cvt_load(const CvtItem& it, f32x4 (&v)[8], int lane) {
    const int row = lane >> 3; int n = it.n0 + (lane & 7) * 4; n = n < it.N ? n : 0;
    const float* p = it.W + (size_t)(it.k0 + row) * it.N + n;
#pragma unroll
    for (int i = 0; i < 8; ++i) v[i] = __builtin_nontemporal_load((const f32x4*)(p + (size_t)(8 * i) * it.N));
}
template <bool MODES>
__device__ __forceinline__ void cvt_store(const CvtItem& it, const f32x4 (&v)[8], LAS float* scr, int lane) {
    const int row = lane >> 3, c4 = (lane & 7) * 4; const float keep = (it.n0 + c4 < it.N) ? 1.f : 0.f;
#pragma unroll
    for (int i = 0; i < 8; ++i) { LAS float* d = scr + (8 * i + row) * 33 + c4; d[0] = v[i].x * keep; d[1] = v[i].y * keep; d[2] = v[i].z * keep; d[3] = v[i].w * keep; }
    LDS_WAIT(); asm volatile("" ::: "memory");
    const int c = lane & 7; const int K = it.K;
    float x[4][8];
#pragma unroll
    for (int j = 0; j < 4; ++j) { const LAS float* s = scr + (8 * c) * 33 + (lane >> 3) + 8 * j;
#pragma unroll
        for (int q = 0; q < 8; ++q) x[j][q] = s[q * 33]; }
    LDS_WAIT(); asm volatile("" ::: "memory");
    bf16_t* dp = it.dst + (size_t)(lane >> 3) * K + it.k0 + 8 * c;
#pragma unroll
    for (int j = 0; j < 4; ++j) {
        u32x4 o; o.x = cvt_pk_bf16(x[j][0], x[j][1]); o.y = cvt_pk_bf16(x[j][2], x[j][3]); o.z = cvt_pk_bf16(x[j][4], x[j][5]); o.w = cvt_pk_bf16(x[j][6], x[j][7]);
        if (MODES && it.mode == 2) {
            o.x = cvt_pk_bf16(x[j][0] - bf_lo(o.x), x[j][1] - bf_hi(o.x)); o.y = cvt_pk_bf16(x[j][2] - bf_lo(o.y), x[j][3] - bf_hi(o.y));
            o.z = cvt_pk_bf16(x[j][4] - bf_lo(o.z), x[j][5] - bf_hi(o.z)); o.w = cvt_pk_bf16(x[j][6] - bf_lo(o.w), x[j][7] - bf_hi(o.w)); }
        __builtin_nontemporal_store(o, (u32x4*)(dp + (size_t)(8 * j) * K));
        if (MODES && it.mode == 1) __builtin_nontemporal_store(o, (u32x4*)(it.dst2 + (size_t)((lane >> 3) + 8 * j) * K + it.k0 + 8 * c)); }
}
constexpr int NB_IN = (TOT + 31) / 32;
constexpr int I_IN = (D / 64) * NB_IN, I_CV = (CW / 64) * (D / 32), I_AT = I_CV, I_O = (D / 64) * (D / 32), I_R = (D / 64) * 2 * 2;
constexpr int I_13 = (D / 64) * (DE / 32)  , I_2 = (DE / 64) * (D / 32)  ;
constexpr int NITEMS_SMALL = I_IN + I_CV + I_AT + I_O + I_R, NITEMS_EXP = 130 * I_13 + 65 * I_2;
__device__ __forceinline__ CvtItem small_item(const Frame& F, int r) {
    CvtItem it; it.dst2 = nullptr; it.mode = 0;
    if (r < I_IN) { const int kb = r / NB_IN, nb = r % NB_IN; it.W = F.in[7]; it.K = D; it.N = TOT; it.k0 = 64 * kb; it.n0 = 32 * nb; it.dst = (bf16_t*)(F.ws + WS_WINT) + (size_t)(32 * nb) * D; return it; } r -= I_IN;
    if (r < I_CV) { const int kb = r / (D / 32), nb = r % (D / 32); it.W = F.in[9]; it.K = CW; it.N = D; it.k0 = 64 * kb; it.n0 = 32 * nb; it.dst = (bf16_t*)(F.ws + WS_WCVT) + (size_t)(32 * nb) * CW; return it; } r -= I_CV;
    if (r < I_AT) { const int kb = r / (D / 32), nb = r % (D / 32); it.W = F.in[14]; it.K = AW; it.N = D; it.k0 = 64 * kb; it.n0 = 32 * nb; it.dst = (bf16_t*)(F.ws + WS_WATT) + (size_t)(32 * nb) * AW; return it; } r -= I_AT;
    if (r < I_O) { const int kb = r / (D / 32), nb = r % (D / 32); it.W = F.in[15]; it.K = D; it.N = D; it.k0 = 64 * kb; it.n0 = 32 * nb; it.dst = (bf16_t*)(F.ws + WS_WOT) + (size_t)(32 * nb) * D; return it; } r -= I_O;
    { it.mode = 1 + (r & 1); const int q = r >> 1, kb = q / 2, nb = q % 2; it.W = F.in[16]; it.K = D; it.N = NE; it.k0 = 64 * kb; it.n0 = 32 * nb;
      it.dst = (bf16_t*)(F.ws + WS_WRX) + (size_t)((it.mode == 2 ? 64 : 0) + 32 * nb) * D; it.dst2 = (bf16_t*)(F.ws + WS_WRY) + (size_t)(32 * nb) * D; return it; }
}
__device__ __forceinline__ CvtItem expert_item(const Frame& F, int r) {
    CvtItem it; it.dst2 = nullptr; it.mode = 0;
    const bool up = r < 130 * I_13; const int r2 = up ? r : r - 130 * I_13;
    const int mtx = r2 >> 9, q = r2 & 511;
    const int kb = up ? (q >> 4) : (q >> 6), nb = up ? (q & 15) : (q & 63);
    const int is3 = ((mtx >= 64 && mtx < 128) || mtx == 129) ? 1 : 0; const int e = mtx < 64 ? mtx : (mtx < 128 ? mtx - 64 : 64);
    const float* Wup = mtx < 64 ? F.in[18] + (size_t)mtx * D * DE : (mtx < 128 ? F.in[19] + (size_t)(mtx - 64) * D * DE : (mtx == 128 ? F.in[21] : F.in[22]));
    const float* Wdn = mtx < 64 ? F.in[20] + (size_t)mtx * DE * D : F.in[23];
    const int n0 = 32 * nb; const int drow = e * 1024 + (n0 >> 7) * 256 + is3 * 128 + (n0 & 127);
    it.W = up ? Wup : Wdn; it.K = up ? D : DE; it.N = up ? DE : D; it.k0 = 64 * kb; it.n0 = n0;
    it.dst = up ? (bf16_t*)(F.ws + WS_W13T) + (size_t)drow * D : (bf16_t*)(F.ws + WS_W2T) + ((size_t)mtx * D + n0) * DE;
    return it;
}
template <bool EXPERTS>
__device__ __forceinline__ void cvt_run(const Frame& F, int n, int blk0, int nblk, int first = 0) {
    LAS float* scr = (LAS float*)(F.lds + F.wave * 16384);
    const int gw = first + (F.bid - blk0) * NWAVES + F.wave, S = nblk * NWAVES;
    const int cnt = gw < n ? (n - gw + S - 1) / S : 0; if (cnt == 0) return;
    CvtItem i0, i1, i2, i3; f32x4 v0[8], v1[8], v2[8], v3[8];
#define CV_LD(I, V, k_) do { const int kk_ = (k_) < cnt ? (k_) : cnt - 1; I = EXPERTS ? expert_item(F, gw + kk_ * S) : small_item(F, gw + kk_ * S); cvt_load(I, V, F.lane); } while (0)
    CV_LD(i0, v0, 0); CV_LD(i1, v1, 1); CV_LD(i2, v2, 2);
    int k = 0;
    for (; k + 4 <= cnt; k += 4) {
        CV_LD(i3, v3, k + 3); cvt_store<!EXPERTS>(i0, v0, scr, F.lane);
        CV_LD(i0, v0, k + 4); cvt_store<!EXPERTS>(i1, v1, scr, F.lane);
        CV_LD(i1, v1, k + 5); cvt_store<!EXPERTS>(i2, v2, scr, F.lane);
        CV_LD(i2, v2, k + 6); cvt_store<!EXPERTS>(i3, v3, scr, F.lane);
    }
    if (k < cnt) cvt_store<!EXPERTS>(i0, v0, scr, F.lane);
    if (k + 1 < cnt) cvt_store<!EXPERTS>(i1, v1, scr, F.lane);
    if (k + 2 < cnt) cvt_store<!EXPERTS>(i2, v2, scr, F.lane);
#undef CV_LD
}

__device__ __forceinline__ void p0_prologue(const Frame& F) {
    const float* c_in = F.in[1]; const float* w_ada = F.in[5];
    LAS float* scr = (LAS float*)(F.lds + F.wave * 16384);
    const int gw = F.bid * NWAVES + F.wave, NGW = F.G * NWAVES;
    for (int task = gw; task < 192 * 8; task += NGW) {
        const int kc = task & 7, cc = task >> 3, kbase = kc * 256;
#pragma unroll
        for (int b = 0; b < 4; ++b)
#pragma unroll
            for (int j = 0; j < 4; ++j) { const int k = F.lane + 64 * j; scr[b * 256 + k] = silu_f(c_in[b * D + kbase + k]); }
        LDS_WAIT(); asm volatile("" ::: "memory");
        float a0 = 0.f, a1 = 0.f, a2 = 0.f, a3 = 0.f;
        const float* wp = w_ada + (size_t)kbase * (6 * D) + cc * 64 + F.lane;
#pragma unroll 16
        for (int k = 0; k < 256; ++k) { const float w = wp[(size_t)k * (6 * D)];
            a0 += scr[k] * w; a1 += scr[256 + k] * w; a2 += scr[512 + k] * w; a3 += scr[768 + k] * w; }
        float* mp = (float*)(F.ws + WS_MODP) + (size_t)kc * (4 * 6 * D) + cc * 64 + F.lane;
        mp[0] = a0; mp[6 * D] = a1; mp[2 * 6 * D] = a2; mp[3 * 6 * D] = a3;
        LDS_WAIT(); asm volatile("" ::: "memory");
    }
    cvt_run<false>(F, NITEMS_SMALL, 0, F.G);
#ifndef CVT_OVERLAP
    cvt_run<true>(F, NITEMS_EXP, 0, F.G);
#endif
#ifdef CVT_P0_ON
    if (F.bid < CVT_P0_ON) cvt_run<true>(F, NITEMS_EXP, 0, CVT_P0_ON);
#endif
    {
        const u32x4 z = {0u, 0u, 0u, 0u};
        const int gt = gw * 64 + F.lane, NGT = NGW * 64;
        u32x4* p1 = (u32x4*)((bf16_t*)(F.ws + WS_WINT) + (size_t)9824 * D); for (int i = gt; i < 160 * 256; i += NGT) p1[i] = z;
        u32x4* p2 = (u32x4*)((bf16_t*)(F.ws + WS_WRX) + (size_t)128 * D); for (int i = gt; i < 128 * 256; i += NGT) p2[i] = z;
        u32x4* p3 = (u32x4*)((bf16_t*)(F.ws + WS_WRY) + (size_t)64 * D); for (int i = gt; i < 192 * 256; i += NGT) p3[i] = z;
    }
}

__device__ __forceinline__ float mod_value(const Frame& F, int idx) {
    const float* mp = (const float*)(F.ws + WS_MODP) + idx; float s = 0.f;
#pragma unroll
    for (int p = 0; p < 8; ++p) s += mp[(size_t)p * (4 * 6 * D)];
    return s + F.in[6][idx % (6 * D)];
}

__device__ __forceinline__ void p1_norm1(const Frame& F) {
    LAS float* sh = (LAS float*)F.lds;
    LAS float* sc = sh + D;
    float* MOD = (float*)(F.ws + WS_MOD);
    for (int idx = F.bid * NTHREADS + F.tid; idx < 4 * 6 * D; idx += F.G * NTHREADS) MOD[idx] = mod_value(F, idx);
    for (int blk = F.bid; blk < NTOK / 64; blk += F.G) {
        const int b = blk / (SEQ / 64);
        __syncthreads();
        for (int i = F.tid; i < D; i += NTHREADS) { sh[i] = mod_value(F, b * 6 * D + i); sc[i] = (1.f + mod_value(F, b * 6 * D + D + i)) * F.in[3][i]; }
        __syncthreads();
        for (int j = 0; j < 8; ++j) {
            const int t = blk * 64 + F.wave * 8 + j;
            const f32x4* xr = (const f32x4*)(F.in[0] + (size_t)t * D) + F.lane;
            f32x4 v[8]; float s = 0.f;
#pragma unroll
            for (int q = 0; q < 8; ++q) { v[q] = xr[64 * q]; s += (v[q].x * v[q].x + v[q].y * v[q].y) + (v[q].z * v[q].z + v[q].w * v[q].w); }
            const float r = rsqrtf(wave_sum(s) * (1.f / D) + EPS);
            u32x2* o = (u32x2*)((bf16_t*)(F.ws + WS_HB) + (size_t)t * D) + F.lane;
#pragma unroll
            for (int q = 0; q < 8; ++q) { const int c0 = 4 * F.lane + 256 * q;
                const f32x4 a = *(const LAS f32x4*)(sc + c0), bb = *(const LAS f32x4*)(sh + c0);
                u32x2 w; w.x = pk2(v[q].x * r * a.x + bb.x, v[q].y * r * a.y + bb.y); w.y = pk2(v[q].z * r * a.z + bb.z, v[q].w * r * a.w + bb.w);
                o[64 * q] = w; }
        }
    }
}

__device__ __forceinline__ void p3_mix(const Frame& F) {
    const bf16_t* PROJ = (const bf16_t*)(F.ws + WS_PROJ);
    bf16_t* UMIX = (bf16_t*)(F.ws + WS_UMIX); bf16_t* KN = (bf16_t*)(F.ws + WS_KN); bf16_t* VT = (bf16_t*)(F.ws + WS_VT); bf16_t* KIN = (bf16_t*)(F.ws + WS_KIN);
    const float* conv_w = F.in[8];
    LAS bf16_t* tile = (LAS bf16_t*)F.lds;
    const int c0 = F.lane * 16;
    float w0[16], w1[16], w2[16];
#pragma unroll
    for (int i = 0; i < 16; ++i) { w0[i] = conv_w[c0 + i]; w1[i] = conv_w[CW + c0 + i]; w2[i] = conv_w[2 * CW + c0 + i]; }
    const float* knw = F.in[11]; float kw4[4];
#pragma unroll
    for (int i = 0; i < 4; ++i) kw4[i] = knw[(F.lane & 15) * 4 + i];
    const float iw = F.in[12][F.lane], ib = F.in[13][F.lane];
    for (int blk = F.bid; blk < NTOK / 64; blk += F.G) {
        const int tok0 = blk * 64, b = tok0 / SEQ, tt0 = tok0 % SEQ;
        __syncthreads();
#pragma unroll
        for (int it = 0; it < 4; ++it) { const int idx = it * NTHREADS + F.tid, tk = idx >> 5, ch = idx & 31;
            const u32x4 v = *(const u32x4*)(PROJ + (size_t)(tok0 + tk) * TOTP + O_V + ch * 8);
            const unsigned wv[4] = {v.x, v.y, v.z, v.w};
#pragma unroll
            for (int j = 0; j < 4; ++j) { tile[(ch * 8 + 2 * j) * 72 + tk] = (bf16_t)(wv[j] & 0xffffu); tile[(ch * 8 + 2 * j + 1) * 72 + tk] = (bf16_t)(wv[j] >> 16); } }
        __syncthreads();
#pragma unroll
        for (int it = 0; it < 4; ++it) { const int idx = it * NTHREADS + F.tid, col = idx >> 3, ch = idx & 7;
            const int g16 = ch >> 1, c1 = ch & 1;
            const u32x2 v0 = *(const LAS u32x2*)(tile + col * 72 + 16 * g16 + 4 * c1), v1 = *(const LAS u32x2*)(tile + col * 72 + 16 * g16 + 8 + 4 * c1);
            *(u32x4*)(VT + ((size_t)(b * 256 + col)) * SEQ + tt0 + ch * 8) = (u32x4){v0.x, v0.y, v1.x, v1.y}; }
        float vm1[16], vm2[16];
        {
            const int t = tok0 + F.wave * 8, tt = t % SEQ;
#pragma unroll
            for (int back = 1; back <= 2; ++back) {
                float* dst = back == 1 ? vm1 : vm2;
                if (tt >= back) {
                    const bf16_t* p = PROJ + (size_t)(t - back) * TOTP;
                    const u32x4 a0 = *(const u32x4*)(p + O_CC + c0), a1 = *(const u32x4*)(p + O_CC + c0 + 8), b0 = *(const u32x4*)(p + O_CU + c0), b1 = *(const u32x4*)(p + O_CU + c0 + 8);
                    const unsigned aw[8] = {a0.x, a0.y, a0.z, a0.w, a1.x, a1.y, a1.z, a1.w}, bw[8] = {b0.x, b0.y, b0.z, b0.w, b1.x, b1.y, b1.z, b1.w};
#pragma unroll
                    for (int i = 0; i < 8; ++i) { dst[2 * i] = bf_lo(aw[i]) * bf_lo(bw[i]); dst[2 * i + 1] = bf_hi(aw[i]) * bf_hi(bw[i]); }
                } else {
#pragma unroll
                    for (int i = 0; i < 16; ++i) dst[i] = 0.f;
                }
            }
        }
        for (int j = 0; j < 8; ++j) {
            const int t = tok0 + F.wave * 8 + j;
            const bf16_t* p = PROJ + (size_t)t * TOTP;
            const u32x4 a0 = *(const u32x4*)(p + O_CC + c0), a1 = *(const u32x4*)(p + O_CC + c0 + 8), b0 = *(const u32x4*)(p + O_CU + c0), b1 = *(const u32x4*)(p + O_CU + c0 + 8);
            const u32x4 g0 = *(const u32x4*)(p + O_CB + c0), g1 = *(const u32x4*)(p + O_CB + c0 + 8);
            const unsigned aw[8] = {a0.x, a0.y, a0.z, a0.w, a1.x, a1.y, a1.z, a1.w}, bw[8] = {b0.x, b0.y, b0.z, b0.w, b1.x, b1.y, b1.z, b1.w}, gw[8] = {g0.x, g0.y, g0.z, g0.w, g1.x, g1.y, g1.z, g1.w};
            float v0[16]; unsigned ow[8];
#pragma unroll
            for (int i = 0; i < 8; ++i) { v0[2 * i] = bf_lo(aw[i]) * bf_lo(bw[i]); v0[2 * i + 1] = bf_hi(aw[i]) * bf_hi(bw[i]); }
#pragma unroll
            for (int i = 0; i < 8; ++i) {
                const float y0 = w0[2 * i] * vm2[2 * i] + w1[2 * i] * vm1[2 * i] + w2[2 * i] * v0[2 * i];
                const float y1 = w0[2 * i + 1] * vm2[2 * i + 1] + w1[2 * i + 1] * vm1[2 * i + 1] + w2[2 * i + 1] * v0[2 * i + 1];
                ow[i] = pk2(bf_lo(gw[i]) * y0, bf_hi(gw[i]) * y1); }
            u32x4* o = (u32x4*)(UMIX + (size_t)t * CW + c0);
            o[0] = (u32x4){ow[0], ow[1], ow[2], ow[3]}; o[1] = (u32x4){ow[4], ow[5], ow[6], ow[7]};
#pragma unroll
            for (int i = 0; i < 16; ++i) { vm2[i] = vm1[i]; vm1[i] = v0[i]; }
            { const u32x2 kv = *(const u32x2*)(p + O_K + F.lane * 4);
              float k0 = bf_lo(kv.x), k1 = bf_hi(kv.x), k2 = bf_lo(kv.y), k3 = bf_hi(kv.y);
              float s = (k0 * k0 + k1 * k1) + (k2 * k2 + k3 * k3);
              s = row16_sum(s);
              const float r = rsqrtf(s * (1.f / 64.f) + EPS);
              u32x2 ov; ov.x = pk2(k0 * r * kw4[0], k1 * r * kw4[1]); ov.y = pk2(k2 * r * kw4[2], k3 * r * kw4[3]);
              *(u32x2*)(KN + (size_t)t * KVW + F.lane * 4) = ov; }
            { const float xv = bf2f(p[O_KI + F.lane]);
              const float mu = wave_sum(xv) * (1.f / 64.f), dx = xv - mu, var = wave_sum(dx * dx) * (1.f / 64.f);
              KIN[(size_t)t * IDIM + F.lane] = (bf16_t)f2bf(dx * rsqrtf(var + EPS) * iw + ib); }
        }
    }
}

__device__ __forceinline__ unsigned f2key(float f) { const unsigned u = __float_as_uint(f); return (u & 0x80000000u) ? ~u : (u | 0x80000000u); }
__device__ __forceinline__ unsigned fxkey(float v) { const int q = (int)__builtin_fmaf(v, 131072.f, 524289.f); return (unsigned)(q < 1 ? 1 : (q > 1048574 ? 1048574 : q)); }
__device__ __forceinline__ int crow32(int r, int hi) { return (r & 3) + 8 * (r >> 2) + 4 * hi; }

__device__ __forceinline__ void p4_index(const Frame& F) {
    const bf16_t* PROJ = (const bf16_t*)(F.ws + WS_PROJ); const bf16_t* KIN = (const bf16_t*)(F.ws + WS_KIN);
    unsigned* MASK = (unsigned*)(F.ws + WS_MASK);
    LAS unsigned* SCK = (LAS unsigned*)F.lds;
    LAS float* WQ = (LAS float*)(F.lds + LIST_OFF);
    LAS bf16_t* UQ = (LAS bf16_t*)(F.lds + LIST_OFF + 512);
    const int lane = F.lane, n32 = lane & 31, hi = lane >> 5, w = F.wave;
    constexpr int NUNITS = BATCH * (SEQ / 8);
    for (int r = 0;; ++r) {
        const int L = r * F.G + ((r & 1) ? (F.G - 1 - F.bid) : F.bid);
        if (L >= NUNITS) break;
        const int b = L & 3, qg = (SEQ / 8 - 1) - (L >> 2), t0 = qg * 8;
        const int nkt = (t0 + 7) / 32 + 1;
        bf16x8 Af[4][4];
        {
            const int qsel = (n32 >> 2) & 1, head = (n32 & 3) + 4 * (n32 >> 3);
#pragma unroll
            for (int rt = 0; rt < 4; ++rt) {
                const bf16_t* p = PROJ + (size_t)(b * SEQ + t0 + 2 * rt + qsel) * TOTP + O_QI + head * 64 + 8 * hi;
#pragma unroll
                for (int ks = 0; ks < 4; ++ks) Af[rt][ks] = *(const bf16x8*)(p + 16 * ks);
            }
        }
        bf16x8 B0[4], B1[4];
#define P4_LDB(dst, kt_) do { const bf16_t* kp_ = KIN + (size_t)(b * SEQ + (kt_) * 32 + n32) * IDIM + 8 * hi; _Pragma("unroll") for (int ks = 0; ks < 4; ++ks) dst[ks] = *(const bf16x8*)(kp_ + 16 * ks); } while (0)
        if (w < nkt) P4_LDB(B0, w);
        __syncthreads();
        if (F.tid < 128) WQ[F.tid] = bf2f(PROJ[(size_t)(b * SEQ + t0 + (F.tid >> 4)) * TOTP + O_WI + (F.tid & 15)]) * (0.25f * 0.125f);
        __syncthreads();
        { const int q = F.tid >> 6, d = F.tid & 63; const bf16_t* qp = PROJ + (size_t)(b * SEQ + t0 + q) * TOTP + O_QI + d; float uacc = 0.f;
#pragma unroll
          for (int h2 = 0; h2 < 16; ++h2) uacc += WQ[q * 16 + h2] * bf2f(qp[h2 * 64]);
          UQ[q * 64 + d] = (bf16_t)f2bf(uacc); }
        __syncthreads();
        bf16x8 A5[4];
        { const int qm = n32 < 4 ? 2 * n32 : 2 * (n32 - 4) + 1;
#pragma unroll
          for (int ks = 0; ks < 4; ++ks) { const bf16x8 v = *(const LAS bf16x8*)(UQ + (qm & 7) * 64 + 16 * ks + 8 * hi); A5[ks] = n32 < 8 ? v : (bf16x8){0, 0, 0, 0, 0, 0, 0, 0}; } }
#define P4_TILE(Bc, kt_) do { f32x16 lin = {}; _Pragma("unroll") for (int ks = 0; ks < 4; ++ks) lin = __builtin_amdgcn_mfma_f32_32x32x16_bf16(A5[ks], Bc[ks], lin, 0, 0, 0); \
        _Pragma("unroll") for (int rt = 0; rt < 4; ++rt) { \
            f32x16 acc = {}; _Pragma("unroll") for (int ks = 0; ks < 4; ++ks) acc = __builtin_amdgcn_mfma_f32_32x32x16_bf16(Af[rt][ks], Bc[ks], acc, 0, 0, 0); \
            const LAS f32x4* wv = (const LAS f32x4*)(WQ + (2 * rt + hi) * 16); float s_ = lin[rt]; \
            _Pragma("unroll") for (int i4 = 0; i4 < 4; ++i4) { const f32x4 ww = wv[i4]; \
                s_ += ww.x * __builtin_fabsf(acc[4 * i4]) + ww.y * __builtin_fabsf(acc[4 * i4 + 1]) + ww.z * __builtin_fabsf(acc[4 * i4 + 2]) + ww.w * __builtin_fabsf(acc[4 * i4 + 3]); } \
            SCK[(2 * rt + hi) * SEQ + (kt_) * 32 + n32] = fxkey(0.5f * s_); } } while (0)
#ifndef P4_REP_SC
#define P4_REP_SC 1
#endif
#ifndef P4_REP_SEL
#define P4_REP_SEL 1
#endif
#pragma unroll 1
        for (int rep_ = 0; rep_ < P4_REP_SC; ++rep_) { if (rep_ && w < nkt) P4_LDB(B0, w);
        for (int kt = w; kt < nkt; kt += 16) {
            if (kt + 8 < nkt) P4_LDB(B1, kt + 8);
            P4_TILE(B0, kt);
            if (kt + 8 < nkt) {
                if (kt + 16 < nkt) P4_LDB(B0, kt + 16);
                P4_TILE(B1, kt + 8);
            }
        }
        }
#undef P4_LDB
#undef P4_TILE
        __syncthreads();
#ifndef P4_REP_SEL
#define P4_REP_SEL 1
#endif
#pragma unroll 1
        for (int rep2_ = 0; rep2_ < P4_REP_SEL; ++rep2_) {
            const int t = t0 + w, jmax = t >> 6;
            unsigned key[64];
#pragma unroll
            for (int g8 = 0; g8 < 8; ++g8) {
                if (g8 * 8 <= jmax) {
#pragma unroll
                    for (int jj = 0; jj < 8; ++jj) { const int j = g8 * 8 + jj, s = j * 64 + lane; const unsigned v = SCK[w * SEQ + s]; key[j] = (s <= t) ? v : 0u; }
                } else {
#pragma unroll
                    for (int jj = 0; jj < 8; ++jj) key[g8 * 8 + jj] = 0u;
                }
            }
#define P4_CNT8(g8_, op_, cand_, c_) do { unsigned long long m0_, m1_, m2_, m3_, m4_, m5_, m6_, m7_; \
                asm volatile("v_cmp_" op_ "_u32_e64 %0, %8, %16\n\tv_cmp_" op_ "_u32_e64 %1, %9, %16\n\tv_cmp_" op_ "_u32_e64 %2, %10, %16\n\tv_cmp_" op_ "_u32_e64 %3, %11, %16\n\t" \
                             "v_cmp_" op_ "_u32_e64 %4, %12, %16\n\tv_cmp_" op_ "_u32_e64 %5, %13, %16\n\tv_cmp_" op_ "_u32_e64 %6, %14, %16\n\tv_cmp_" op_ "_u32_e64 %7, %15, %16" \
                    : "=&s"(m0_), "=&s"(m1_), "=&s"(m2_), "=&s"(m3_), "=&s"(m4_), "=&s"(m5_), "=&s"(m6_), "=&s"(m7_) \
                    : "v"(key[(g8_) * 8 + 0]), "v"(key[(g8_) * 8 + 1]), "v"(key[(g8_) * 8 + 2]), "v"(key[(g8_) * 8 + 3]), "v"(key[(g8_) * 8 + 4]), "v"(key[(g8_) * 8 + 5]), "v"(key[(g8_) * 8 + 6]), "v"(key[(g8_) * 8 + 7]), "s"(cand_)); \
                c_ += (__popcll(m0_) + __popcll(m1_)) + (__popcll(m2_) + __popcll(m3_)) + (__popcll(m4_) + __popcll(m5_)) + (__popcll(m6_) + __popcll(m7_)); } while (0)
            unsigned TH = 0u; bool exact = false; int rem = 0;
            if (t + 1 <= NSEL) { TH = 1u; exact = true; }
            else {
#pragma unroll 1
                for (int bit = 19; bit >= 0; --bit) {
                    const unsigned cand = (unsigned)__builtin_amdgcn_readfirstlane((int)(TH | (1u << bit)));
                    int c = 0;
#pragma unroll
                    for (int g8 = 0; g8 < 8; ++g8) { if (g8 * 8 <= jmax) P4_CNT8(g8, "ge", cand, c); }
                    if (c >= NSEL) TH = cand;
                    if (c == NSEL) { exact = true; break; }
                }
                if (!exact) { int cgt = 0; const unsigned ths = (unsigned)__builtin_amdgcn_readfirstlane((int)TH);
#pragma unroll
                    for (int g8 = 0; g8 < 8; ++g8) { if (g8 * 8 <= jmax) P4_CNT8(g8, "gt", ths, cgt); }
                    rem = NSEL - cgt; }
            }
            unsigned char* mrow = (unsigned char*)(F.ws + WS_MASKB) + ((size_t)(b * SEQ + t)) * SEQ + (((lane >> 2) & 1) * 32 + (lane >> 3) * 4 + (lane & 3));
#pragma unroll
            for (int g8 = 0; g8 < 8; ++g8) {
                if (g8 * 8 <= jmax) {
#pragma unroll
                    for (int jj = 0; jj < 8; ++jj) { const int j = g8 * 8 + jj;
                        unsigned long long m;
                        if (exact) m = __ballot(key[j] >= TH);
                        else {
                            m = __ballot(key[j] > TH);
                            unsigned long long e = __ballot(key[j] == TH);
                            while (rem > 0 && e) { const unsigned long long bitv = e & (~e + 1ull); m |= bitv; e ^= bitv; --rem; }
                        }
                        unsigned bytev; asm volatile("s_nop 1\n\tv_cndmask_b32_e64 %0, 0, %1, %2" : "=v"(bytev) : "v"(0xFFu), "s"(m));
                        asm volatile("global_store_byte %0, %1, off offset:%2" :: "v"(mrow), "v"(bytev), "n"(j * 64) : "memory"); }
                }
            }
        }
#undef P4_CNT8
    }
}

constexpr int P5_KBUF = 0, P5_VBUF = 49152, P5_STG = 98304, P5_BIAS = 135168, P5_BTW = 324, P5_END = P5_BIAS + 16 * P5_BTW * 4;
static_assert(P5_END <= MISC_OFF, "P5 LDS map");
__device__ __forceinline__ int t5_bucket(int n) {
    if (n < 16) return n;
    const int large = 16 + (int)(__logf((float)n * (1.f / 16.f)) * (16.f / 2.0794415416798357f));
    return large < 31 ? large : 31;
}
__device__ __forceinline__ void p5_attn(const Frame& F) {
    const bf16_t* PROJ = (const bf16_t*)(F.ws + WS_PROJ); const bf16_t* KN = (const bf16_t*)(F.ws + WS_KN); const bf16_t* VT = (const bf16_t*)(F.ws + WS_VT);
    const unsigned* MASK = (const unsigned*)(F.ws + WS_MASK); bf16_t* AO = (bf16_t*)(F.ws + WS_AO);
    const float* rel_bias = F.in[2]; const float* qnw = F.in[10];
    const int lane = F.lane, q32 = lane & 31, hi = lane >> 5, w = F.wave, tid = F.tid;
    constexpr float LOG2E = 1.4426950408889634f;
    LAS float* BT = (LAS float*)(F.lds + P5_BIAS);
    __syncthreads();
    for (int i = tid; i < 16 * P5_BTW; i += NTHREADS) { const int h = i / P5_BTW, d = i % P5_BTW - 64;
        BT[i] = (d >= 0 && d < 128) ? (rel_bias[t5_bucket(d) * NH + h] - rel_bias[31 * NH + h]) * LOG2E : 0.f; }
    __syncthreads();
    constexpr int NUNITS = BATCH * NKV * (SEQ / 64);
    if (w >= 4) __builtin_amdgcn_s_setprio(1);
    const int kkey = tid >> 3, kch = tid & 7;
    const int ldsK = kkey * 128 + ((kch ^ ((kkey >> 1) & 7)) * 16);
    const bf16x8 ones = {0x3f80, 0x3f80, 0x3f80, 0x3f80, 0x3f80, 0x3f80, 0x3f80, 0x3f80};
#define P5_QK(p0_, p1_, kslot_) do { const LAS unsigned char* kb_ = F.lds + P5_KBUF + (kslot_) * 8192; p0_ = (f32x16){}; p1_ = (f32x16){}; \
        _Pragma("unroll") for (int ks = 0; ks < 4; ++ks) { const int ch = 2 * ks + hi; \
            const bf16x8 a0 = *(const LAS bf16x8*)(kb_ + q32 * 128 + ((ch ^ ((q32 >> 1) & 7)) * 16)); \
            const bf16x8 a1 = *(const LAS bf16x8*)(kb_ + (q32 + 32) * 128 + ((ch ^ (((q32 + 32) >> 1) & 7)) * 16)); \
            p0_ = __builtin_amdgcn_mfma_f32_32x32x16_bf16(a0, Qf[ks], p0_, 0, 0, 0); p1_ = __builtin_amdgcn_mfma_f32_32x32x16_bf16(a1, Qf[ks], p1_, 0, 0, 0); } } while (0)
#define P5_LDK(Kf_, kslot_) P5_LDKR(Kf_, kslot_, 0, 4)
#define P5_LDKR(Kf_, kslot_, k0_, k1_) do { const LAS unsigned char* kb_ = F.lds + P5_KBUF + (kslot_) * 8192; \
        _Pragma("unroll") for (int ks = (k0_); ks < (k1_); ++ks) { const int ch = 2 * ks + hi; \
            Kf_[2 * ks] = *(const LAS bf16x8*)(kb_ + q32 * 128 + ((ch ^ ((q32 >> 1) & 7)) * 16)); \
            Kf_[2 * ks + 1] = *(const LAS bf16x8*)(kb_ + (q32 + 32) * 128 + ((ch ^ (((q32 + 32) >> 1) & 7)) * 16)); } } while (0)
#define P5_QKF(p0_, p1_, Kf_) do { p0_ = (f32x16){}; p1_ = (f32x16){}; \
        _Pragma("unroll") for (int ks = 0; ks < 4; ++ks) { p0_ = __builtin_amdgcn_mfma_f32_32x32x16_bf16(Kf_[2 * ks], Qf[ks], p0_, 0, 0, 0); p1_ = __builtin_amdgcn_mfma_f32_32x32x16_bf16(Kf_[2 * ks + 1], Qf[ks], p1_, 0, 0, 0); } } while (0)
#define P5_LDVR(Vf_, vslot_, s0_, s1_) do { const LAS unsigned char* vb_ = F.lds + P5_VBUF + (vslot_) * 8192; \
        _Pragma("unroll") for (int s = (s0_); s < (s1_); ++s) _Pragma("unroll") for (int blk = 0; blk < 2; ++blk) { const int dim = q32 + 32 * blk, swz = (dim >> 1) & 7; \
            Vf_[2 * s + blk] = *(const LAS bf16x8*)(vb_ + dim * 128 + (((2 * s + hi) ^ swz) * 16)); } } while (0)
    for (int r = 0;; ++r) {
        const int L = r * F.G + ((r & 1) ? (F.G - 1 - F.bid) : F.bid);
        if (L >= NUNITS) break;
        const int bg = L & 15, b = bg >> 2, g = bg & 3, qt = (SEQ / 64 - 1) - (L >> 4), t0 = qt * 64;
        const int h = 4 * g + (w >> 1), tq = t0 + 32 * (w & 1) + q32;
        const int nkt = qt + 1;
        bf16x8 Qf[4];
        {
            const bf16_t* qp = PROJ + (size_t)(b * SEQ + tq) * TOTP + O_Q + h * 64 + 8 * hi;
            u32x4 raw[4]; float ss = 0.f;
#pragma unroll
            for (int ks = 0; ks < 4; ++ks) { raw[ks] = *(const u32x4*)(qp + 16 * ks); const unsigned xw[4] = {raw[ks].x, raw[ks].y, raw[ks].z, raw[ks].w};
#pragma unroll
                for (int i = 0; i < 4; ++i) { const float a = bf_lo(xw[i]), c = bf_hi(xw[i]); ss += a * a + c * c; } }
            ss += __shfl_xor(ss, 32);
            const float rs = rsqrtf(ss * (1.f / 64.f) + EPS) * (0.125f * LOG2E);
#pragma unroll
            for (int ks = 0; ks < 4; ++ks) { const unsigned xw[4] = {raw[ks].x, raw[ks].y, raw[ks].z, raw[ks].w}; const float* wn = qnw + 16 * ks + 8 * hi; u32x4 o;
                unsigned ow[4];
#pragma unroll
                for (int i = 0; i < 4; ++i) ow[i] = pk2(bf_lo(xw[i]) * rs * wn[2 * i], bf_hi(xw[i]) * rs * wn[2 * i + 1]);
                o = (u32x4){ow[0], ow[1], ow[2], ow[3]}; Qf[ks] = __builtin_bit_cast(bf16x8, o); }
        }
        const bf16_t* kg = KN + (size_t)(b * SEQ) * KVW + g * 64 + kkey * KVW + kch * 8;
        const bf16_t* vg = VT + ((size_t)((b * 4 + g) * 64 + kkey)) * SEQ + kch * 8;
        const unsigned char* mg = (const unsigned char*)(F.ws + WS_MASKB) + ((size_t)(b * SEQ + tq)) * SEQ + hi * 32;
        f32x16 O0 = {}, O1 = {}, Ls = {};
        __syncthreads();
        { const int t1 = nkt > 1 ? 1 : 0, t2 = nkt > 2 ? 2 : nkt - 1;
          const u32x4 kv0 = *(const u32x4*)kg, vv0 = *(const u32x4*)vg;
          const u32x4 kv1 = *(const u32x4*)(kg + (size_t)t1 * 64 * KVW), vv1 = *(const u32x4*)(vg + t1 * 64);
          const u32x4 kv2 = *(const u32x4*)(kg + (size_t)t2 * 64 * KVW), vv2 = *(const u32x4*)(vg + t2 * 64);
          *(LAS u32x4*)(F.lds + P5_KBUF + ldsK) = kv0; *(LAS u32x4*)(F.lds + P5_VBUF + ldsK) = vv0;
          *(LAS u32x4*)(F.lds + P5_KBUF + 8192 + ldsK) = kv1; *(LAS u32x4*)(F.lds + P5_VBUF + 8192 + ldsK) = vv1;
          *(LAS u32x4*)(F.lds + P5_KBUF + 16384 + ldsK) = kv2; *(LAS u32x4*)(F.lds + P5_VBUF + 16384 + ldsK) = vv2; }
        u32x4 mc0 = *(const u32x4*)mg, mc1 = *(const u32x4*)(mg + 16);
        __syncthreads();
        f32x16 pa0, pa1, pb0, pb1; bf16x8 Kf[8], Vf[8]; P5_LDK(Kf, 0); P5_QKF(pa0, pa1, Kf);
        int s0 = 0;
#define P5_SLOT(j_) ((s0 + (j_)) >= 6 ? (s0 + (j_)) - 6 : (s0 + (j_)))
#define P5_SDW(za_, zb_, xa_, xb_, mw_, SA_, SB_) asm("v_exp_f32 %0, %2\n\tv_exp_f32 %1, %3\n\tv_and_b32_sdwa %0, %0, sext(%4) dst_sel:DWORD dst_unused:UNUSED_PAD src0_sel:DWORD src1_sel:" SA_ "\n\t" \
            "v_and_b32_sdwa %1, %1, sext(%4) dst_sel:DWORD dst_unused:UNUSED_PAD src0_sel:DWORD src1_sel:" SB_ : "=&v"(za_), "=&v"(zb_) : "v"(xa_), "v"(xb_), "v"(mw_))
#define P5_X(PP, MM, s_, h_) do { _Pragma("unroll") for (int i_ = 0; i_ < 4; i_ += 2) { \
            const int ra_ = 8 * ((s_) & 1) + 4 * (h_) + i_, rb_ = ra_ + 1; \
              \
            float za_, zb_; { const unsigned mw_ = MM[ra_ >> 2]; \
            if ((ra_ & 3) == 0) P5_SDW(za_, zb_, PP[ra_], PP[rb_], mw_, "BYTE_0", "BYTE_1"); else P5_SDW(za_, zb_, PP[ra_], PP[rb_], mw_, "BYTE_2", "BYTE_3"); } \
            pw[s_][2 * (h_) + (i_ >> 1)] = cvt_pk_bf16(za_, zb_); } } while (0)
#define P5_SB __builtin_amdgcn_sched_barrier(0)
#define P5_Q(N0, N1, j_) do { if ((j_) == 0) N0 = __builtin_amdgcn_mfma_f32_32x32x16_bf16(Kf[0], Qf[0], (f32x16){}, 0, 0, 0); \
            else if ((j_) == 1) N1 = __builtin_amdgcn_mfma_f32_32x32x16_bf16(Kf[1], Qf[0], (f32x16){}, 0, 0, 0); \
            else if ((j_) & 1) N1 = __builtin_amdgcn_mfma_f32_32x32x16_bf16(Kf[j_], Qf[(j_) >> 1], N1, 0, 0, 0); \
            else N0 = __builtin_amdgcn_mfma_f32_32x32x16_bf16(Kf[j_], Qf[(j_) >> 1], N0, 0, 0, 0); } while (0)
#define P5_PB(s_) __builtin_bit_cast(bf16x8, ((u32x4){pw[s_][0], pw[s_][1], pw[s_][2], pw[s_][3]}))
#define P5_PVL(s_) Ls = __builtin_amdgcn_mfma_f32_32x32x16_bf16(ones, P5_PB(s_), Ls, 0, 0, 0)
#define P5_PV0(s_) O0 = __builtin_amdgcn_mfma_f32_32x32x16_bf16(Vf[2 * (s_)], P5_PB(s_), O0, 0, 0, 0)
#define P5_PV1(s_) O1 = __builtin_amdgcn_mfma_f32_32x32x16_bf16(Vf[2 * (s_) + 1], P5_PB(s_), O1, 0, 0, 0)
#define P5_STEP(C0, C1, N0, N1, kt_, sc_, sn_) do { \
            const int t1 = (kt_) + 1 < nkt ? (kt_) + 1 : (kt_); \
            const u32x4 mn0 = *(const u32x4*)(mg + t1 * 64), mn1 = *(const u32x4*)(mg + t1 * 64 + 16); \
            P5_LDKR(Kf, sn_, 0, 2); P5_LDVR(Vf, sc_, 0, 2); \
            const u32x4 m0 = mc0, m1 = mc1; \
            if ((kt_) + 3 > qt) { \
                const LAS float* bt = BT + (w >> 1 | (g << 2)) * P5_BTW + (tq - (kt_) * 64 - 4 * hi + 64);     \
                _Pragma("unroll") for (int r2 = 0; r2 < 16; ++r2) { const int kk = (r2 & 3) + 8 * (r2 >> 2); C0[r2] += bt[-kk]; C1[r2] += bt[-kk - 32]; } \
            } \
            unsigned pw[4][4]; \
            P5_SB; P5_Q(N0, N1, 0); P5_SB; P5_X(C0, m0, 0, 0); P5_SB; P5_Q(N0, N1, 1); P5_SB; P5_Q(N0, N1, 2); P5_SB; P5_X(C0, m0, 0, 1); P5_SB; P5_Q(N0, N1, 3); P5_LDKR(Kf, sn_, 2, 4); P5_SB; \
            P5_PVL(0); P5_SB; P5_X(C0, m0, 1, 0); P5_SB; P5_PV0(0); P5_SB; P5_PV1(0); P5_LDVR(Vf, sc_, 2, 3); P5_SB; P5_X(C0, m0, 1, 1); P5_SB; P5_Q(N0, N1, 4); P5_SB; \
            P5_PVL(1); P5_SB; P5_X(C1, m1, 2, 0); P5_SB; P5_PV0(1); P5_SB; P5_PV1(1); P5_LDVR(Vf, sc_, 3, 4); P5_SB; P5_X(C1, m1, 2, 1); P5_SB; P5_Q(N0, N1, 5); P5_SB; \
            P5_PVL(2); P5_SB; P5_X(C1, m1, 3, 0); P5_SB; P5_PV0(2); P5_SB; P5_PV1(2); P5_SB; P5_X(C1, m1, 3, 1); P5_SB; P5_Q(N0, N1, 6); P5_SB; P5_Q(N0, N1, 7); P5_SB; \
            P5_PVL(3); P5_PV0(3); P5_PV1(3); P5_SB; \
            mc0 = mn0; mc1 = mn1; } while (0)
        int kt = 0;
        for (; kt + 2 <= nkt; kt += 2) {
            const int t3 = kt + 3 < nkt ? kt + 3 : nkt - 1, t4 = kt + 4 < nkt ? kt + 4 : nkt - 1;
            const u32x4 k3 = *(const u32x4*)(kg + (size_t)t3 * 64 * KVW), v3 = *(const u32x4*)(vg + t3 * 64);
            const u32x4 k4 = *(const u32x4*)(kg + (size_t)t4 * 64 * KVW), v4 = *(const u32x4*)(vg + t4 * 64);
            const int sA = P5_SLOT(0), sB = P5_SLOT(1), sC = P5_SLOT(2), sD = P5_SLOT(3), sE = P5_SLOT(4);
            P5_STEP(pa0, pa1, pb0, pb1, kt, sA, sB);
            P5_STEP(pb0, pb1, pa0, pa1, kt + 1, sB, sC);
            if (kt + 3 < nkt) { *(LAS u32x4*)(F.lds + P5_KBUF + sD * 8192 + ldsK) = k3; *(LAS u32x4*)(F.lds + P5_VBUF + sD * 8192 + ldsK) = v3; }
            if (kt + 4 < nkt) { *(LAS u32x4*)(F.lds + P5_KBUF + sE * 8192 + ldsK) = k4; *(LAS u32x4*)(F.lds + P5_VBUF + sE * 8192 + ldsK) = v4; }
            s0 = sC;
            __syncthreads();
        }
        if (kt < nkt) { const int sA = P5_SLOT(0), sB = P5_SLOT(1); P5_STEP(pa0, pa1, pb0, pb1, kt, sA, sB); __syncthreads(); }
#undef P5_STEP
#undef P5_SLOT
        const float inv = 1.f / Ls[0];
        LAS bf16_t* stg = (LAS bf16_t*)(F.lds + P5_STG) + w * (32 * 72);
#pragma unroll
        for (int r2 = 0; r2 < 16; ++r2) { const int dim = crow32(r2, hi);
            stg[q32 * 72 + dim] = (bf16_t)f2bf(O0[r2] * inv); stg[q32 * 72 + dim + 32] = (bf16_t)f2bf(O1[r2] * inv); }
        LDS_WAIT(); asm volatile("" ::: "memory");
#pragma unroll
        for (int i = 0; i < 4; ++i) { const int row = i * 8 + (lane >> 3), ch = lane & 7;
            const u32x4 v = *(const LAS u32x4*)(stg + row * 72 + ch * 8);
            *(u32x4*)(AO + (size_t)(b * SEQ + t0 + 32 * (w & 1) + row) * AW + h * 64 + ch * 8) = v; }
    }
#undef P5_QK
    __builtin_amdgcn_s_setprio(0);
}
namespace pg8 {
template <bool ADD> struct EpiGate {
    static constexpr int PERM = 3; static constexpr bool IDEMP = !ADD;
    const bf16_t* G; int ldg; bf16_t* O;
    __device__ __forceinline__ void operator()(const f32x4 (&acc)[2][2][4][2], const Unit& u, int wr, int wc, int fr, int fq) const {
        const int row0 = u.row0 + wr * 64 + fr; const int col0 = u.pn * BM + wc * 64 + 8 * fq;
#pragma unroll
        for (int ai = 0; ai < 2; ++ai)
#pragma unroll
            for (int m = 0; m < 4; ++m) { const size_t row = (size_t)(row0 + ai * HALF + m * 16);
#pragma unroll
                for (int bj = 0; bj < 2; ++bj) { const f32x4 v0 = acc[ai][bj][m][0], v1 = acc[ai][bj][m][1];
                    const u32x4 g = *(const u32x4*)(G + row * ldg + col0 + bj * 32);
                    float r[8] = {v0[0] * sigmoid_f(bf_lo(g.x)), v0[1] * sigmoid_f(bf_hi(g.x)), v0[2] * sigmoid_f(bf_lo(g.y)), v0[3] * sigmoid_f(bf_hi(g.y)),
                                  v1[0] * sigmoid_f(bf_lo(g.z)), v1[1] * sigmoid_f(bf_hi(g.z)), v1[2] * sigmoid_f(bf_lo(g.w)), v1[3] * sigmoid_f(bf_hi(g.w))};
                    bf16_t* op = O + row * D + col0 + bj * 32;
                    if (ADD) { const u32x4 o = *(const u32x4*)op;
                        r[0] += bf_lo(o.x); r[1] += bf_hi(o.x); r[2] += bf_lo(o.y); r[3] += bf_hi(o.y); r[4] += bf_lo(o.z); r[5] += bf_hi(o.z); r[6] += bf_lo(o.w); r[7] += bf_hi(o.w); }
                    u32x4 w; w.x = cvt_pk_bf16(r[0], r[1]); w.y = cvt_pk_bf16(r[2], r[3]); w.z = cvt_pk_bf16(r[4], r[5]); w.w = cvt_pk_bf16(r[6], r[7]);
                    *(u32x4*)op = w; } }
    }
};
struct EpiX1 {
    static constexpr int PERM = 0; static constexpr bool IDEMP = true;
    const float* X; const float* gate; float* O;
    __device__ __forceinline__ void operator()(const f32x4 (&acc)[2][2][4][2], const Unit& u, int wr, int wc, int fr, int fq) const {
        const int row0 = u.row0 + wr * 64 + fr; const int col0 = u.pn * BM + wc * 32 + 4 * fq; const float* gp = gate + (size_t)(u.row0 / SEQ) * 6 * D;
#pragma unroll
        for (int bj = 0; bj < 2; ++bj)
#pragma unroll
            for (int n = 0; n < 2; ++n) { const int c = col0 + bj * HALF + n * 16; const f32x4 gv = *(const f32x4*)(gp + c);
#pragma unroll
                for (int ai = 0; ai < 2; ++ai)
#pragma unroll
                    for (int m = 0; m < 4; ++m) { const size_t off = (size_t)(row0 + ai * HALF + m * 16) * D + c;
                        const f32x4 xv = *(const f32x4*)(X + off); const f32x4 ov = xv + gv * acc[ai][bj][m][n]; EPI_ST16(O + off, __builtin_bit_cast(u32x4, ov)); } }
    }
};
struct EpiY1 {
    static constexpr int PERM = 3; static constexpr bool IDEMP = true;
    const float* gate; bf16_t* O;
    __device__ __forceinline__ void operator()(const f32x4 (&acc)[2][2][4][2], const Unit& u, int wr, int wc, int fr, int fq) const {
        const int row0 = u.row0 + wr * 64 + fr; const int col0 = u.pn * BM + wc * 64 + 8 * fq; const float* gp = gate + (size_t)(u.row0 / SEQ) * 6 * D + col0;
#pragma unroll
        for (int bj = 0; bj < 2; ++bj) { const f32x4 g0 = *(const f32x4*)(gp + bj * 32), g1 = *(const f32x4*)(gp + bj * 32 + 4);
#pragma unroll
            for (int ai = 0; ai < 2; ++ai)
#pragma unroll
                for (int m = 0; m < 4; ++m) { bf16_t* rowp = O + (size_t)(row0 + ai * HALF + m * 16) * D + col0;
                    const f32x4 v0 = g0 * acc[ai][bj][m][0], v1 = g1 * acc[ai][bj][m][1];
                    u32x4 w; w.x = cvt_pk_bf16(v0[0], v0[1]); w.y = cvt_pk_bf16(v0[2], v0[3]); w.z = cvt_pk_bf16(v1[0], v1[1]); w.w = cvt_pk_bf16(v1[2], v1[3]);
                    EPI_ST16(rowp + bj * 32, w); } }
    }
};
struct EpiRouter {
    static constexpr int PERM = 0; static constexpr bool IDEMP = true;
    float* O;
    __device__ __forceinline__ void operator()(const f32x4 (&acc)[2][2][4][2], const Unit& u, int wr, int wc, int fr, int fq) const {
        const int row0 = u.row0 + wr * 64 + fr; const int ncols = (u.e & 1) ? 64 : 128, coff = ((u.e & 1) ? 128 : 0) + (u.e >> 1) * 192;
#pragma unroll
        for (int n = 0; n < 2; ++n) { const int c = wc * 32 + n * 16 + 4 * fq;
            if (c < ncols) {
#pragma unroll
                for (int ai = 0; ai < 2; ++ai)
#pragma unroll
                    for (int m = 0; m < 4; ++m) *(f32x4*)(O + (size_t)(row0 + ai * HALF + m * 16) * 384 + coff + c) = acc[ai][0][m][n]; } }
    }
};
struct EpiSwiglu {
    static constexpr int PERM = 1; static constexpr bool IDEMP = true;
    bf16_t* O;
    __device__ __forceinline__ void operator()(const f32x4 (&acc)[2][2][4][2], const Unit& u, int wr, int wc, int fr, int fq) const {
        const int row0 = u.row0 + wr * 64 + fr; const int col0 = u.pn * HALF + wc * 32 + 8 * fq;
#pragma unroll
        for (int ai = 0; ai < 2; ++ai)
#pragma unroll
            for (int m = 0; m < 4; ++m) { const f32x4 a0 = acc[ai][0][m][0], a1 = acc[ai][0][m][1], b0 = acc[ai][1][m][0], b1 = acc[ai][1][m][1];
                u32x4 w; w.x = cvt_pk_bf16(silu_f(a0[0]) * b0[0], silu_f(a0[1]) * b0[1]); w.y = cvt_pk_bf16(silu_f(a0[2]) * b0[2], silu_f(a0[3]) * b0[3]);
                w.z = cvt_pk_bf16(silu_f(a1[0]) * b1[0], silu_f(a1[1]) * b1[1]); w.w = cvt_pk_bf16(silu_f(a1[2]) * b1[2], silu_f(a1[3]) * b1[3]);
                EPI_ST16(O + (size_t)(row0 + ai * HALF + m * 16) * DE + col0, w); }
    }
};
constexpr float YB_SCALE = 1.f;
struct EpiFp8 {
    static constexpr int PERM = 2; static constexpr bool IDEMP = true;
    unsigned char* O; int nostore;
    __device__ __forceinline__ void operator()(const f32x4 (&acc)[2][2][4][2], const Unit& u, int wr, int wc, int fr, int fq) const {
        if (nostore == 2) { asm volatile("" :: "v"(acc[0][0][0][0]), "v"(acc[1][1][3][1])); return; }
        const int row0 = u.row0 + wr * 64 + fr; const int col0 = u.pn * BM + wc * 64 + 16 * fq;
#pragma unroll
        for (int ai = 0; ai < 2; ++ai)
#pragma unroll
            for (int m = 0; m < 4; ++m) { unsigned char* rowp = O + (size_t)(row0 + ai * HALF + m * 16) * D + col0; unsigned wv[4];
#pragma unroll
                for (int bj = 0; bj < 2; ++bj) { const f32x4 v0 = acc[ai][bj][m][0], v1 = acc[ai][bj][m][1];
                    int w0 = __builtin_amdgcn_cvt_pk_fp8_f32(v0[0], v0[1], 0, false); w0 = __builtin_amdgcn_cvt_pk_fp8_f32(v0[2], v0[3], w0, true);
                    int w1 = __builtin_amdgcn_cvt_pk_fp8_f32(v1[0], v1[1], 0, false); w1 = __builtin_amdgcn_cvt_pk_fp8_f32(v1[2], v1[3], w1, true);
                    wv[2 * bj] = (unsigned)w0; wv[2 * bj + 1] = (unsigned)w1; }
                if (!nostore) *(u32x4*)rowp = (u32x4){wv[0], wv[1], wv[2], wv[3]};     else asm volatile("" :: "v"(wv[0]), "v"(wv[1]), "v"(wv[2]), "v"(wv[3])); }
    }
};
struct RouterOrder {
    const char* Ahi; const char* Alo; const char* Bx; const char* By; int G, c; int krep = 1;
    __device__ __forceinline__ bool next(int i, Unit& u) const {
        const int L = i * G + c; if (L >= 256) return false;
        const int which = (L >> 6) & 1, kh = L >> 7;
        u.e = which | (kh << 1); u.pm = L & 63; u.pn = 0; u.row0 = u.pm * BM;
        u.A = (which ? Alo : Ahi) + (size_t)u.pm * BM * D * 2 + (size_t)kh * (D / 2) * 2; u.B = (which ? By : Bx) + (size_t)kh * (D / 2) * 2; return true;
    }
    __device__ __forceinline__ const LAS int* list(int) const { return nullptr; }
    __device__ __forceinline__ void a_ready(const Unit&) const {}
    __device__ __forceinline__ void done(const Unit&) const {}
};
struct MoeOrder {
    const char* A; const char* W; const LAS int* tstart; const LAS int* lists; int G, c, npn_shift, a_tile_bytes; size_t w_exp_bytes, w_tile_bytes;
    const LAS int* uexp;
    int krep = 1;
    int L0 = 0, Llim = 0x7fffffff;
    unsigned* done_cnt = nullptr;
    unsigned* ready_cnt = nullptr;
    __device__ __forceinline__ int find_expert(int tile) const {
        int e = 0;
#pragma unroll 1
        for (int step = 32; step > 0; step >>= 1) if (e + step <= 64 && tstart[e + step] <= tile) e += step;
        if (e < 64 && tstart[e + 1] <= tile) e += 1;
        return e;
    }
    __device__ __forceinline__ void fill_table(LAS int* tab, int tid) const {
        if (tid < 32) { const int L = L0 + tid * G + c; const int tile = L >> npn_shift; tab[tid] = (L < Llim && tile < tstart[65]) ? find_expert(tile) : -1; }
    }
    __device__ __forceinline__ bool next(int i, Unit& u) const {
        const int e = i < 32 ? uexp[i] : -1; if (e < 0) return false;
        const int L = L0 + i * G + c; const int tile = L >> npn_shift;
        u.e = e; u.pm = tile; u.pn = L & ((1 << npn_shift) - 1); u.row0 = tile * BM;
        u.A = A + (size_t)tile * a_tile_bytes; u.B = W + (size_t)e * w_exp_bytes + (size_t)u.pn * w_tile_bytes; return true;
    }
    __device__ __forceinline__ const LAS int* list(int i) const { return lists + i * 256; }
    __device__ __forceinline__ void a_ready(const Unit& u) const {
        if (ready_cnt == nullptr) return;
        if (threadIdx.x < 64) {
            unsigned spins = 0;
            while ((unsigned)__builtin_amdgcn_readfirstlane((int)__hip_atomic_load(ready_cnt + u.pm, __ATOMIC_RELAXED, __HIP_MEMORY_SCOPE_AGENT)) < 32u) { __builtin_amdgcn_s_sleep(2); if (++spins > (1u << 20)) break; }
            __builtin_amdgcn_fence(__ATOMIC_ACQUIRE, "agent");
            asm volatile("s_waitcnt vmcnt(0)" ::: "memory");
        }
        asm volatile("" ::: "memory"); __builtin_amdgcn_s_barrier(); asm volatile("" ::: "memory");
    }
    __device__ __forceinline__ void done(const Unit& u) const {
        if (done_cnt != nullptr && (threadIdx.x & 63) == 0) (void)__hip_atomic_fetch_add(done_cnt + u.pm, 1u, __ATOMIC_RELAXED, __HIP_MEMORY_SCOPE_AGENT);
    }
};
}

__device__ __forceinline__ void p8_norm2(const Frame& F) {
    LAS float* sh = (LAS float*)F.lds; LAS float* sc = sh + D;
    const float* MOD = (const float*)(F.ws + WS_MOD);
    for (int blk = F.bid; blk < NTOK / 64; blk += F.G) {
        const int b = blk / (SEQ / 64);
        __syncthreads();
        for (int i = F.tid; i < D; i += NTHREADS) { sh[i] = MOD[b * 6 * D + 3 * D + i]; sc[i] = (1.f + MOD[b * 6 * D + 4 * D + i]) * F.in[4][i]; }
        __syncthreads();
        for (int j = 0; j < 8; ++j) {
            const int t = blk * 64 + F.wave * 8 + j;
            const f32x4* xr = (const f32x4*)(F.in[0] + (size_t)t * D) + F.lane; const u32x2* yr = (const u32x2*)((const bf16_t*)(F.ws + WS_Y1) + (size_t)t * D) + F.lane;
            f32x4 v[8]; float s = 0.f;
#pragma unroll
            for (int q = 0; q < 8; ++q) { const u32x2 yv = yr[64 * q]; v[q] = xr[64 * q] + (f32x4){bf_lo(yv.x), bf_hi(yv.x), bf_lo(yv.y), bf_hi(yv.y)}; s += (v[q].x * v[q].x + v[q].y * v[q].y) + (v[q].z * v[q].z + v[q].w * v[q].w); }
            const float r = rsqrtf(wave_sum(s) * (1.f / D) + EPS);
            u32x2* oh = (u32x2*)((bf16_t*)(F.ws + WS_HB) + (size_t)t * D) + F.lane;
            u32x2* ol = (u32x2*)((bf16_t*)(F.ws + WS_HLO) + (size_t)t * D) + F.lane;
#pragma unroll
            for (int q = 0; q < 8; ++q) { const int c0 = 4 * F.lane + 256 * q;
                const f32x4 a = *(const LAS f32x4*)(sc + c0), bb = *(const LAS f32x4*)(sh + c0);
                const float y0 = v[q].x * r * a.x + bb.x, y1 = v[q].y * r * a.y + bb.y, y2 = v[q].z * r * a.z + bb.z, y3 = v[q].w * r * a.w + bb.w;
                u32x2 wh; wh.x = pk2(y0, y1); wh.y = pk2(y2, y3);
                u32x2 wl; wl.x = pk2(y0 - bf_lo(wh.x), y1 - bf_hi(wh.x)); wl.y = pk2(y2 - bf_lo(wh.y), y3 - bf_hi(wh.y));
                oh[64 * q] = wh; ol[64 * q] = wl; }
        }
    }
}

__device__ __forceinline__ void p10a_route(const Frame& F) {
    const float* RLOG = (const float*)(F.ws + WS_RLOG); const float* rbias = F.in[17];
    int* TOKE = (int*)(F.ws + WS_TOKE); float* TOKW = (float*)(F.ws + WS_TOKW); int* TOKRANK = (int*)(F.ws + WS_TOKRANK); int* BLKBASE = (int*)(F.ws + WS_BLKBASE);
    LAS int* hist = (LAS int*)F.lds;
    const int e = F.lane; const float rb = rbias[e];
    for (int blk = F.bid; blk < NTOK / 64; blk += F.G) {
        __syncthreads();
        if (F.tid < 64) hist[F.tid] = 0;
        __syncthreads();
        for (int j = 0; j < 8; ++j) {
            const int t = blk * 64 + F.wave * 8 + j;
            const float* rl = RLOG + (size_t)t * 384;
            const float logit = ((rl[e] + rl[192 + e]) + (rl[64 + e] + rl[256 + e])) + (rl[128 + e] + rl[320 + e]);
            const float s = 1.f / (1.f + expf(-logit)), sel = s + rb;
            float m1 = sel;
            m1 = fmaxf(m1, __shfl_xor(m1, 1)); m1 = fmaxf(m1, __shfl_xor(m1, 2)); m1 = fmaxf(m1, __shfl_xor(m1, 4));
            const unsigned long long ismax = __ballot(sel == m1);
            const int firstmax = __ffsll((long long)((ismax >> (e & ~7)) & 0xffull)) - 1 + (e & ~7);
            float m2 = (e == firstmax) ? -3.0e38f : sel;
            m2 = fmaxf(m2, __shfl_xor(m2, 1)); m2 = fmaxf(m2, __shfl_xor(m2, 2)); m2 = fmaxf(m2, __shfl_xor(m2, 4));
            const float gs = m1 + m2; const int g = e >> 3;
            int grank = 0;
#pragma unroll
            for (int g2 = 0; g2 < 8; ++g2) { const float o = __shfl(gs, g2 * 8); grank += (o > gs || (o == gs && g2 < g)) ? 1 : 0; }
            const float cand = grank < 4 ? sel : -1.0e30f;
            int rank = 0;
#pragma unroll
            for (int e2 = 0; e2 < 64; ++e2) { const float o = __shfl(cand, e2); rank += (o > cand || (o == cand && e2 < e)) ? 1 : 0; }
            const bool chosen = rank < 8;
            const float wsum = wave_sum(chosen ? s : 0.f);
            if (chosen) {
                const int lr = __hip_atomic_fetch_add(&hist[e], 1, __ATOMIC_RELAXED, __HIP_MEMORY_SCOPE_WORKGROUP);
                TOKE[t * 8 + rank] = e; TOKW[t * 8 + rank] = s / wsum * 2.5f; TOKRANK[t * 8 + rank] = lr;
            }
        }
        __syncthreads();
        if (F.tid < 64) { const int base = (int)atomicAdd(F.ctl + CW_CNT + F.tid, (unsigned)hist[F.tid]); BLKBASE[blk * 64 + F.tid] = base; }
    }
}
__device__ __forceinline__ void moe_tile_table(const Frame& F, LAS int* tst) {
    __syncthreads();
    if (F.tid == 0) { int o = 0; for (int e = 0; e < 64; ++e) { tst[e] = o; o += ((int)F.ctl[CW_CNT + e] + 255) >> 8; } tst[64] = o; tst[65] = o + NTOK / 256; }
    __syncthreads();
}
__device__ __forceinline__ int moe_tail_units(int T) {
    const int rem = (4 * T) & 255, ntail = rem ? 256 - rem : 0;
    const int R = max(0, (8 * T - TAIL_CAP * ntail + 255) >> 8);
    return max(0, 8 * T - 256 * R);
}
__device__ __forceinline__ void p10b_lists(const Frame& F) {
    const int* TOKE = (const int*)(F.ws + WS_TOKE); const int* TOKRANK = (const int*)(F.ws + WS_TOKRANK); const int* BLKBASE = (const int*)(F.ws + WS_BLKBASE);
    int* TOKPOS = (int*)(F.ws + WS_TOKPOS); int* SRT = (int*)(F.ws + WS_SRT);
    LAS int* tst = (LAS int*)F.lds;
    moe_tile_table(F, tst);
    for (int blk = F.bid; blk < NTOK / 64; blk += F.G) {
        { const int i = blk * 512 + F.tid;
          const int e = TOKE[i], pos = tst[e] * 256 + BLKBASE[blk * 64 + e] + TOKRANK[i];
          SRT[pos] = i >> 3; TOKPOS[i] = pos; }
        if (F.tid < 64) SRT[tst[64] * 256 + blk * 64 + F.tid] = blk * 64 + F.tid;
    }
    for (int e = F.bid; e < 64; e += F.G) {
        const int lo = tst[e] * 256 + (int)F.ctl[CW_CNT + e], hi = tst[e + 1] * 256;
        for (int p = lo + F.tid; p < hi; p += NTHREADS) SRT[p] = 0;
    }
}
__device__ __forceinline__ void p13_combine(const Frame& F) {
    const unsigned char* YB = (const unsigned char*)(F.ws + WS_YB); const int* TOKPOS = (const int*)(F.ws + WS_TOKPOS); const float* TOKW = (const float*)(F.ws + WS_TOKW);
    const float* MOD = (const float*)(F.ws + WS_MOD);
    LAS int* tst = (LAS int*)F.lds;
    moe_tile_table(F, tst);
    const int sh0 = tst[64] * 256;
    const int gw = F.bid * NWAVES + F.wave, NGW = F.G * NWAVES;
    for (int t = gw; t < NTOK; t += NGW) {
        const int b = t / SEQ;
        int pos[9]; float wk[9];
#pragma unroll
        for (int k = 0; k < 8; ++k) { pos[k] = TOKPOS[t * 8 + k]; wk[k] = TOKW[t * 8 + k] * (1.f / pg8::YB_SCALE); }
        pos[8] = sh0 + t; wk[8] = 1.f / pg8::YB_SCALE;
        float* orow = F.out + (size_t)t * D; const float* g2 = MOD + (size_t)b * 6 * D + 5 * D; const float* xrow = F.in[0] + (size_t)t * D; const bf16_t* yrow = (const bf16_t*)(F.ws + WS_Y1) + (size_t)t * D;
#pragma unroll 2
        for (int q = 0; q < 8; ++q) { const int c = 4 * F.lane + 256 * q;
            float a0 = 0.f, a1 = 0.f, a2 = 0.f, a3 = 0.f;
#pragma unroll
            for (int k = 0; k < 9; ++k) { const int y = *(const int*)(YB + (size_t)pos[k] * D + c);
                const f32x2 lo = __builtin_amdgcn_cvt_pk_f32_fp8(y, false), hi2 = __builtin_amdgcn_cvt_pk_f32_fp8(y, true);
                a0 += wk[k] * lo.x; a1 += wk[k] * lo.y; a2 += wk[k] * hi2.x; a3 += wk[k] * hi2.y; }
            const u32x2 yv = *(const u32x2*)(yrow + c); const f32x4 xv = *(const f32x4*)(xrow + c) + (f32x4){bf_lo(yv.x), bf_hi(yv.x), bf_lo(yv.y), bf_hi(yv.y)}, gv = *(const f32x4*)(g2 + c);
            *(f32x4*)(orow + c) = (f32x4){xv.x + gv.x * a0, xv.y + gv.y * a1, xv.z + gv.z * a2, xv.w + gv.w * a3}; }
    }
}
constexpr int N_PHASES = 16;
__global__ void __launch_bounds__(NTHREADS, 2) mk_fwd(Args args) {
    extern __shared__ __attribute__((aligned(16))) unsigned char lds_raw[];
    Frame F;
    F.lds = (LAS unsigned char*)lds_raw; F.ws = args.ws; F.ctl = (unsigned*)(args.ws + WS_CTL); F.in = args.in; F.out = args.out;
    F.tid = threadIdx.x; F.lane = F.tid & 63; F.wave = __builtin_amdgcn_readfirstlane(F.tid >> 6); F.G = gridDim.x; F.bid = blockIdx.x;
    volatile LAS unsigned* MISC = (volatile LAS unsigned*)(F.lds + MISC_OFF);
    if (F.tid < 64) MISC[F.tid] = 0u;
    __syncthreads();
    const int vcu = (F.G % 8 == 0) ? (F.bid & 7) * (F.G >> 3) + (F.bid >> 3) : F.bid;
    const int lo = args.ph_lo, hi = args.ph_hi;
    const bool need_bar = (hi - lo) > 1;
    XcdBarrier bar; bar.bar = F.ctl + CW_BAR + args.bar_region * XCD_BAR_WORDS; bar.x = 0; bar.st = MISC + 8;
    if (need_bar) bar = xcd_barrier_post(F.ctl + CW_BAR + args.bar_region * XCD_BAR_WORDS, MISC + 8);
#define IN(k) (lo <= (k) && (k) < hi)
#define SEAM(k) do { if (IN(k) && IN((k) + 1)) xcd_barrier(bar); } while (0)
#ifndef DUP_MASK
#define DUP_MASK 0
#endif
#define PHASE_NOSEAM(k, ...) if (IN(k)) { __VA_ARGS__ if ((DUP_MASK >> (k)) & 1) { xcd_barrier(bar); __VA_ARGS__ } }
#define PHASE(k, ...) if (IN(k)) { __VA_ARGS__ if ((DUP_MASK >> (k)) & 1) { xcd_barrier(bar); __VA_ARGS__ } } SEAM(k);

    PHASE(0, p0_prologue(F);)
    PHASE(1, p1_norm1(F);)
#ifdef CVT_XCD
    PHASE(2,  if (F.G != 256) { pg8::PlainOrder S; S.init(F.ws + WS_HB, F.ws + WS_WINT, NTOK, TOTP, D, F.G, F.bid); pg8::EpiBf16 E{(bf16_t*)(F.ws + WS_PROJ), TOTP}; pg8::gemm_phase<pg8::EpiBf16, pg8::PlainOrder, false>(F.lds, D, S, E); cvt_run<true>(F, NITEMS_EXP, 0, F.G); }
        else { const int xcd = F.bid & 7, jx = F.bid >> 3;
            int wg0 = 0, it0 = 0, nu = 0, it1 = 0;
            { int wacc = 0, iacc = 0;
              for (int x = 0; x < 8; ++x) { const int n_x = (P2_NU >> (4 * x)) & 15; const int q_x = (int)(((long long)NITEMS_EXP * ((P2_CV >> (4 * x)) & 15)) / P2_CVSUM);
                  if (x == xcd) { wg0 = wacc; nu = n_x; it0 = iacc; it1 = (x == 7) ? NITEMS_EXP : iacc + q_x; } wacc += 32 * n_x; iacc += q_x; } }
            { Frame Fx = F; Fx.bid = jx; cvt_run<true>(Fx, it1, 0, 32, it0); }
            pg8::XcdRunOrder S; S.A = (const char*)(F.ws + WS_HB); S.Bt = (const char*)(F.ws + WS_WINT); S.K = D; S.nM = NTOK / 256; S.nN = TOTP / 256; S.wg0 = wg0; S.wpx = 32; S.j = jx; S.nu = nu;
            pg8::EpiBf16 E{(bf16_t*)(F.ws + WS_PROJ), TOTP}; pg8::gemm_phase<pg8::EpiBf16, pg8::XcdRunOrder, false>(F.lds, D, S, E); })
#elif defined(CVT_OVERLAP) && !defined(CVT_IN_ATTN) && !defined(CVT_P0_ON)
    PHASE(2,  constexpr int NU = (NTOK / 256) * (TOTP / 256);
        if (F.G <= CVT_NG) { pg8::PlainOrder S; S.init(F.ws + WS_HB, F.ws + WS_WINT, NTOK, TOTP, D, F.G, F.bid); pg8::EpiBf16 E{(bf16_t*)(F.ws + WS_PROJ), TOTP}; pg8::gemm_phase<pg8::EpiBf16, pg8::PlainOrder, false>(F.lds, D, S, E); cvt_run<true>(F, NITEMS_EXP, 0, F.G); }
        else { pg8::PlainOrder S; pg8::EpiBf16 E{(bf16_t*)(F.ws + WS_PROJ), TOTP};
            if (F.bid < CVT_NG) {
#if defined(STAG2) && STAG2 > 0
                { const unsigned long long t0_ = __builtin_amdgcn_s_memrealtime(); const unsigned long long dl_ = (unsigned long long)((F.bid & 7) * STAG2); while (__builtin_amdgcn_s_memrealtime() - t0_ < dl_) __builtin_amdgcn_s_sleep(8); }
#endif
                S.init(F.ws + WS_HB, F.ws + WS_WINT, NTOK, TOTP, D, CVT_NG, F.bid);
#ifdef KREP_P2
 S.krep = KREP_P2;
#endif
 S.Lend = CVT_NG * CVT_UG < NU ? CVT_NG * CVT_UG : NU; }
            else { cvt_run<true>(F, NITEMS_EXP, CVT_NG, F.G - CVT_NG); S.init(F.ws + WS_HB, F.ws + WS_WINT, NTOK, TOTP, D, F.G - CVT_NG, F.bid - CVT_NG); S.L0 = CVT_NG * CVT_UG < NU ? CVT_NG * CVT_UG : NU; }

#ifdef P2X
            if (F.bid < CVT_NG) { pg8::EpiBf16 E0{(bf16_t*)(F.ws + WS_PROJ), TOTP, P2X == 1 ? 1 : 0}; pg8::gemm_phase<pg8::EpiBf16, pg8::PlainOrder, false>(F.lds, D, S, E0); }
#endif
            pg8::gemm_phase<pg8::EpiBf16, pg8::PlainOrder, false>(F.lds, D, S, E); })
#else
    PHASE(2,  pg8::PlainOrder S; S.init(F.ws + WS_HB, F.ws + WS_WINT, NTOK, TOTP, D, F.G, F.bid); pg8::EpiBf16 E{(bf16_t*)(F.ws + WS_PROJ), TOTP}; pg8::gemm_phase<pg8::EpiBf16, pg8::PlainOrder, false>(F.lds, D, S, E);)
#endif
    PHASE(3, p3_mix(F);)
#ifdef CVT_IN_ATTN
    PHASE(4, if (F.G <= CVT_NG2) { p4_index(F); cvt_run<true>(F, CVT_SPLIT, 0, F.G); } else if (F.bid < CVT_NG2) { Frame Fg = F; Fg.G = CVT_NG2; p4_index(Fg); } else { cvt_run<true>(F, CVT_SPLIT, CVT_NG2, F.G - CVT_NG2); })
    PHASE(5, if (F.G <= CVT_NG2) { p5_attn(F); cvt_run<true>(F, NITEMS_EXP, 0, F.G, CVT_SPLIT); } else if (F.bid < CVT_NG2) { Frame Fg = F; Fg.G = CVT_NG2; p5_attn(Fg); } else { cvt_run<true>(F, NITEMS_EXP, CVT_NG2, F.G - CVT_NG2, CVT_SPLIT); })
#else
    PHASE(4, p4_index(F);)
    PHASE(5, p5_attn(F);)
#endif
    PHASE_NOSEAM(6,  pg8::PlainOrder S; S.init(F.ws + WS_UMIX, F.ws + WS_WCVT, NTOK, D, CW, F.G, F.bid); pg8::EpiGate<false> E{(const bf16_t*)(F.ws + WS_PROJ) + O_GA, TOTP, (bf16_t*)(F.ws + WS_HB)}; pg8::gemm_phase<pg8::EpiGate<false>, pg8::PlainOrder, false>(F.lds, CW, S, E);)
    PHASE(7,  pg8::PlainOrder S; S.init(F.ws + WS_AO, F.ws + WS_WATT, NTOK, D, AW, F.G, F.bid); pg8::EpiGate<true> E{(const bf16_t*)(F.ws + WS_PROJ) + O_GB, TOTP, (bf16_t*)(F.ws + WS_HB)}; pg8::gemm_phase<pg8::EpiGate<true>, pg8::PlainOrder, false>(F.lds, AW, S, E);)
    PHASE(8,  pg8::PlainOrder S; S.init(F.ws + WS_HB, F.ws + WS_WOT, NTOK, D, D, F.G, F.bid); pg8::EpiY1 E{(const float*)(F.ws + WS_MOD) + 2 * D, (bf16_t*)(F.ws + WS_Y1)}; pg8::gemm_phase<pg8::EpiY1, pg8::PlainOrder, false>(F.lds, D, S, E);)
    PHASE(9, p8_norm2(F);)
    PHASE(10,  pg8::RouterOrder S{(const char*)(F.ws + WS_HB), (const char*)(F.ws + WS_HLO), (const char*)(F.ws + WS_WRX), (const char*)(F.ws + WS_WRY), F.G, F.bid}; pg8::EpiRouter E{(float*)(F.ws + WS_RLOG)}; pg8::gemm_phase<pg8::EpiRouter, pg8::RouterOrder, false>(F.lds, D / 2, S, E, D);)
    PHASE(11, p10a_route(F);)
    PHASE(12, p10b_lists(F);)
    PHASE(13,  LAS int* tst = (LAS int*)(F.lds + LIST_OFF + 11264); LAS int* lists = (LAS int*)(F.lds + LIST_OFF); moe_tile_table(F, tst); const int* SRT = (const int*)(F.ws + WS_SRT); for (int i = 0; i < 11; ++i) { const int tile = (i * F.G + vcu) >> 2; if (tile >= tst[65]) break; if (F.tid < 256) lists[i * 256 + F.tid] = SRT[tile * 256 + F.tid]; } __syncthreads(); pg8::MoeOrder S{(const char*)(F.ws + WS_HB), (const char*)(F.ws + WS_W13T), tst, lists, F.G, vcu, 2, 0, (size_t)1024 * D * 2, (size_t)256 * D * 2, tst + 96}; S.fill_table(tst + 96, F.tid); __syncthreads(); S.Llim = 4 * tst[65]; S.done_cnt = F.ctl + CW_TDONE; pg8::EpiSwiglu E{(bf16_t*)(F.ws + WS_HH)}; pg8::gemm_phase<pg8::EpiSwiglu, pg8::MoeOrder, true>(F.lds, D, S, E);
               { const int T_ = tst[65], rem_ = (4 * T_) & 255, ntail_ = rem_ ? 256 - rem_ : 0; const int M_ = moe_tail_units(T_);
                 if (M_ > 0 && vcu >= rem_) { pg8::MoeOrder S2{(const char*)(F.ws + WS_HH), (const char*)(F.ws + WS_W2T), tst, nullptr, ntail_, vcu - rem_, 3, 256 * DE * 2, (size_t)D * DE * 2, (size_t)256 * DE * 2, tst + 128}; S2.Llim = M_; S2.ready_cnt = F.ctl + CW_TDONE;
                   S2.fill_table(tst + 128, F.tid); __syncthreads(); pg8::EpiFp8 E2{(unsigned char*)(F.ws + WS_YB), 0}; pg8::gemm_phase<pg8::EpiFp8, pg8::MoeOrder, false>(F.lds, DE, S2, E2); } })
#ifndef STAG14
#define STAG14 0
#endif
    PHASE(14,  if (STAG14 && vcu >= 8) { const unsigned long long t0_ = __builtin_amdgcn_s_memrealtime(); const unsigned long long dl_ = (unsigned long long)((vcu & 7) * STAG14); while (__builtin_amdgcn_s_memrealtime() - t0_ < dl_) __builtin_amdgcn_s_sleep(8); }
               LAS int* tst = (LAS int*)(F.lds + LIST_OFF + 11264); moe_tile_table(F, tst); pg8::MoeOrder S{(const char*)(F.ws + WS_HH), (const char*)(F.ws + WS_W2T), tst, nullptr, F.G, vcu, 3, 256 * DE * 2, (size_t)D * DE * 2, (size_t)256 * DE * 2, tst + 96}; S.L0 = moe_tail_units(tst[65]); S.Llim = 8 * tst[65]; S.fill_table(tst + 96, F.tid); __syncthreads(); pg8::EpiFp8 E{(unsigned char*)(F.ws + WS_YB), 0};
#if defined(P14X)
               { pg8::EpiFp8 E0{(unsigned char*)(F.ws + WS_YB), P14X == 1 ? 1 : (P14X == 3 ? 2 : 0)}; pg8::gemm_phase<pg8::EpiFp8, pg8::MoeOrder, false>(F.lds, DE, S, E0); xcd_barrier(bar); }
#endif
               pg8::gemm_phase<pg8::EpiFp8, pg8::MoeOrder, false>(F.lds, DE, S, E);)
#ifdef P15_DELAY
    PHASE(15, { const unsigned long long t0_ = __builtin_amdgcn_s_memrealtime(); while (__builtin_amdgcn_s_memrealtime() - t0_ < (unsigned long long)P15_DELAY) __builtin_amdgcn_s_sleep(8); } p13_combine(F);)
#else
    PHASE(15, p13_combine(F);)
#endif
#undef IN
#undef SEAM
}

static int g_grid = 0;
static bool mk_setup(size_t ws_size) {
    if (g_grid == 0) {
        if (ws_size < WS_END) { fprintf(stderr, "kernel_launch: workspace too small: %zu < %zu\n", ws_size, (size_t)WS_END); g_grid = -1; return false; }
        int dev = 0, cus = 0, per_cu = 0;
        if (hipGetDevice(&dev) != hipSuccess || hipDeviceGetAttribute(&cus, hipDeviceAttributeMultiprocessorCount, dev) != hipSuccess) { g_grid = -1; return false; }
        if (hipFuncSetAttribute((const void*)mk_fwd, hipFuncAttributeMaxDynamicSharedMemorySize, LDS_BYTES) != hipSuccess) { fprintf(stderr, "kernel_launch: hipFuncSetAttribute failed\n"); g_grid = -1; return false; }
        if (hipOccupancyMaxActiveBlocksPerMultiprocessor(&per_cu, (const void*)mk_fwd, NTHREADS, LDS_BYTES) != hipSuccess || per_cu < 1) { fprintf(stderr, "kernel_launch: occupancy query says %d\n", per_cu); }
        (void)hipGetLastError();
        g_grid = cus;
    }
    return g_grid > 0;
}
static void mk_launch(const Args& a0, int lo, int hi, int region, hipStream_t stream) {
    Args a = a0; a.ph_lo = lo; a.ph_hi = hi; a.bar_region = region;
    hipLaunchKernelGGL(mk_fwd, dim3(g_grid), dim3(NTHREADS), LDS_BYTES, stream, a);
}
#ifndef MK_N_LAUNCHES
#define MK_N_LAUNCHES 1
#endif
extern "C" void kernel_launch(void* const* d_in, const int* in_sizes, int n_in, void* d_out, int out_size, void* d_ws, size_t ws_size, hipStream_t stream) {
    if (!mk_setup(ws_size)) return;
    (void)hipMemsetAsync((char*)d_ws + WS_CTL, 0, CTL_ZERO_BYTES, stream);
    Args a{};
    for (int i = 0; i < 24; ++i) a.in[i] = (const float*)d_in[i];
    a.out = (float*)d_out; a.ws = (unsigned char*)d_ws;
    if (MK_N_LAUNCHES == 1) mk_launch(a, 0, N_PHASES, 0, stream);
    else for (int p = 0; p < N_PHASES; ++p) mk_launch(a, p, p + 1, 0, stream);
}
```
